# Optimizing an MI355X kernel written in HIP

```python
import jax, jax.numpy as jnp
from jax import lax
import numpy as np

D_MODEL = 1024
BATCH = 8
SEQ = 4096
DEPTH = 4

GRID_W = 64
CTX_LEN = 256
N_MIXERS = 3
QUERY_BLOCK = 128
NORM_EPS = 1e-6
ROPE_BASE = 10000.0

A_HEADS = 16
A_KV_HEADS = 4
A_GROUP = A_HEADS // A_KV_HEADS
A_HEAD_DIM = D_MODEL // A_HEADS
F_GROUPS = 4
M_HEADS = 16
M_Q_LORA = 3 * D_MODEL // 8
M_KV_LORA = D_MODEL // 4
M_NOPE = D_MODEL // 16
M_ROPE = D_MODEL // 32
M_V = D_MODEL // 16
FF_DENSE = 11 * D_MODEL // 4
N_EXPERTS = 8
TOP_K = 2
FF_EXPERT = 7 * D_MODEL // 2

N_A = (DEPTH + 2) // 3
N_B = (DEPTH + 1) // 3
N_C = DEPTH // 3
N_DENSE = (DEPTH + 1) // 2
N_MOE = DEPTH // 2

kernel_name = "hybrid_gqa_fnet_mla_moe_dit"


def rmsnorm(x, g):
    x32 = x.astype(jnp.float32)
    y = x32 * lax.rsqrt(jnp.mean(x32 * x32, axis=-1, keepdims=True) + NORM_EPS)
    return (y * g.astype(jnp.float32)).astype(x.dtype)


def modulate(h, shift, scale):
    return h * (1 + scale) + shift


def axial_rope_tables(rows, cols, rot_dim):
    nf = rot_dim // 4
    inv = ROPE_BASE ** (-jnp.arange(nf, dtype=jnp.float32) / nf)
    ang_r = rows[:, None] * inv[None, :]
    ang_c = cols[:, None] * inv[None, :]
    return (jnp.cos(ang_r), jnp.sin(ang_r), jnp.cos(ang_c), jnp.sin(ang_c))


def _rotate(x, cos, sin):
    x1, x2 = jnp.split(x, 2, axis=-1)
    cos = cos[None, :, None, :]
    sin = sin[None, :, None, :]
    return jnp.concatenate([x1 * cos - x2 * sin, x2 * cos + x1 * sin], axis=-1)


def apply_axial_rope(x, tabs):
    cr, sr, cc, sc = tabs
    xr, xc = jnp.split(x, 2, axis=-1)
    out = jnp.concatenate([_rotate(xr, cr, sr), _rotate(xc, cc, sc)], axis=-1)
    return out.astype(x.dtype)


def sweep_attention(q, k, v, scale):
    B, Sq, KV, G, dk = q.shape
    dv = v.shape[-1]
    nb = Sq // QUERY_BLOCK
    qb = q.reshape(B, nb, QUERY_BLOCK, KV, G, dk).transpose(1, 0, 2, 3, 4, 5)

    def one_block(qblk):
        s = jnp.einsum('bqkgd,bskd->bkgqs', qblk, k, preferred_element_type=jnp.float32) * scale
        p = jax.nn.softmax(s, axis=-1).astype(v.dtype)
        return jnp.einsum('bkgqs,bskd->bqkgd', p, v)

    o = lax.map(one_block, qb)
    return o.transpose(1, 0, 2, 3, 4, 5).reshape(B, Sq, KV * G * dv)


def _gqa_project(h, w_qkv, g_q, g_k, with_q):
    B, S, _ = h.shape
    nq = A_HEADS * A_HEAD_DIM
    nkv = A_KV_HEADS * A_HEAD_DIM
    out = h @ (w_qkv if with_q else w_qkv[:, nq:])
    q = None
    if with_q:
        q = rmsnorm(out[..., :nq].reshape(B, S, A_HEADS, A_HEAD_DIM), g_q)
        out = out[..., nq:]
    k = rmsnorm(out[..., :nkv].reshape(B, S, A_KV_HEADS, A_HEAD_DIM), g_k)
    v = out[..., nkv:].reshape(B, S, A_KV_HEADS, A_HEAD_DIM)
    return q, k, v


def gqa_mixer(hc, hl, w_qkv, g_q, g_k, w_o, rope, ctx_queries):
    scale = A_HEAD_DIM ** -0.5
    ql, kl, vl = _gqa_project(hl, w_qkv, g_q, g_k, True)
    ql = apply_axial_rope(ql, rope)
    kl = apply_axial_rope(kl, rope)
    qc, kc, vc = _gqa_project(hc, w_qkv, g_q, g_k, ctx_queries)
    k_all = jnp.concatenate([kc, kl], axis=1)
    v_all = jnp.concatenate([vc, vl], axis=1)
    B, S = hl.shape[:2]
    yl = sweep_attention(ql.reshape(B, S, A_KV_HEADS, A_GROUP, A_HEAD_DIM), k_all, v_all, scale) @ w_o
    yc = None
    if ctx_queries:
        L = hc.shape[1]
        yc = sweep_attention(qc.reshape(B, L, A_KV_HEADS, A_GROUP, A_HEAD_DIM), kc, vc, scale) @ w_o
    return yc, yl


def fourier_mixer(h, w_f):
    B, S, D = h.shape
    hg = h.astype(jnp.float32).reshape(B, S, F_GROUPS, D // F_GROUPS)
    f = jnp.fft.fftn(hg, axes=(1, 3), norm='ortho').real
    return f.reshape(B, S, D).astype(h.dtype) @ w_f


def _mla_project(h, w_down, g_cq, g_ckv, w_uq, w_ukv, rope, with_q):
    B, S, _ = h.shape
    d = h @ (w_down if with_q else w_down[:, M_Q_LORA:])
    cq = None
    if with_q:
        cq = d[..., :M_Q_LORA]
        d = d[..., M_Q_LORA:]
    ckv = d[..., :M_KV_LORA]
    kr = d[..., M_KV_LORA:].reshape(B, S, 1, M_ROPE)
    kv = (rmsnorm(ckv, g_ckv) @ w_ukv).reshape(B, S, M_HEADS, M_NOPE + M_V)
    k_nope, v = kv[..., :M_NOPE], kv[..., M_NOPE:]
    if rope is not None:
        kr = apply_axial_rope(kr, rope)
    k = jnp.concatenate([k_nope, jnp.broadcast_to(kr, (B, S, M_HEADS, M_ROPE))], axis=-1)
    q = None
    if with_q:
        q = (rmsnorm(cq, g_cq) @ w_uq).reshape(B, S, M_HEADS, M_NOPE + M_ROPE)
        if rope is not None:
            q = jnp.concatenate([q[..., :M_NOPE], apply_axial_rope(q[..., M_NOPE:], rope)], axis=-1)
    return q, k, v


def mla_mixer(hc, hl, w_down, g_cq, g_ckv, w_uq, w_ukv, w_o, rope, ctx_queries):
    scale = (M_NOPE + M_ROPE) ** -0.5
    ql, kl, vl = _mla_project(hl, w_down, g_cq, g_ckv, w_uq, w_ukv, rope, True)
    qc, kc, vc = _mla_project(hc, w_down, g_cq, g_ckv, w_uq, w_ukv, None, ctx_queries)
    k_all = jnp.concatenate([kc, kl], axis=1)
    v_all = jnp.concatenate([vc, vl], axis=1)
    yl = sweep_attention(ql[:, :, :, None, :], k_all, v_all, scale) @ w_o
    yc = None
    if ctx_queries:
        yc = sweep_attention(qc[:, :, :, None, :], kc, vc, scale) @ w_o
    return yc, yl


def swiglu(h, w_gu, w_down):
    g, u = jnp.split(h @ w_gu, 2, axis=-1)
    return (jax.nn.silu(g) * u) @ w_down


def moe_swiglu(h, w_router, w_gu, w_down):
    B, S, D = h.shape
    t = h.reshape(B * S, D)
    logits = (t @ w_router).astype(jnp.float32)
    top_v, top_i = lax.top_k(logits, TOP_K)
    wts = jax.nn.softmax(top_v, axis=-1)
    gates = jnp.sum(jax.nn.one_hot(top_i, N_EXPERTS, dtype=jnp.float32) * wts[..., None], axis=1).astype(h.dtype)
    out = jnp.zeros_like(t)
    for e in range(N_EXPERTS):
        out = out + gates[:, e:e + 1] * swiglu(t, w_gu[e], w_down[e])
    return out.reshape(B, S, D)


def setup_inputs(seed: int = 0) -> dict:
    key = jax.random.key(seed)
    ks = jax.random.split(key, 24)
    D = D_MODEL

    def nrm(k, shape, std):
        return jax.random.normal(k, shape, dtype=jnp.float32) * std

    def gain(k, shape):
        return 1.0 + 0.02 * jax.random.normal(k, shape, dtype=jnp.float32)

    return {
        'x': nrm(ks[0], (BATCH, SEQ, D), 1.0),
        'c': nrm(ks[1], (BATCH, D), 1.0),
        'ctx': nrm(ks[2], (BATCH, CTX_LEN, D), 1.0),
        'c_ctx': nrm(ks[3], (D,), 1.0),
        'w_mod': nrm(ks[4], (DEPTH, D, 6 * D), 0.5 * D ** -0.5),
        'b_mod': nrm(ks[5], (DEPTH, 6 * D), 0.02),
        'norm_g': gain(ks[6], (DEPTH, 4, D)),
        'a_w_qkv': nrm(ks[7], (N_A, D, (A_HEADS + 2 * A_KV_HEADS) * A_HEAD_DIM), D ** -0.5),
        'a_g_q': gain(ks[8], (N_A, A_HEAD_DIM)),
        'a_g_k': gain(ks[9], (N_A, A_HEAD_DIM)),
        'a_w_o': nrm(ks[10], (N_A, A_HEADS * A_HEAD_DIM, D), (A_HEADS * A_HEAD_DIM) ** -0.5),
        'f_w': nrm(ks[11], (N_B, D, D), D ** -0.5),
        'm_w_down': nrm(ks[12], (N_C, D, M_Q_LORA + M_KV_LORA + M_ROPE), D ** -0.5),
        'm_g_cq': gain(ks[13], (N_C, M_Q_LORA)),
        'm_g_ckv': gain(ks[14], (N_C, M_KV_LORA)),
        'm_w_uq': nrm(ks[15], (N_C, M_Q_LORA, M_HEADS * (M_NOPE + M_ROPE)), M_Q_LORA ** -0.5),
        'm_w_ukv': nrm(ks[16], (N_C, M_KV_LORA, M_HEADS * (M_NOPE + M_V)), M_KV_LORA ** -0.5),
        'm_w_o': nrm(ks[17], (N_C, M_HEADS * M_V, D), (M_HEADS * M_V) ** -0.5),
        'd_w_gu': nrm(ks[18], (N_DENSE, D, 2 * FF_DENSE), D ** -0.5),
        'd_w_down': nrm(ks[19], (N_DENSE, FF_DENSE, D), FF_DENSE ** -0.5),
        'e_w_router': nrm(ks[20], (N_MOE, D, N_EXPERTS), D ** -0.5),
        'e_w_gu': nrm(ks[21], (N_MOE, N_EXPERTS, D, 2 * FF_EXPERT), D ** -0.5),
        'e_w_down': nrm(ks[22], (N_MOE, N_EXPERTS, FF_EXPERT, D), FF_EXPERT ** -0.5),
    }


def reference(x, c, ctx, c_ctx, w_mod, b_mod, norm_g, a_w_qkv, a_g_q, a_g_k, a_w_o, f_w,
              m_w_down, m_g_cq, m_g_ckv, m_w_uq, m_w_ukv, m_w_o, d_w_gu, d_w_down,
              e_w_router, e_w_gu, e_w_down):
    B, S, D = x.shape
    L = ctx.shape[1]
    ROWS = S // GRID_W
    rows = jnp.repeat(jnp.arange(ROWS, dtype=jnp.float32), GRID_W)
    cols = jnp.tile(jnp.arange(GRID_W, dtype=jnp.float32), ROWS)
    rope_a = axial_rope_tables(rows, cols, A_HEAD_DIM)
    rope_m = axial_rope_tables(rows, cols, M_ROPE)
    sc_lat = jax.nn.silu(c)
    sc_ctx = jax.nn.silu(c_ctx)
    xl, xc = x, ctx

    for i in range(DEPTH):
        last = i == DEPTH - 1
        kind = i % N_MIXERS
        j = i // N_MIXERS
        ctx_in = (not last) or kind != 1

        mod_l = sc_lat @ w_mod[i] + b_mod[i]
        sh_m, s_m, g_m, sh_f, s_f, g_f = [t[:, None, :] for t in jnp.split(mod_l, 6, axis=-1)]
        hl = modulate(rmsnorm(xl, norm_g[i, 0]), sh_m, s_m)
        hc = None
        mc = None
        if ctx_in:
            n_c = 6 * D if not last else 2 * D
            mod_c = sc_ctx @ w_mod[i, :, :n_c] + b_mod[i, :n_c]
            mc = jnp.split(mod_c, n_c // D)
            hc = modulate(rmsnorm(xc, norm_g[i, 0]), mc[0], mc[1])

        if kind == 0:
            yc, yl = gqa_mixer(hc, hl, a_w_qkv[j], a_g_q[j], a_g_k[j], a_w_o[j], rope_a, not last)
        elif kind == 1:
            yl = fourier_mixer(hl, f_w[j])
            yc = fourier_mixer(hc, f_w[j]) if not last else None
        else:
            yc, yl = mla_mixer(hc, hl, m_w_down[j], m_g_cq[j], m_g_ckv[j], m_w_uq[j], m_w_ukv[j],
                               m_w_o[j], rope_m, not last)
        xl = xl + g_m * rmsnorm(yl, norm_g[i, 1])
        if not last:
            xc = xc + mc[2] * rmsnorm(yc, norm_g[i, 1])

        hl2 = modulate(rmsnorm(xl, norm_g[i, 2]), sh_f, s_f)
        if not last:
            hc2 = modulate(rmsnorm(xc, norm_g[i, 2]), mc[3], mc[4])
            h2 = jnp.concatenate([hc2, hl2], axis=1)
        else:
            h2 = hl2
        if i % 2 == 0:
            y2 = swiglu(h2, d_w_gu[i // 2], d_w_down[i // 2])
        else:
            y2 = moe_swiglu(h2, e_w_router[i // 2], e_w_gu[i // 2], e_w_down[i // 2])
        if not last:
            xc = xc + mc[5] * rmsnorm(y2[:, :L], norm_g[i, 3])
            yl2 = y2[:, L:]
        else:
            yl2 = y2
        xl = xl + g_f * rmsnorm(yl2, norm_g[i, 3])

    return xl
```

```cpp
#include <hip/hip_runtime.h>
#include <cstdio>
#include <cstdint>

#ifndef MK_PER_PHASE
#define MK_PER_PHASE 0
#endif

#ifndef FOURIER_FFT
#define FOURIER_FFT 1
#endif
#ifndef DBG_CHECK
#define DBG_CHECK 0
#endif
#ifndef DBG_SKIP
#define DBG_SKIP 0
#endif
#define LAS __attribute__((address_space(3)))
#define GAS __attribute__((address_space(1)))
typedef unsigned short bf16_t;
typedef short bf16x8 __attribute__((ext_vector_type(8)));
typedef float f32x4 __attribute__((ext_vector_type(4)));
typedef float f32x2 __attribute__((ext_vector_type(2)));
typedef float f32x16 __attribute__((ext_vector_type(16)));
typedef unsigned u32x4 __attribute__((ext_vector_type(4)));
typedef unsigned u32x2 __attribute__((ext_vector_type(2)));

constexpr int D = 1024, NBATCH = 8, SEQ = 4096, CTXL = 256, TPB = SEQ + CTXL, NTOK = NBATCH * TPB, NLAT = NBATCH * SEQ;
constexpr int FFD = 2816, FFE = 3584, NEXP = 8;
constexpr int MOE_ROWS = 71680;
constexpr int LIST_CAP = NTOK;
constexpr float NORM_EPS = 1e-6f;
constexpr float LOG2E = 1.4426950408889634f;
constexpr int NPHASE = 35;
constexpr int DOWN8 = 2;
constexpr int GU8 = 2;
constexpr float W8_GU = 64.0f, W8_D = 128.0f, A8_ACT = 4.0f;

constexpr size_t MiB = (size_t)1 << 20;
constexpr size_t WS_CTL = 0, CTL_ZERO_BYTES = 1 * MiB;
constexpr size_t WS_MOD = 1 * MiB;
constexpr size_t WS_TAB = 2 * MiB;
constexpr size_t WS_X = 4 * MiB;
constexpr size_t WS_H = 140 * MiB;
constexpr size_t WS_WQKV0 = 208 * MiB, WS_WQKV1 = 211 * MiB, WS_WOA0 = 214 * MiB, WS_WOA1 = 216 * MiB, WS_WFP = 218 * MiB, WS_WMD = 222 * MiB, WS_WUQ = 224 * MiB,
                 WS_WUKV = 226 * MiB, WS_WMO = 227 * MiB, WS_WDGU0 = 229 * MiB, WS_WDGU1 = 240 * MiB, WS_WDD0 = 251 * MiB, WS_WDD1 = 257 * MiB, WS_WEGU0 = 263 * MiB,
                 WS_WEGU1 = 375 * MiB, WS_WED0 = 487 * MiB, WS_WED1 = 543 * MiB, WS_TSEQ = 599 * MiB, WS_TCTX = 663 * MiB;
constexpr size_t T0 = 664 * MiB;
constexpr size_t WS_A_RAW = T0, WS_A_Q = T0 + 102 * MiB, WS_A_K = T0 + 170 * MiB, WS_A_VT = T0 + 187 * MiB, WS_A_O = T0 + 204 * MiB;
constexpr size_t WS_F_HT = T0, WS_F_U = T0 + 68 * MiB, WS_F_G1 = T0 + 204 * MiB, WS_F_G2 = T0 + 332 * MiB;
constexpr size_t WS_BD1 = WS_TAB + 65536, WS_T2BD = WS_TAB + 393216;
constexpr size_t WS_M_K8 = T0;
constexpr size_t WS_M_DM = T0, WS_M_CQ = T0 + 51 * MiB, WS_M_CKV = T0 + 77 * MiB, WS_M_KR = T0 + 94 * MiB, WS_M_Q = T0 + 97 * MiB, WS_M_KV = T0 + 199 * MiB,
                 WS_M_VT = T0 + 340 * MiB, WS_M_O = T0 + 408 * MiB;
constexpr size_t WS_Y = T0 + 476 * MiB;
constexpr size_t WS_ACT = T0, WS_Y2 = T0 + 490 * MiB, WS_LIST = T0 + 630 * MiB, WS_TOKINFO = T0 + 632 * MiB;
constexpr size_t WS_CSP = T0 + 560 * MiB;
constexpr size_t WS_MSP = 72 * MiB;
constexpr size_t WS_END = T0 + 634 * MiB;
static_assert((size_t)NTOK * 1024 * 4 == 136 * MiB && (size_t)MOE_ROWS * FFE * 2 == 490 * MiB && (size_t)MOE_ROWS * 1024 * 2 == 140 * MiB, "sizes");

constexpr int CW_BAR = 4096;
constexpr int CW_MOE = 8192;

constexpr int RING_BYTES = 131072;
constexpr int MISC_OFF = RING_BYTES + 320;
constexpr int LDS_BYTES = 147456;
constexpr int NWAVES = 8;

__device__ __forceinline__ unsigned f2bf(float f) { unsigned u = __builtin_bit_cast(unsigned, f); return (u + 0x7fffu + ((u >> 16) & 1u)) >> 16; }
typedef __bf16 bf16x2_p __attribute__((ext_vector_type(2)));
__device__ __forceinline__ unsigned pk2(float lo, float hi) { const f32x2 v = {lo, hi}; return __builtin_bit_cast(unsigned, __builtin_convertvector(v, bf16x2_p)); }
__device__ __forceinline__ float u2f(unsigned u) { return __builtin_bit_cast(float, u); }
__device__ __forceinline__ float bf2f(unsigned b) { return __builtin_bit_cast(float, b << 16); }
__device__ __forceinline__ float bflo(unsigned w) { return __builtin_bit_cast(float, w << 16); }
__device__ __forceinline__ float bfhi(unsigned w) { return __builtin_bit_cast(float, w & 0xffff0000u); }
__device__ __forceinline__ float wave_sum(float v) {
#pragma unroll
    for (int o = 1; o < 64; o <<= 1) v += __shfl_xor(v, o);
    return v;
}
__device__ __forceinline__ void unpack8(const u32x4 w, float (&v)[8]) { const unsigned a = w.x, b = w.y, c = w.z, d = w.w; v[0] = bflo(a); v[1] = bfhi(a); v[2] = bflo(b); v[3] = bfhi(b); v[4] = bflo(c); v[5] = bfhi(c); v[6] = bflo(d); v[7] = bfhi(d); }
__device__ __forceinline__ u32x4 pack8(const float (&v)[8]) { u32x4 w; w.x = pk2(v[0], v[1]); w.y = pk2(v[2], v[3]); w.z = pk2(v[4], v[5]); w.w = pk2(v[6], v[7]); return w; }
typedef int v8i __attribute__((ext_vector_type(8)));
typedef int v4i __attribute__((ext_vector_type(4)));
__device__ __forceinline__ unsigned pk_fp8x4(float a, float b, float c, float d) { int w = __builtin_amdgcn_cvt_pk_fp8_f32(a, b, 0, false); w = __builtin_amdgcn_cvt_pk_fp8_f32(c, d, w, true); return (unsigned)w; }
#define LDS_WAIT() asm volatile("s_waitcnt lgkmcnt(0)" ::: "memory")
#define RLX_AGENT __ATOMIC_RELAXED, __HIP_MEMORY_SCOPE_AGENT

namespace pg8 {
constexpr int BM = 256, BK = 64, HALF = 128, HTB = HALF * BK * 2, STAGE_BYTES = 8 * HTB, NXCD = 8, WGM = 8;
__host__ __device__ __forceinline__ int lds_byte(int r, int c) { const int st = (r >> 4) * 2 + (c >> 5), rr = r & 15, cc = c & 31, ob = rr * 64 + cc * 2; return st * 1024 + (ob ^ (((ob >> 9) & 1) << 5)); }
__host__ __device__ __forceinline__ void stage_rc(int b, int& R, int& C) { const int st = b / 1024, sb = b % 1024, swz = sb ^ (((sb >> 9) & 1) << 5); R = (st >> 1) * 16 + swz / 64; C = (st & 1) * 32 + (swz % 64) / 2; }
__host__ __device__ __forceinline__ int perm32(int rho) { const int n = rho >> 4, i = rho & 15; return 8 * (i >> 2) + 4 * n + (i & 3); }

struct Unit { const char* a; const char* b; bf16_t* c; int pm, pn, e, nt; };

struct Sched {
    int nM, nN, nB, G, c;
    const char* A; const char* Bt; bf16_t* C;
    long sAb, sBb, sCb;
    long sAm, sBn;
    int pmw; long cm1, cm2, cn;
    int moe; long sBe;
    int tend0, tend1, tend2, tend3, tend4, tend5, tend6, tend7;
    int cnt0, cnt1, cnt2, cnt3, cnt4, cnt5, cnt6, cnt7;
    const int* list; int cap;
    int nB2; long sAb2, sBb2, sCb2;
    int cs_ntl;
    int ms_full, ms_nsl, ms_kt; bf16_t* ms_P;
    int cs_nsl; bf16_t* cs_P;
    __device__ __forceinline__ void init_plain(const bf16_t* A_, long lda, const bf16_t* Bt_, long ldb, bf16_t* C_, long ldc, int M, int N, int G_, int c_) {
        nM = M / BM; nN = N / BM; nB = 1; G = G_; c = c_; A = (const char*)A_; Bt = (const char*)Bt_; C = C_; sAb = sBb = sCb = 0;
        sAm = (long)BM * lda * 2; sBn = (long)BM * ldb * 2; pmw = 1 << 30; cm1 = (long)BM * ldc; cm2 = 0; cn = BM; moe = 0; sBe = 0;
        cs_nsl = -1; cs_ntl = 4; cs_P = nullptr; ms_full = 0; ms_nsl = 1; ms_kt = 0; ms_P = nullptr; nB2 = 1; sAb2 = sBb2 = sCb2 = 0;
        tend0 = tend1 = tend2 = tend3 = tend4 = tend5 = tend6 = tend7 = 0; cnt0 = cnt1 = cnt2 = cnt3 = cnt4 = cnt5 = cnt6 = cnt7 = 0; list = nullptr; cap = 0;
    }
    __device__ __forceinline__ bool next(int i, Unit& u) const {
        u.nt = 0;
        if (cs_nsl >= 0) {
            const int L = i * G + c, NL = 128 * nN;
            if (L < NL) { int wgid = L; { const int q = NL / NXCD, xcd = wgid % NXCD, off = wgid / NXCD; wgid = xcd * q + off; }
                const int nig = WGM * nN, gid = wgid / nig, lp = gid * WGM + (wgid % nig) % WGM, pn = (wgid % nig) / WGM; const int pm = (lp >> 4) * 17 + 1 + (lp & 15);
                u.pm = pm; u.pn = pn; u.e = 0; u.a = A + (long)pm * sAm; u.b = Bt + (long)pn * sBn; u.c = C + (long)pm * cm1 + (long)pn * cn; return true; }
            const int q = L - NL; if (q >= 8 * nN * cs_nsl) return false;
            const int sl = q % cs_nsl, r = q / cs_nsl, pn = r % nN, b = r / nN, pm = b * 17;
            u.pm = pm; u.pn = pn; u.e = 0; u.nt = (sl == cs_nsl - 1) ? cs_ntl : 4; u.a = A + (long)pm * sAm + sl * 512; u.b = Bt + (long)pn * sBn + sl * 512;
            u.c = cs_P + ((long)(sl * 8 + b) * 256) * (cm1 / 256) + (long)pn * cn; return true;
        }
        const long L = (long)i * G + c; const int per = nM * nN; const long tot = (long)per * nB;
        int wgid, msl = -1;
        if (ms_nsl > 1) {
            if (L < ms_full) { wgid = (int)L; const int q = ms_full / NXCD, xcd = wgid % NXCD, off = wgid / NXCD; wgid = xcd * q + off; }
            else { const int q = (int)L - ms_full; msl = q % ms_nsl; wgid = ms_full + q / ms_nsl; if (wgid >= (int)tot) return false; }
        } else {
        if (L >= tot) return false;
        wgid = (int)L; { const int nwg = (int)tot; const int q = nwg / NXCD, r = nwg % NXCD, xcd = wgid % NXCD, off = wgid / NXCD; wgid = (xcd < r ? xcd * (q + 1) : r * (q + 1) + (xcd - r) * q) + off; }
        }
        const int b = wgid / per, w = wgid - b * per;
        const int nig = WGM * nN, gid = w / nig, fm = gid * WGM, gsz = (nM - fm) < WGM ? (nM - fm) : WGM;
        const int pm = fm + ((w % nig) % gsz), pn = (w % nig) / gsz;
        int e = 0;
        if (moe) { e = (pm >= tend0) + (pm >= tend1) + (pm >= tend2) + (pm >= tend3) + (pm >= tend4) + (pm >= tend5) + (pm >= tend6); }
        u.pm = pm; u.pn = pn; u.e = e;
        const int b1 = b / nB2, b2 = b - b1 * nB2;
        u.a = A + (long)b1 * sAb + (long)b2 * sAb2 + (long)pm * sAm;
        u.b = Bt + (long)b1 * sBb + (long)b2 * sBb2 + (long)pn * sBn + (long)e * sBe;
        u.c = C + (long)b1 * sCb + (long)b2 * sCb2 + (long)(pm % pmw) * cm1 + (long)(pm / pmw) * cm2 + (long)pn * cn;
        if (msl >= 0) { const int h = ms_kt / 2, k0 = 2 * ((h * msl) / ms_nsl), k1 = 2 * ((h * (msl + 1)) / ms_nsl);
            u.nt = k1 - k0; u.a += (long)k0 * 128; u.b += (long)k0 * 128;
            if (msl > 0) u.c = ms_P + (long)((msl - 1) * 32 + (pm - ms_full / nN)) * cm1 + (long)pn * cn; }
        return true;
    }
    __device__ __forceinline__ int gather_tok(const Unit& u, int r) const {
        const int e = u.e;
        const int ts = e == 0 ? 0 : e == 1 ? tend0 : e == 2 ? tend1 : e == 3 ? tend2 : e == 4 ? tend3 : e == 5 ? tend4 : e == 6 ? tend5 : tend6;
        const int cn_ = e == 0 ? cnt0 : e == 1 ? cnt1 : e == 2 ? cnt2 : e == 3 ? cnt3 : e == 4 ? cnt4 : e == 5 ? cnt5 : e == 6 ? cnt6 : cnt7;
        const int slot = (u.pm - ts) * 256 + r;
        return slot < cn_ ? list[(long)e * cap + slot] : 0;
    }
};

typedef __bf16 bf16x2_c __attribute__((ext_vector_type(2)));
__device__ __forceinline__ unsigned cvt_pk_bf16(float lo, float hi) { const f32x2 v = {lo, hi}; return __builtin_bit_cast(unsigned, __builtin_convertvector(v, bf16x2_c)); }

struct EpiPlain {
    static constexpr bool PERM = true;
    int ldc; float scale;
    __device__ __forceinline__ void operator()(const f32x4 (&acc)[2][2][4][2], const Unit& u, int wr, int wc, int fr, int fq) const {
        bf16_t* base = u.c + (size_t)(wr * 64 + fr) * ldc + wc * 32 + 8 * fq;
#pragma unroll
        for (int ai = 0; ai < 2; ++ai)
#pragma unroll
            for (int m = 0; m < 4; ++m) { bf16_t* rowp = base + (size_t)(ai * HALF + m * 16) * ldc;
#pragma unroll
                for (int bj = 0; bj < 2; ++bj) { const f32x4 v0 = acc[ai][bj][m][0] * scale, v1 = acc[ai][bj][m][1] * scale;
                    u32x4 w; w.x = cvt_pk_bf16(v0[0], v0[1]); w.y = cvt_pk_bf16(v0[2], v0[3]); w.z = cvt_pk_bf16(v1[0], v1[1]); w.w = cvt_pk_bf16(v1[2], v1[3]);
                    *(u32x4*)(rowp + bj * HALF) = w; } }
    }
};
struct EpiMirror {
    static constexpr bool PERM = true;
    int ldc_unused;
    __device__ __forceinline__ void operator()(const f32x4 (&acc)[2][2][4][2], const Unit& u, int wr, int wc, int fr, int fq) const {
        constexpr long LDC = 2048;
        const int kt = u.pm & 7, ri = u.pm >> 3; const unsigned sx = ri ? 0x80008000u : 0u;
        const int r0 = wr * 64 + fr;
        bf16_t* nb = u.c + (long)r0 * LDC + wc * 32 + 8 * fq;
        bf16_t* mb = u.c + (long)(4096 - 512 * kt - r0) * LDC + wc * 32 + 8 * fq;
#pragma unroll
        for (int ai = 0; ai < 2; ++ai)
#pragma unroll
            for (int m = 0; m < 4; ++m) { bf16_t* rowp = nb + (long)(ai * HALF + m * 16) * LDC; bf16_t* mirp = mb - (long)(ai * HALF + m * 16) * LDC;
                if (ai == 0 && m == 0) mirp = (kt == 0 && r0 == 0) ? rowp : mirp;
#pragma unroll
                for (int bj = 0; bj < 2; ++bj) { const f32x4 v0 = acc[ai][bj][m][0], v1 = acc[ai][bj][m][1];
                    u32x4 w; w.x = cvt_pk_bf16(v0[0], v0[1]); w.y = cvt_pk_bf16(v0[2], v0[3]); w.z = cvt_pk_bf16(v1[0], v1[1]); w.w = cvt_pk_bf16(v1[2], v1[3]);
                    *(u32x4*)(rowp + bj * HALF) = w;
                    u32x4 x; x.x = w.x ^ sx; x.y = w.y ^ sx; x.z = w.z ^ sx; x.w = w.w ^ sx;
                    *(u32x4*)(mirp + bj * HALF) = x; } }
    }
};
struct EpiFFT2 {
    static constexpr bool PERM = true;
    int unused;
    __device__ __forceinline__ void operator()(const f32x4 (&acc)[2][2][4][2], const Unit& u, int wr, int wc, int fr, int fq) const {
        constexpr long LDC = 2048;
        bf16_t* base = u.c + wr * 256 + (long)fr * 64 * LDC + wc * 32 + 8 * fq;
#pragma unroll
        for (int ai = 0; ai < 2; ++ai)
#pragma unroll
            for (int m = 0; m < 4; ++m) { bf16_t* rowp = base + (long)ai * LDC + (long)(m * 16) * 64 * LDC;
#pragma unroll
                for (int bj = 0; bj < 2; ++bj) { const f32x4 v0 = acc[ai][bj][m][0], v1 = acc[ai][bj][m][1];
                    u32x4 w; w.x = cvt_pk_bf16(v0[0], v0[1]); w.y = cvt_pk_bf16(v0[2], v0[3]); w.z = cvt_pk_bf16(v1[0], v1[1]); w.w = cvt_pk_bf16(v1[2], v1[3]);
                    *(u32x4*)(rowp + bj * HALF) = w; } }
    }
};
__device__ __forceinline__ float silu_mul(float g, float u) { return g * u * __builtin_amdgcn_rcpf(1.0f + __builtin_amdgcn_exp2f(-g * LOG2E)); }
struct EpiSwiGLU {
    static constexpr bool PERM = true;
    int ldc;
    __device__ __forceinline__ void operator()(const f32x4 (&acc)[2][2][4][2], const Unit& u, int wr, int wc, int fr, int fq) const {
        bf16_t* base = u.c + (size_t)(wr * 64 + fr) * ldc + wc * 32 + 8 * fq;
#pragma unroll
        for (int ai = 0; ai < 2; ++ai)
#pragma unroll
            for (int m = 0; m < 4; ++m) { bf16_t* rowp = base + (size_t)(ai * HALF + m * 16) * ldc;
                const f32x4 g0 = acc[ai][0][m][0], g1 = acc[ai][0][m][1], u0 = acc[ai][1][m][0], u1 = acc[ai][1][m][1];
                u32x4 w; w.x = cvt_pk_bf16(silu_mul(g0[0], u0[0]), silu_mul(g0[1], u0[1])); w.y = cvt_pk_bf16(silu_mul(g0[2], u0[2]), silu_mul(g0[3], u0[3]));
                w.z = cvt_pk_bf16(silu_mul(g1[0], u1[0]), silu_mul(g1[1], u1[1])); w.w = cvt_pk_bf16(silu_mul(g1[2], u1[2]), silu_mul(g1[3], u1[3]));
                *(u32x4*)rowp = w; }
    }
};

struct EpiSwiGLU8 {
    static constexpr bool PERM = true;
    int ldc; float sin, sout;
    __device__ __forceinline__ void operator()(const f32x4 (&acc)[2][2][4][2], const Unit& u, int wr, int wc, int fr, int fq) const {
        unsigned char* base = (unsigned char*)u.c + (size_t)(wr * 64 + fr) * ldc + wc * 32 + 8 * fq;
#pragma unroll
        for (int ai = 0; ai < 2; ++ai)
#pragma unroll
            for (int m = 0; m < 4; ++m) { unsigned char* rowp = base + (size_t)(ai * HALF + m * 16) * ldc;
                const f32x4 g0 = acc[ai][0][m][0] * sin, g1 = acc[ai][0][m][1] * sin, u0 = acc[ai][1][m][0] * sin, u1 = acc[ai][1][m][1] * sin;
                u32x2 w; w.x = pk_fp8x4(silu_mul(g0[0], u0[0]) * sout, silu_mul(g0[1], u0[1]) * sout, silu_mul(g0[2], u0[2]) * sout, silu_mul(g0[3], u0[3]) * sout);
                w.y = pk_fp8x4(silu_mul(g1[0], u1[0]) * sout, silu_mul(g1[1], u1[1]) * sout, silu_mul(g1[2], u1[2]) * sout, silu_mul(g1[3], u1[3]) * sout);
                *(u32x2*)rowp = w; }
    }
};
__device__ __forceinline__ v8i cat8(bf16x8 lo, bf16x8 hi) { const v4i a = __builtin_bit_cast(v4i, lo), b = __builtin_bit_cast(v4i, hi); return __builtin_shufflevector(a, b, 0, 1, 2, 3, 4, 5, 6, 7); }
template <class Epi, bool GATHER, bool FP8 = false>
__device__ __forceinline__ void gemm_phase(LAS unsigned char* lds, const int K, const int lda, const int ldb, const Sched& S, const Epi& E) {
    const int tid = threadIdx.x, wid = __builtin_amdgcn_readfirstlane(tid >> 6), lane = tid & 63, wr = wid >> 2, wc = wid & 3, fr = lane & 15, fq = lane >> 4;
    const int nt_def = K / BK;
    unsigned voffA[2], voffB[2]; int RA[2], CA2[2];
#pragma unroll
    for (int i = 0; i < 2; ++i) { int R, C; stage_rc(tid * 16 + i * 8192, R, C); const int Rb = Epi::PERM ? ((R & ~31) + perm32(R & 31)) : R;
        voffA[i] = (unsigned)(R * lda + C) * 2u; voffB[i] = (unsigned)(Rb * ldb + C) * 2u; RA[i] = R; CA2[i] = C * 2; }
    const size_t kstep = (size_t)(BK * 2);
    const size_t hstepA = (size_t)HALF * lda * 2, hstepB = (size_t)HALF * ldb * 2;
    const unsigned ldsw = (unsigned)wid * 1024u;
    const int aoff = lds_byte(wr * 64 + fr, fq * 8), boff = lds_byte(wc * 32 + fr, fq * 8);
    unsigned gAc[2][2], gAn[2][2];
#define PG8_SA(b, h) (((b) * 2 + (h)) * HTB)
#define PG8_SB(b, h) ((4 + (b) * 2 + (h)) * HTB)
#define PG8_STAGE(bufoff, gbase, voff) do { _Pragma("unroll") for (int _i = 0; _i < 2; ++_i) \
        __builtin_amdgcn_global_load_lds((const unsigned*)((const char*)(gbase) + (voff)[_i]), (LAS unsigned*)(lds + (bufoff) + ldsw + _i * 8192), 16, 0, 0); } while (0)
#define PG8_STAGE_A(bufoff, kbase, h, NX) do { if constexpr (GATHER) { unsigned _o[2]; _o[0] = (NX) ? gAn[h][0] : gAc[h][0]; _o[1] = (NX) ? gAn[h][1] : gAc[h][1]; PG8_STAGE(bufoff, kbase, _o); } \
        else { PG8_STAGE(bufoff, (kbase) + (h) * hstepA, voffA); } } while (0)
#define PG8_LDA(dst, b, h) do { _Pragma("unroll") for (int m = 0; m < 4; ++m) _Pragma("unroll") for (int k = 0; k < 2; ++k) dst[m][k] = *(const LAS bf16x8*)(lds + PG8_SA(b, h) + aoff + m * 2048 + k * 1024); } while (0)
#define PG8_LDB(dst, b, h) do { _Pragma("unroll") for (int n = 0; n < 2; ++n) _Pragma("unroll") for (int k = 0; k < 2; ++k) dst[n][k] = *(const LAS bf16x8*)(lds + PG8_SB(b, h) + boff + n * 2048 + k * 1024); } while (0)
#define PG8_MMA(ai, bj, At, Bt) do { __builtin_amdgcn_s_setprio(1); if constexpr (FP8) { _Pragma("unroll") for (int m = 0; m < 4; ++m) _Pragma("unroll") for (int n = 0; n < 2; ++n) \
        { const v8i _b8 = cat8(Bt[n][0], Bt[n][1]), _a8 = cat8(At[m][0], At[m][1]); asm volatile("v_mfma_f32_16x16x128_f8f6f4 %0, %1, %2, %0" : "+v"(acc[ai][bj][m][n]) : "v"(_b8), "v"(_a8)); } } \
        else { _Pragma("unroll") for (int m = 0; m < 4; ++m) _Pragma("unroll") for (int n = 0; n < 2; ++n) _Pragma("unroll") for (int k = 0; k < 2; ++k) \
        acc[ai][bj][m][n] = __builtin_amdgcn_mfma_f32_16x16x32_bf16(Bt[n][k], At[m][k], acc[ai][bj][m][n], 0, 0, 0); } __builtin_amdgcn_s_setprio(0); } while (0)
#define PG8_WAIT_V(n) asm volatile("s_waitcnt vmcnt(" #n ")" ::: "memory")
#define PG8_WAIT_L(n) asm volatile("s_waitcnt lgkmcnt(" #n ")" ::: "memory")
#define PG8_BAR __builtin_amdgcn_s_barrier()
#define PG8_SCHED __builtin_amdgcn_sched_barrier(0)
#define PG8_GATHER_OFFS(dst, un) do { _Pragma("unroll") for (int _h = 0; _h < 2; ++_h) _Pragma("unroll") for (int _i = 0; _i < 2; ++_i) { \
        const int _t = S.gather_tok(un, _h * HALF + RA[_i]); dst[_h][_i] = (unsigned)_t * (unsigned)(lda * 2) + (unsigned)CA2[_i]; } } while (0)
    Unit cur, nxt; int ui = 0;
    if (!S.next(0, cur)) return;
    f32x4 acc[2][2][4][2];
#pragma unroll
    for (int a = 0; a < 2; ++a)
#pragma unroll
        for (int b = 0; b < 2; ++b)
#pragma unroll
            for (int m = 0; m < 4; ++m)
#pragma unroll
                for (int n = 0; n < 2; ++n) acc[a][b][m][n] = (f32x4){0.f, 0.f, 0.f, 0.f};
    bf16x8 At[4][2], B0[2][2], B1[2][2];
    const char* cA = cur.a; const char* cB = cur.b;
    if constexpr (GATHER) { PG8_GATHER_OFFS(gAc, cur); _Pragma("unroll") for (int _h = 0; _h < 2; ++_h) _Pragma("unroll") for (int _i = 0; _i < 2; ++_i) gAn[_h][_i] = gAc[_h][_i]; }
    PG8_STAGE(PG8_SB(0, 0), cB, voffB); PG8_STAGE(PG8_SB(0, 1), cB + hstepB, voffB); PG8_STAGE_A(PG8_SA(0, 0), cA, 0, false); PG8_STAGE_A(PG8_SA(0, 1), cA, 1, false);
    if (wr == 1) PG8_BAR;
    PG8_WAIT_V(2); PG8_BAR;
    PG8_STAGE(PG8_SB(1, 0), cB + kstep, voffB); PG8_STAGE_A(PG8_SA(1, 0), cA + kstep, 0, false); PG8_STAGE(PG8_SB(1, 1), cB + hstepB + kstep, voffB);
    PG8_WAIT_V(6); PG8_BAR;
    for (;;) {
        const bool has_next = S.next(ui + 1, nxt);
        const char* nA = has_next ? nxt.a : cA; const char* nB = has_next ? nxt.b : cB;
        if constexpr (GATHER) { if (has_next) { PG8_GATHER_OFFS(gAn, nxt); } }
        const int nt = cur.nt ? cur.nt : nt_def;
#pragma unroll 1
        for (int t = 0; t < nt; t += 2) {
            const bool last = (t == nt - 2);
            const char* a1 = cA + (size_t)(t + 1) * kstep;
            const char* a2 = last ? nA : cA + (size_t)(t + 2) * kstep; const char* b2 = last ? nB : cB + (size_t)(t + 2) * kstep;
            const char* a3 = a2 + kstep; const char* b3 = b2 + kstep;
            PG8_LDB(B0, 0, 0); PG8_LDB(B1, 0, 1); PG8_SCHED; PG8_LDA(At, 0, 0); PG8_STAGE_A(PG8_SA(1, 1), a1, 1, false);
            PG8_WAIT_V(8); PG8_WAIT_L(0); PG8_BAR; PG8_MMA(0, 0, At, B0); PG8_MMA(0, 1, At, B1); PG8_BAR; PG8_SCHED;
            PG8_LDA(At, 0, 1); PG8_STAGE(PG8_SB(0, 0), b2, voffB); PG8_STAGE(PG8_SB(0, 1), b2 + hstepB, voffB); PG8_STAGE_A(PG8_SA(0, 0), a2, 0, last);
            PG8_WAIT_V(8); PG8_WAIT_L(0); PG8_BAR; PG8_MMA(1, 0, At, B0); PG8_MMA(1, 1, At, B1); PG8_BAR; PG8_SCHED;
            PG8_LDB(B0, 1, 0); PG8_LDB(B1, 1, 1); PG8_SCHED; PG8_LDA(At, 1, 0); PG8_STAGE_A(PG8_SA(0, 1), a2, 1, last);
            PG8_WAIT_V(8); PG8_WAIT_L(0); PG8_BAR; PG8_MMA(0, 0, At, B0); PG8_MMA(0, 1, At, B1); PG8_BAR; PG8_SCHED;
            PG8_LDA(At, 1, 1); PG8_STAGE(PG8_SB(1, 0), b3, voffB); PG8_STAGE(PG8_SB(1, 1), b3 + hstepB, voffB); PG8_STAGE_A(PG8_SA(1, 0), a3, 0, last);
            PG8_WAIT_V(8); PG8_WAIT_L(0); PG8_BAR; PG8_MMA(1, 0, At, B0); PG8_MMA(1, 1, At, B1); PG8_BAR; PG8_SCHED;
        }
        if constexpr (FP8) asm volatile("s_nop 15\n\ts_nop 15" ::: "memory");
        if (wr == 0) PG8_BAR;
        E(acc, cur, wr, wc, fr, fq);
        if (!has_next) break;
#pragma unroll
        for (int a = 0; a < 2; ++a)
#pragma unroll
            for (int b = 0; b < 2; ++b)
#pragma unroll
                for (int m = 0; m < 4; ++m)
#pragma unroll
                    for (int n = 0; n < 2; ++n) acc[a][b][m][n] = (f32x4){0.f, 0.f, 0.f, 0.f};
        cur = nxt; cA = nA; cB = nB; ++ui;
        if constexpr (GATHER) { _Pragma("unroll") for (int _h = 0; _h < 2; ++_h) _Pragma("unroll") for (int _i = 0; _i < 2; ++_i) gAc[_h][_i] = gAn[_h][_i]; }
        if (wr == 1) PG8_BAR;
    }
    PG8_WAIT_V(0);
    PG8_BAR;
#undef PG8_SA
#undef PG8_SB
#undef PG8_STAGE
#undef PG8_STAGE_A
#undef PG8_LDA
#undef PG8_LDB
#undef PG8_MMA
#undef PG8_WAIT_V
#undef PG8_WAIT_L
#undef PG8_BAR
#undef PG8_SCHED
#undef PG8_GATHER_OFFS
}
}

constexpr bool MLA_SPEC = true;
constexpr int QKV8 = 0;
constexpr bool ATT_LSUM = true;
constexpr bool ATT_PV8 = true;
constexpr bool MLA_QK8 = true;
constexpr bool ATT_QK8 = true;
#ifndef ATT_NEGM
#define ATT_NEGM false
#endif
namespace att {
__device__ __forceinline__ float add_nopk(float a, float b) { float o = a + b; asm("" : "+v"(o)); return o; }
typedef __bf16 bf16x2_t __attribute__((ext_vector_type(2)));
__device__ __forceinline__ unsigned cvt2(float lo, float hi) { const f32x2 v = {lo, hi}; return __builtin_bit_cast(unsigned, __builtin_convertvector(v, bf16x2_t)); }
template <int DK, int NQ, bool NOREF = false>
__device__ __forceinline__ bool unit(LAS unsigned char* lds, const bf16_t* Qp, int qpitch, const bf16_t* Kp, int kpitch, const bf16_t* Vtp, int vtpitch, bf16_t* Op, int opitch, int ntiles, int nrows,
                                     const float* qgain = nullptr, const float* qtab = nullptr, int qpos0 = -1) {
    constexpr bool QK8 = ATT_QK8 && (DK == 64 || (DK == 96 && MLA_QK8));
    constexpr bool PV8 = QK8 && ATT_PV8;
    constexpr int NKC = QK8 ? DK / 16 : DK / 8, KBUF = NKC * 1024, VBUF = PV8 ? 4096 : 8192, ND0 = DK / 16;
    const int tid = threadIdx.x, lane = tid & 63, r = lane & 31, h = lane >> 5; const int wid = __builtin_amdgcn_readfirstlane(tid >> 6);
    LAS unsigned char* Kb = lds; LAS unsigned char* Vb = lds + 2 * KBUF;
    bf16x8 qf[NQ][ND0]; v8i qf8[NQ], qf8b[NQ];
#pragma unroll
    for (int j = 0; j < NQ; ++j) { qf8[j] = (v8i){0, 0, 0, 0, 0, 0, 0, 0}; qf8b[j] = (v8i){0, 0, 0, 0, 0, 0, 0, 0}; }
#pragma unroll
    for (int j = 0; j < NQ; ++j) { const bf16_t* qrow = Qp + (size_t)(wid * (32 * NQ) + j * 32 + r) * qpitch + h * 8;
#pragma unroll
      for (int d0 = 0; d0 < ND0; ++d0) qf[j][d0] = *(const bf16x8*)(qrow + d0 * 16); }
    if constexpr (DK == 64) { if (qgain != nullptr) {
        float g[4][8];
#pragma unroll
        for (int d0 = 0; d0 < 4; ++d0) { const f32x4 g0 = *(const f32x4*)(qgain + 16 * d0 + 8 * h), g1 = *(const f32x4*)(qgain + 16 * d0 + 8 * h + 4);
#pragma unroll
            for (int i = 0; i < 4; ++i) { g[d0][i] = g0[i]; g[d0][4 + i] = g1[i]; } }
#pragma unroll
        for (int j = 0; j < NQ; ++j) {
            float x[4][8]; float ss = 0.f;
#pragma unroll
            for (int d0 = 0; d0 < 4; ++d0) { unpack8(__builtin_bit_cast(u32x4, qf[j][d0]), x[d0]);
#pragma unroll
                for (int i = 0; i < 8; ++i) ss += x[d0][i] * x[d0][i]; }
            ss += __shfl_xor(ss, 32);
            const float rs = (1.0f / sqrtf(ss * (1.0f / 64.0f) + NORM_EPS)) * (0.125f * LOG2E);
#pragma unroll
            for (int d0 = 0; d0 < 4; ++d0)
#pragma unroll
                for (int i = 0; i < 8; ++i) x[d0][i] *= rs * g[d0][i];
            if (qpos0 >= 0) { const int sp = qpos0 + wid * (32 * NQ) + j * 32 + r;
#pragma unroll
                for (int part = 0; part < 2; ++part) { const int pp = part ? (sp & 63) : (sp >> 6); const float* tc = qtab + pp * 16 + 8 * h;
                    const f32x4 c0 = *(const f32x4*)tc, c1 = *(const f32x4*)(tc + 4), s0 = *(const f32x4*)(tc + 1024), s1 = *(const f32x4*)(tc + 1028);
#pragma unroll
                    for (int i = 0; i < 8; ++i) { const float cs = i < 4 ? c0[i & 3] : c1[i & 3], sn = i < 4 ? s0[i & 3] : s1[i & 3];
                        const float x1 = x[2 * part][i], x2 = x[2 * part + 1][i]; x[2 * part][i] = x1 * cs - x2 * sn; x[2 * part + 1][i] = x2 * cs + x1 * sn; } } }
#pragma unroll
            for (int d0 = 0; d0 < 4; ++d0) qf[j][d0] = __builtin_bit_cast(bf16x8, pack8(x[d0]));
            if constexpr (QK8) { qf8[j] = (v8i){(int)pk_fp8x4(x[0][0], x[0][1], x[0][2], x[0][3]), (int)pk_fp8x4(x[0][4], x[0][5], x[0][6], x[0][7]), (int)pk_fp8x4(x[1][0], x[1][1], x[1][2], x[1][3]), (int)pk_fp8x4(x[1][4], x[1][5], x[1][6], x[1][7]),
                                               (int)pk_fp8x4(x[2][0], x[2][1], x[2][2], x[2][3]), (int)pk_fp8x4(x[2][4], x[2][5], x[2][6], x[2][7]), (int)pk_fp8x4(x[3][0], x[3][1], x[3][2], x[3][3]), (int)pk_fp8x4(x[3][4], x[3][5], x[3][6], x[3][7])}; }
        } } }
    if constexpr (DK == 96) { if (qtab != nullptr) {
        const float C2m = 0.10206207261596577f * LOG2E;
#pragma unroll
        for (int j = 0; j < NQ; ++j) {
            float x[6][8];
#pragma unroll
            for (int d0 = 0; d0 < 6; ++d0) unpack8(__builtin_bit_cast(u32x4, qf[j][d0]), x[d0]);
            if (qpos0 >= 0) { const int sp = qpos0 + wid * (32 * NQ) + j * 32 + r;
#pragma unroll
                for (int part = 0; part < 2; ++part) { const int pp = part ? (sp & 63) : (sp >> 6); const float* tc = qtab + 2048 + pp * 8;
                    const f32x4 c0 = *(const f32x4*)tc, c1 = *(const f32x4*)(tc + 4), s0 = *(const f32x4*)(tc + 512), s1 = *(const f32x4*)(tc + 516);
#pragma unroll
                    for (int i = 0; i < 8; ++i) { const float cs = i < 4 ? c0[i & 3] : c1[i & 3], sn = i < 4 ? s0[i & 3] : s1[i & 3];
                        const float xv = x[4 + part][i], pr = __shfl_xor(xv, 32);
                        x[4 + part][i] = h ? (xv * cs + pr * sn) : (xv * cs - pr * sn); } } }
#pragma unroll
            for (int d0 = 0; d0 < 6; ++d0) {
#pragma unroll
                for (int i = 0; i < 8; ++i) x[d0][i] *= C2m;
                qf[j][d0] = __builtin_bit_cast(bf16x8, pack8(x[d0])); }
            if constexpr (QK8) { qf8[j] = (v8i){(int)pk_fp8x4(x[0][0], x[0][1], x[0][2], x[0][3]), (int)pk_fp8x4(x[0][4], x[0][5], x[0][6], x[0][7]), (int)pk_fp8x4(x[1][0], x[1][1], x[1][2], x[1][3]), (int)pk_fp8x4(x[1][4], x[1][5], x[1][6], x[1][7]),
                                               (int)pk_fp8x4(x[2][0], x[2][1], x[2][2], x[2][3]), (int)pk_fp8x4(x[2][4], x[2][5], x[2][6], x[2][7]), (int)pk_fp8x4(x[3][0], x[3][1], x[3][2], x[3][3]), (int)pk_fp8x4(x[3][4], x[3][5], x[3][6], x[3][7])};
                                 qf8b[j] = (v8i){(int)pk_fp8x4(x[4][0], x[4][1], x[4][2], x[4][3]), (int)pk_fp8x4(x[4][4], x[4][5], x[4][6], x[4][7]), (int)pk_fp8x4(x[5][0], x[5][1], x[5][2], x[5][3]), (int)pk_fp8x4(x[5][4], x[5][5], x[5][6], x[5][7]), 0, 0, 0, 0}; }
        } } }
    const bf16_t* kg0 = Kp + (size_t)lane * kpitch + wid * 8; const bf16_t* kg1 = kg0 + 64; const bf16_t* vg = Vtp + (size_t)lane * vtpitch + wid * 8;
    const bool k1 = wid < NKC, k2 = (wid + 8) < NKC;
    const char* vg8 = (const char*)Vtp + (size_t)lane * (vtpitch * 2) + (wid & 3) * 16;
#define ATT_DMA(t, slot) do { if (k1) __builtin_amdgcn_global_load_lds((const unsigned*)(kg0 + (size_t)(t) * 64 * kpitch), (LAS unsigned*)(Kb + (slot) * KBUF + wid * 1024), 16, 0, 0); \
        if (k2) __builtin_amdgcn_global_load_lds((const unsigned*)(kg1 + (size_t)(t) * 64 * kpitch), (LAS unsigned*)(Kb + (slot) * KBUF + (wid + 8) * 1024), 16, 0, 0); \
        if constexpr (PV8) { if (wid >= 4) __builtin_amdgcn_global_load_lds((const unsigned*)(vg8 + (size_t)(t) * 64), (LAS unsigned*)(Vb + (slot) * VBUF + (wid - 4) * 1024), 16, 0, 0); } \
        else __builtin_amdgcn_global_load_lds((const unsigned*)(vg + (t) * 64), (LAS unsigned*)(Vb + (slot) * VBUF + wid * 1024), 16, 0, 0); } while (0)
    ATT_DMA(0, 0);
    __syncthreads();
    const int prow = (r & ~12) | ((r & 4) << 1) | ((r & 8) >> 1);
    const int koff = h * 1024 + prow * 16, voff = h * 1024 + r * 16;
    constexpr bool PVSHARE = (DK == 64) || (NQ == 1) || NOREF;
    constexpr bool NEGM = (NQ == 1);
    f32x16 o0[NQ], o1[NQ], negm[NEGM ? NQ : 1]; float mref[NQ], lrun[NQ];
    negm[0] = f32x16{};
#pragma unroll
    for (int j = 0; j < NQ; ++j) { o0[j] = f32x16{}; o1[j] = f32x16{}; mref[j] = 0.f; lrun[j] = 0.f; if constexpr (NEGM) negm[j] = f32x16{}; }
    constexpr float THR = 8.0f;
    constexpr bool LSUM = NOREF && PV8 && ATT_LSUM;
    f32x16 lacc[NQ];
#pragma unroll
    for (int j = 0; j < NQ; ++j) lacc[j] = f32x16{};
    v8i ones8 = {0x38383838, 0x38383838, 0x38383838, 0x38383838, 0x38383838, 0x38383838, 0x38383838, 0x38383838};
    if constexpr (LSUM) asm volatile("" : "+v"(ones8));
    for (int t = 0; t < ntiles; ++t) {
        const int cur = t & 1; const bool more = (t + 1 < ntiles);
        if constexpr (!NOREF && !QK8) {
#pragma unroll
        for (int j = 0; j < NQ; ++j)
#pragma unroll
            for (int d0 = 0; d0 < ND0; ++d0) asm volatile("" : "+v"(qf[j][d0]));
        }
        if (more) ATT_DMA(t + 1, cur ^ 1);
        const LAS unsigned char* kb = Kb + cur * KBUF + koff; const LAS unsigned char* vb = Vb + cur * VBUF + voff;
        f32x16 p0[NQ], p1[NQ];
#pragma unroll
        for (int j = 0; j < NQ; ++j) { if constexpr (NEGM) { p0[j] = negm[j]; p1[j] = negm[j]; } else { p0[j] = f32x16{}; p1[j] = f32x16{}; } }
        constexpr bool QKSEQ = false, PINST = false;
        if constexpr (QK8) {
            const LAS unsigned char* k8 = Kb + cur * KBUF + h * 2048 + prow * 16;
            const v8i a0 = pg8::cat8(*(const LAS bf16x8*)(k8), *(const LAS bf16x8*)(k8 + 1024)), a1 = pg8::cat8(*(const LAS bf16x8*)(k8 + 512), *(const LAS bf16x8*)(k8 + 1024 + 512));
#pragma unroll
            for (int j = 0; j < NQ; ++j) {
                if constexpr (PV8) {
                asm volatile("v_mfma_f32_32x32x64_f8f6f4 %0, %1, %2, -4.0" : "=&v"(p0[j]) : "v"(a0), "v"(qf8[j]));
                asm volatile("v_mfma_f32_32x32x64_f8f6f4 %0, %1, %2, -4.0" : "=&v"(p1[j]) : "v"(a1), "v"(qf8[j])); } else {
                asm volatile("v_mfma_f32_32x32x64_f8f6f4 %0, %1, %2, 0" : "=&v"(p0[j]) : "v"(a0), "v"(qf8[j]));
                asm volatile("v_mfma_f32_32x32x64_f8f6f4 %0, %1, %2, 0" : "=&v"(p1[j]) : "v"(a1), "v"(qf8[j])); } }
            if constexpr (DK == 96) {
                const bf16x8 z8 = bf16x8{};
                const v8i b0 = pg8::cat8(*(const LAS bf16x8*)(Kb + cur * KBUF + (4 + h) * 1024 + prow * 16), z8), b1 = pg8::cat8(*(const LAS bf16x8*)(Kb + cur * KBUF + (4 + h) * 1024 + prow * 16 + 512), z8);
#pragma unroll
                for (int j = 0; j < NQ; ++j) {
                    asm volatile("v_mfma_f32_32x32x64_f8f6f4 %0, %1, %2, %0" : "+v"(p0[j]) : "v"(b0), "v"(qf8b[j]));
                    asm volatile("v_mfma_f32_32x32x64_f8f6f4 %0, %1, %2, %0" : "+v"(p1[j]) : "v"(b1), "v"(qf8b[j])); } }
            static_assert(!QK8 || NQ == 2, "QK8 assumes two query blocks");
            asm volatile("s_nop 15\n\ts_nop 7" : "+v"(p0[0]), "+v"(p1[0]), "+v"(p0[NQ - 1]), "+v"(p1[NQ - 1]));
        } else
        if constexpr (!QKSEQ) {
#pragma unroll
        for (int d0 = 0; d0 < ND0; ++d0) { const bf16x8 a0 = *(const LAS bf16x8*)(kb + d0 * 2048), a1 = *(const LAS bf16x8*)(kb + d0 * 2048 + 512);
#pragma unroll
            for (int j = 0; j < NQ; ++j) { p0[j] = __builtin_amdgcn_mfma_f32_32x32x16_bf16(a0, qf[j][d0], p0[j], 0, 0, 0); p1[j] = __builtin_amdgcn_mfma_f32_32x32x16_bf16(a1, qf[j][d0], p1[j], 0, 0, 0); } }
        }
        if constexpr (PINST) __builtin_amdgcn_sched_barrier(0);
        bf16x8 pb[NQ][4]; v8i p8[NQ];
#pragma unroll
        for (int j = 0; j < NQ; ++j) {
            if constexpr (QKSEQ) { asm volatile("" ::: "memory");
#pragma unroll
                for (int d0 = 0; d0 < ND0; ++d0) { const bf16x8 a0 = *(const LAS bf16x8*)(kb + d0 * 2048), a1 = *(const LAS bf16x8*)(kb + d0 * 2048 + 512);
                    p0[j] = __builtin_amdgcn_mfma_f32_32x32x16_bf16(a0, qf[j][d0], p0[j], 0, 0, 0); p1[j] = __builtin_amdgcn_mfma_f32_32x32x16_bf16(a1, qf[j][d0], p1[j], 0, 0, 0); } }
            if constexpr (!NOREF) {
            float mx = fmaxf(fmaxf(p0[j][0], p0[j][1]), p1[j][0]);
#pragma unroll
            for (int i = 2; i < 16; i += 2) mx = fmaxf(fmaxf(mx, p0[j][i]), p0[j][i + 1]);
#pragma unroll
            for (int i = 1; i < 15; i += 2) mx = fmaxf(fmaxf(mx, p1[j][i]), p1[j][i + 1]);
            mx = fmaxf(mx, p1[j][15]);
            mx = fmaxf(mx, __shfl_xor(mx, 32));
            if constexpr (!NEGM) mx -= mref[j];
            if (t == 0 || __any(mx > THR)) {
                const float dl = (t == 0) ? mx : fmaxf(mx, 0.f); const float f = __builtin_amdgcn_exp2f(-dl);
                mref[j] += dl; lrun[j] *= f;
#pragma unroll
                for (int i = 0; i < 16; ++i) { o0[j][i] *= f; o1[j][i] *= f; }
                if constexpr (NEGM) {
#pragma unroll
                    for (int i = 0; i < 16; ++i) { p0[j][i] -= dl; p1[j][i] -= dl; negm[j][i] = -mref[j]; } }
            }
            }
            const float sub = NEGM ? 0.f : mref[j];
            float ls = lrun[j];
            if constexpr (LSUM) {
#pragma unroll
            for (int i = 0; i < 16; ++i) { p0[j][i] = __builtin_amdgcn_exp2f(p0[j][i]); p1[j][i] = __builtin_amdgcn_exp2f(p1[j][i]); }
            } else {
#pragma unroll
            for (int i = 0; i < 16; ++i) { p0[j][i] = __builtin_amdgcn_exp2f((NEGM || NOREF) ? p0[j][i] : p0[j][i] - sub); ls = add_nopk(ls, p0[j][i]); }
#pragma unroll
            for (int i = 0; i < 16; ++i) { p1[j][i] = __builtin_amdgcn_exp2f((NEGM || NOREF) ? p1[j][i] : p1[j][i] - sub); ls = add_nopk(ls, p1[j][i]); }
            }
            lrun[j] = ls;
            if constexpr (PINST) { asm volatile("" : "+v"(lrun[j])); __builtin_amdgcn_sched_barrier(0); }
            if constexpr (PV8) {
                int w_[8];
#pragma unroll
                for (int q = 0; q < 4; ++q) { int t0 = __builtin_amdgcn_cvt_pk_bf8_f32(p0[j][4 * q], p0[j][4 * q + 1], 0, false); w_[q] = __builtin_amdgcn_cvt_pk_bf8_f32(p0[j][4 * q + 2], p0[j][4 * q + 3], t0, true);
                                              int t1 = __builtin_amdgcn_cvt_pk_bf8_f32(p1[j][4 * q], p1[j][4 * q + 1], 0, false); w_[4 + q] = __builtin_amdgcn_cvt_pk_bf8_f32(p1[j][4 * q + 2], p1[j][4 * q + 3], t1, true); }
                p8[j] = (v8i){w_[0], w_[1], w_[2], w_[3], w_[4], w_[5], w_[6], w_[7]};
            } else {
#pragma unroll
            for (int s = 0; s < 4; ++s) { u32x4 pw;
                if (s < 2) { pw.x = cvt2(p0[j][8 * s + 0], p0[j][8 * s + 1]); pw.y = cvt2(p0[j][8 * s + 2], p0[j][8 * s + 3]); pw.z = cvt2(p0[j][8 * s + 4], p0[j][8 * s + 5]); pw.w = cvt2(p0[j][8 * s + 6], p0[j][8 * s + 7]); }
                else { const int q = s - 2; pw.x = cvt2(p1[j][8 * q + 0], p1[j][8 * q + 1]); pw.y = cvt2(p1[j][8 * q + 2], p1[j][8 * q + 3]); pw.z = cvt2(p1[j][8 * q + 4], p1[j][8 * q + 5]); pw.w = cvt2(p1[j][8 * q + 6], p1[j][8 * q + 7]); }
                pb[j][s] = __builtin_bit_cast(bf16x8, pw); }
            }
            if constexpr (PINST) __builtin_amdgcn_sched_barrier(0);
            if constexpr (!PVSHARE && !PV8) {
#pragma unroll
                for (int s = 0; s < 4; ++s) { const bf16x8 v0 = *(const LAS bf16x8*)(vb + s * 2048), v1 = *(const LAS bf16x8*)(vb + s * 2048 + 512);
                    o0[j] = __builtin_amdgcn_mfma_f32_32x32x16_bf16(v0, pb[j][s], o0[j], 0, 0, 0); o1[j] = __builtin_amdgcn_mfma_f32_32x32x16_bf16(v1, pb[j][s], o1[j], 0, 0, 0); }
                if constexpr (NOREF) __builtin_amdgcn_sched_barrier(0); }
        }
        if constexpr (PV8) {
            const LAS unsigned char* v8 = Vb + cur * VBUF + h * 2048 + r * 16;
            const v8i va = pg8::cat8(*(const LAS bf16x8*)(v8), *(const LAS bf16x8*)(v8 + 1024)), vb1 = pg8::cat8(*(const LAS bf16x8*)(v8 + 512), *(const LAS bf16x8*)(v8 + 1024 + 512));
#pragma unroll
            for (int j = 0; j < NQ; ++j) {
                asm volatile("s_nop 1\n\tv_mfma_f32_32x32x64_f8f6f4 %0, %1, %2, %0 cbsz:0 blgp:1" : "+v"(o0[j]) : "v"(va), "v"(p8[j]));
                asm volatile("v_mfma_f32_32x32x64_f8f6f4 %0, %1, %2, %0 cbsz:0 blgp:1" : "+v"(o1[j]) : "v"(vb1), "v"(p8[j]));
                if constexpr (LSUM) asm volatile("s_nop 1\n\tv_mfma_f32_32x32x64_f8f6f4 %0, %1, %2, %0 cbsz:0 blgp:1" : "+v"(lacc[j]) : "v"(ones8), "v"(p8[j])); }
        } else
        if constexpr (PVSHARE) {
#pragma unroll
        for (int s = 0; s < 4; ++s) {
            const bf16x8 v0 = *(const LAS bf16x8*)(vb + s * 2048), v1 = *(const LAS bf16x8*)(vb + s * 2048 + 512);
#pragma unroll
            for (int j = 0; j < NQ; ++j) { o0[j] = __builtin_amdgcn_mfma_f32_32x32x16_bf16(v0, pb[j][s], o0[j], 0, 0, 0); o1[j] = __builtin_amdgcn_mfma_f32_32x32x16_bf16(v1, pb[j][s], o1[j], 0, 0, 0); }
        }
        }
        __syncthreads();
    }
#undef ATT_DMA
    if constexpr (LSUM) asm volatile("s_nop 15\n\ts_nop 7" : "+v"(lacc[0]), "+v"(lacc[NQ - 1]) : "v"(ones8));
    if constexpr (PV8) asm volatile("s_nop 15\n\ts_nop 7" : "+v"(o0[0]), "+v"(o1[0]), "+v"(o0[NQ - 1]), "+v"(o1[NQ - 1]));
    if constexpr (NOREF && DK == 96) { int bad = 0;
#pragma unroll
        for (int j = 0; j < NQ; ++j) { const int qr = wid * (32 * NQ) + j * 32 + r; const float ltot = LSUM ? lacc[j][0] : lrun[j] + __shfl_xor(lrun[j], 32);
            if (qr < nrows && !(ltot >= 8.7e-19f && ltot <= (PV8 ? 3.2e4f : 1.2e30f))) bad = 1; }
        if (__syncthreads_or(bad)) return false; }
#pragma unroll
    for (int j = 0; j < NQ; ++j) {
        const int qr = wid * (32 * NQ) + j * 32 + r;
        const float ltot = LSUM ? lacc[j][0] : lrun[j] + __shfl_xor(lrun[j], 32); const float inv = 1.0f / ltot;
        if (qr < nrows) {
            bf16_t* orow = Op + (size_t)qr * opitch + 4 * h;
#pragma unroll
            for (int g = 0; g < 4; ++g) {
                u32x2 w0, w1; w0.x = pk2(o0[j][4 * g] * inv, o0[j][4 * g + 1] * inv); w0.y = pk2(o0[j][4 * g + 2] * inv, o0[j][4 * g + 3] * inv);
                w1.x = pk2(o1[j][4 * g] * inv, o1[j][4 * g + 1] * inv); w1.y = pk2(o1[j][4 * g + 2] * inv, o1[j][4 * g + 3] * inv);
                *(u32x2*)(orow + 8 * g) = w0; *(u32x2*)(orow + 32 + 8 * g) = w1;
            }
        }
    }
    return true;
}
}

#define XB_TMO      128
#define XB_XCNT(j)  (256  + 64 * (j))
#define XB_XSUB(j)  (1280 + 64 * (j))
#define XB_XGEN(j)  (2304 + 64 * (j))
#define XB_TOP      3328
#define XB_TOPGEN   3392
#define XCD_BAR_WORDS 3456
#define XB_SPIN_CAP (1u << 22)
__device__ __forceinline__ unsigned xb_ld(unsigned* p)              { return __hip_atomic_load(p, __ATOMIC_RELAXED, __HIP_MEMORY_SCOPE_AGENT); }
__device__ __forceinline__ unsigned xb_add(unsigned* p, unsigned v) { return __hip_atomic_fetch_add(p, v, __ATOMIC_RELAXED, __HIP_MEMORY_SCOPE_AGENT); }
__device__ __forceinline__ unsigned xb_xcc_id() { return (unsigned)__builtin_amdgcn_s_getreg((3 << 11) | 20) & 0xFu; }
#define XB_SPIN(cond, bar) do { unsigned _sp = 0; while (cond) { __builtin_amdgcn_s_sleep(1); \
    if ((++_sp & 255u) == 0u) { if (xb_ld(&(bar)[XB_TMO])) break; if (_sp > XB_SPIN_CAP) { atomicAdd(&(bar)[XB_TMO], 1u); break; } } } } while (0)
struct XcdBarrier { unsigned* bar; unsigned x; volatile LAS unsigned* st; };
__device__ __forceinline__ XcdBarrier xcd_barrier_post(unsigned* bar, volatile LAS unsigned* st) {
    XcdBarrier b; b.bar = bar; b.x = xb_xcc_id(); b.st = st;
    if (threadIdx.x == 0) (void)xb_add(&bar[XB_XCNT(b.x)], 1u);
    return b;
}
__device__ __forceinline__ void xcd_barrier_complete(unsigned* bar, unsigned x, unsigned& nloc, unsigned& nx) {
    const unsigned G = gridDim.x * gridDim.y * gridDim.z;
    unsigned sum, cnt, mine, sp = 0u;
    for (;;) {
        sum = 0u; cnt = 0u; mine = 0u;
#pragma unroll
        for (unsigned j = 0; j < 16; ++j) { const unsigned c = xb_ld(&bar[XB_XCNT(j)]); sum += c; cnt += (c > 0u) ? 1u : 0u; mine = (j == x) ? c : mine; }
        if (sum == G) break;
        __builtin_amdgcn_s_sleep(1);
        if ((++sp & 255u) == 0u) { if (xb_ld(&bar[XB_TMO])) break; if (sp > XB_SPIN_CAP) { atomicAdd(&bar[XB_TMO], 1u); break; } }
    }
    nloc = mine > 0u ? mine : 1u; nx = cnt > 0u ? cnt : 1u;
}
__device__ __forceinline__ void xcd_barrier(const XcdBarrier& b) {
    asm volatile("s_waitcnt vmcnt(0)" ::: "memory");
    __syncthreads();
    if (threadIdx.x == 0) {
        unsigned* bar = b.bar;
        __builtin_amdgcn_s_waitcnt(0);
        unsigned nloc = b.st[0], nx = b.st[1];
        if (nloc == 0u) { xcd_barrier_complete(bar, b.x, nloc, nx); b.st[0] = nloc; b.st[1] = nx; }
        const unsigned old = xb_add(&bar[XB_XSUB(b.x)], 1u);
        const unsigned gen = old / nloc;
        if (old + 1u == (gen + 1u) * nloc) {
            __builtin_amdgcn_fence(__ATOMIC_RELEASE, "agent");
            asm volatile("s_waitcnt vmcnt(0)" ::: "memory");
            const unsigned og = xb_add(&bar[XB_TOP], 1u);
            const unsigned tg = og / nx;
            if (og + 1u == (tg + 1u) * nx) xb_add(&bar[XB_TOPGEN], 1u);
            else XB_SPIN(xb_ld(&bar[XB_TOPGEN]) == tg, bar);
            __builtin_amdgcn_fence(__ATOMIC_ACQUIRE, "agent");
            xb_add(&bar[XB_XGEN(b.x)], 1u);
            asm volatile("s_waitcnt vmcnt(0)" ::: "memory");
        } else {
            XB_SPIN(xb_ld(&bar[XB_XGEN(b.x)]) == gen, bar);
            __builtin_amdgcn_fence(__ATOMIC_ACQUIRE, "agent");
            asm volatile("s_waitcnt vmcnt(0)" ::: "memory");
        }
    }
    __syncthreads();
}

struct Frame {
    LAS unsigned char* lds;
    unsigned* ctl;
    unsigned char* ws;
    int tid, lane, wave, vcu, G, bx;
    const float* in[23];
    float* out;
};
#define WSP(T, off) ((T*)(F.ws + (off)))

struct Row { f32x4 v[4]; };
__device__ __forceinline__ Row ld_row_f32(const float* p, int lane) { Row r; const f32x4* q = (const f32x4*)p + lane;
#pragma unroll
    for (int j = 0; j < 4; ++j) r.v[j] = q[64 * j]; return r; }
__device__ __forceinline__ Row ld_row_f32_nt(const float* p, int lane) { Row r; const f32x4* q = (const f32x4*)p + lane;
#pragma unroll
    for (int j = 0; j < 4; ++j) r.v[j] = __builtin_nontemporal_load(q + 64 * j); return r; }
__device__ __forceinline__ void st_row_f32(float* p, int lane, const Row& r) { f32x4* q = (f32x4*)p + lane;
#pragma unroll
    for (int j = 0; j < 4; ++j) __builtin_nontemporal_store(r.v[j], q + 64 * j); }
__device__ __forceinline__ Row ld_row_bf16(const bf16_t* p, int lane) { Row r; const u32x2* q = (const u32x2*)p + lane;
#pragma unroll
    for (int j = 0; j < 4; ++j) { const u32x2 w = q[64 * j]; r.v[j] = (f32x4){bflo(w.x), bfhi(w.x), bflo(w.y), bfhi(w.y)}; } return r; }
__device__ __forceinline__ void st_row_bf16(bf16_t* p, int lane, const Row& r) { u32x2* q = (u32x2*)p + lane;
#pragma unroll
    for (int j = 0; j < 4; ++j) { u32x2 w; w.x = pk2(r.v[j][0], r.v[j][1]); w.y = pk2(r.v[j][2], r.v[j][3]); __builtin_nontemporal_store(w, q + 64 * j); } }
__device__ __forceinline__ float row_rstd(const Row& r) { float s = 0.f;
#pragma unroll
    for (int j = 0; j < 4; ++j) s += (r.v[j][0] * r.v[j][0] + r.v[j][1] * r.v[j][1]) + (r.v[j][2] * r.v[j][2] + r.v[j][3] * r.v[j][3]);
    return 1.0f / sqrtf(wave_sum(s) * (1.0f / D) + NORM_EPS); }
__device__ __forceinline__ Row modnorm(const Row& x, const float* g, const float* shift, const float* scale, int lane) {
    const float rs = row_rstd(x); const Row G = ld_row_f32(g, lane), SH = ld_row_f32(shift, lane), SC = ld_row_f32(scale, lane); Row h;
#pragma unroll
    for (int j = 0; j < 4; ++j) h.v[j] = (x.v[j] * rs * G.v[j]) * (1.0f + SC.v[j]) + SH.v[j];
    return h; }
__device__ __forceinline__ Row resid(const Row& x, const Row& y, const float* g, const float* gate, int lane) {
    const float rs = row_rstd(y); const Row G = ld_row_f32(g, lane), GT = ld_row_f32(gate, lane); Row o;
#pragma unroll
    for (int j = 0; j < 4; ++j) o.v[j] = x.v[j] + GT.v[j] * (y.v[j] * rs * G.v[j]);
    return o; }
__device__ __forceinline__ const float* modp(Frame& F, int layer, int mrow, int chunk) { return WSP(const float, WS_MOD) + ((size_t)(layer * 9 + mrow) * 6 + chunk) * D; }
__device__ __forceinline__ const float* normg(Frame& F, int layer, int k) { return F.in[6] + (size_t)(layer * 4 + k) * D; }

__device__ __forceinline__ void cvt_tile(const float* src, size_t ldsrc, bf16_t* dst, size_t lddst, int lane) {
    const int kg = lane >> 3, ng = lane & 7;
    const float* p = src + (size_t)(8 * kg) * ldsrc + 4 * ng;
    f32x4 v[8];
#pragma unroll
    for (int j = 0; j < 8; ++j) v[j] = *(const f32x4*)(p + (size_t)j * ldsrc);
    bf16_t* o = dst + (size_t)(4 * ng) * lddst + 8 * kg;
#pragma unroll
    for (int q = 0; q < 4; ++q) { u32x4 w; w.x = pk2(v[0][q], v[1][q]); w.y = pk2(v[2][q], v[3][q]); w.z = pk2(v[4][q], v[5][q]); w.w = pk2(v[6][q], v[7][q]); *(u32x4*)(o + (size_t)q * lddst) = w; }
}
template <bool GU>
__device__ __forceinline__ void cvt_matrix(const float* W, int K, int N, bf16_t* WT, int gw, int NGW, int lane) {
    const int nblk = N / 32, nitem = (K / 64) * nblk, FF = N / 2;
    for (int it = gw; it < nitem; it += NGW) {
        const int kb = it / nblk, nb = it % nblk, k0 = 64 * kb, n0 = 32 * nb;
        int drow = n0;
        if (GU) { const int half = n0 >= FF ? 1 : 0, n1 = n0 - half * FF; drow = 256 * (n1 / 128) + 128 * half + (n1 % 128); }
        cvt_tile(W + (size_t)k0 * N + n0, (size_t)N, WT + (size_t)drow * K + k0, (size_t)K, lane);
    }
}
__device__ __forceinline__ void cvt_tile8(const float* src, size_t ldsrc, unsigned char* dst, size_t lddst, float sc, int lane) {
    const int kg = lane >> 3, ng = lane & 7;
    const float* p = src + (size_t)(16 * kg) * ldsrc + 4 * ng;
    f32x4 v[16];
#pragma unroll
    for (int j = 0; j < 16; ++j) v[j] = *(const f32x4*)(p + (size_t)j * ldsrc);
    unsigned char* o = dst + (size_t)(4 * ng) * lddst + 16 * kg;
#pragma unroll
    for (int q = 0; q < 4; ++q) { u32x4 w;
        w.x = pk_fp8x4(v[0][q] * sc, v[1][q] * sc, v[2][q] * sc, v[3][q] * sc); w.y = pk_fp8x4(v[4][q] * sc, v[5][q] * sc, v[6][q] * sc, v[7][q] * sc);
        w.z = pk_fp8x4(v[8][q] * sc, v[9][q] * sc, v[10][q] * sc, v[11][q] * sc); w.w = pk_fp8x4(v[12][q] * sc, v[13][q] * sc, v[14][q] * sc, v[15][q] * sc);
        *(u32x4*)(o + (size_t)q * lddst) = w; }
}
template <bool GU>
__device__ __forceinline__ void cvt_matrix8(const float* W, int K, int N, unsigned char* WT, float sc, int nmat, int gw, int NGW, int lane) {
    const int nblk = N / 32, per = (K / 128) * nblk, nitem = per * nmat, FF = N / 2;
    for (int it = gw; it < nitem; it += NGW) {
        const int m = it / per, r = it - m * per, kb = r / nblk, nb = r % nblk, k0 = 128 * kb, n0 = 32 * nb;
        int drow = n0;
        if (GU) { const int half = n0 >= FF ? 1 : 0, n1 = n0 - half * FF; drow = 256 * (n1 / 128) + 128 * half + (n1 % 128); }
        cvt_tile8(W + (size_t)m * K * N + (size_t)k0 * N + n0, (size_t)N, WT + (size_t)m * K * N + (size_t)drow * K + k0, (size_t)K, sc, lane);
    }
}
__device__ __forceinline__ float silu_f(float x) { return x / (1.0f + __expf(-x)); }

__device__ __forceinline__ void p_prologue(Frame& F) {
    LAS float* sc = (LAS float*)(F.lds + 69632);
    const int gw = F.vcu * NWAVES + F.wave, NGW = F.G * NWAVES, lane = F.lane;
    for (int i = F.tid; i < 9 * D; i += 512) { const int r = i / D, k = i % D; sc[i] = silu_f(r < 8 ? F.in[1][r * D + k] : F.in[3][k]); }
    __syncthreads();
    { LAS float* red = (LAS float*)F.lds;
      for (int bi = F.vcu; bi < 4 * 192; bi += F.G) {
        const int l = bi / 192, n0 = (bi % 192) * 32, cg = lane & 7, kq = lane >> 3, kb = F.wave * 8 + kq;
        const float* w = F.in[4] + (size_t)l * D * 6144 + (size_t)kb * 6144 + n0 + 4 * cg;
        f32x4 wv[16];
#pragma unroll
        for (int i = 0; i < 16; ++i) wv[i] = *(const f32x4*)(w + (size_t)i * 64 * 6144);
        f32x4 a[9];
#pragma unroll
        for (int r = 0; r < 9; ++r) a[r] = (f32x4){0.f, 0.f, 0.f, 0.f};
#pragma unroll
        for (int i = 0; i < 16; ++i) {
#pragma unroll
            for (int r = 0; r < 9; ++r) { const float sv = sc[r * D + kb + 64 * i]; a[r] = a[r] + wv[i] * sv; } }
#pragma unroll
        for (int r = 0; r < 9; ++r) {
#pragma unroll
            for (int q = 0; q < 4; ++q) { float v = a[r][q]; v += __shfl_xor(v, 8); v += __shfl_xor(v, 16); v += __shfl_xor(v, 32); a[r][q] = v; } }
        if (kq == 0) {
#pragma unroll
            for (int r = 0; r < 9; ++r) *(LAS f32x4*)(red + (F.wave * 9 + r) * 32 + 4 * cg) = a[r]; }
        __syncthreads();
        if (F.tid < 288) { const int r = F.tid >> 5, c = F.tid & 31; float sacc = F.in[5][l * 6144 + n0 + c];
#pragma unroll
            for (int w8 = 0; w8 < 8; ++w8) sacc += red[(w8 * 9 + r) * 32 + c];
            WSP(float, WS_MOD)[(size_t)(l * 9 + r) * 6144 + n0 + c] = sacc; }
        __syncthreads();
      } }
    for (int it = gw; it < 2048; it += NGW) {
        const int g = it >> 9, ch = (it >> 8) & 1, n0 = (it & 255) * 4, c0 = ch * 128 + 2 * lane; const float* fw = F.in[11] + (size_t)(g * 256) * D + n0;
        const f32x2 wr = {__builtin_amdgcn_cosf((float)c0 * (1.0f / 256.0f)), __builtin_amdgcn_cosf((float)(c0 + 1) * (1.0f / 256.0f))};
        const f32x2 wi = {__builtin_amdgcn_sinf((float)c0 * (1.0f / 256.0f)), __builtin_amdgcn_sinf((float)(c0 + 1) * (1.0f / 256.0f))};
        f32x2 ac[4], as[4];
#pragma unroll
        for (int q = 0; q < 4; ++q) { ac[q] = (f32x2){0.f, 0.f}; as[q] = (f32x2){0.f, 0.f}; }
        for (int l0 = 0; l0 < 256; l0 += 32) {
            f32x2 cr = {__builtin_amdgcn_cosf((float)((l0 * c0) & 255) * (1.0f / 256.0f)), __builtin_amdgcn_cosf((float)((l0 * (c0 + 1)) & 255) * (1.0f / 256.0f))};
            f32x2 ci = {__builtin_amdgcn_sinf((float)((l0 * c0) & 255) * (1.0f / 256.0f)), __builtin_amdgcn_sinf((float)((l0 * (c0 + 1)) & 255) * (1.0f / 256.0f))};
            f32x4 f[32];
#pragma unroll
            for (int l = 0; l < 32; ++l) f[l] = *(const f32x4*)(fw + (size_t)(l0 + l) * D);
#pragma unroll
            for (int l = 0; l < 32; ++l) {
#pragma unroll
                for (int q = 0; q < 4; ++q) { ac[q] = ac[q] + cr * f[l][q]; as[q] = as[q] + ci * f[l][q]; }
                const f32x2 nr = cr * wr - ci * wi, ni = cr * wi + ci * wr; cr = nr; ci = ni; }
        }
        bf16_t* o = WSP(bf16_t, WS_WFP) + (size_t)n0 * 2048 + g * 512 + c0;
#pragma unroll
        for (int q = 0; q < 4; ++q) { *(unsigned*)(o + (size_t)q * 2048) = pk2(ac[q][0], ac[q][1]); *(unsigned*)(o + (size_t)q * 2048 + 256) = pk2(-as[q][0], -as[q][1]); }
    }
    { const long NT = (long)F.G * 512; const long gt = (long)F.vcu * 512 + F.tid;
      if (FOURIER_FFT) {
        for (long it = gt; it < (long)(512 + 256) * 32; it += NT) { const int row = (int)(it >> 5), c8 = (int)(it & 31); float v[8];
#pragma unroll
            for (int j = 0; j < 8; ++j) { const int col = c8 * 8 + j; float x = 0.f;
                if (row < 512) { const int cl = row >> 7, ri = (row >> 6) & 1, kl = row & 63, cl2 = col >> 6, a = col & 63;
                    if (cl == cl2) { const float ph = (float)((kl * a) & 63) * (1.0f / 64.0f); x = ri ? -__builtin_amdgcn_sinf(ph) : __builtin_amdgcn_cosf(ph); } }
                else { const int r2 = row - 512, kl = r2 >> 7, ro = (r2 >> 6) & 1, kh = r2 & 63, kl2 = col >> 7, ri = (col >> 6) & 1, c = col & 63;
                    if (kl == kl2) { const float ph = (float)((kh * c) & 63) * (1.0f / 64.0f); const float cs = __builtin_amdgcn_cosf(ph), sn = __builtin_amdgcn_sinf(ph);
                        x = (ro == 0 ? (ri == 0 ? cs : sn) : (ri == 0 ? sn : -cs)) * (1.0f / 1024.0f); } }
                v[j] = x; }
            u32x4 w; w.x = pk2(v[0], v[1]); w.y = pk2(v[2], v[3]); w.z = pk2(v[4], v[5]); w.w = pk2(v[6], v[7]);
            *(u32x4*)((row < 512 ? WSP(bf16_t, WS_BD1) + (size_t)row * 256 : WSP(bf16_t, WS_T2BD) + (size_t)(row - 512) * 256) + c8 * 8) = w; }
      } else
      for (long it = gt; it < (long)4096 * 512; it += NT) { const int row = (int)(it >> 9), s8 = (int)(it & 511), ri = row >> 11, k = row & 2047; float v[8];
#pragma unroll
          for (int j = 0; j < 8; ++j) { const float ph = (float)((k * (s8 * 8 + j)) & 4095) * (1.0f / 4096.0f); v[j] = (ri ? __builtin_amdgcn_sinf(ph) : __builtin_amdgcn_cosf(ph)) * (1.0f / 1024.0f); }
          u32x4 w; w.x = pk2(v[0], v[1]); w.y = pk2(v[2], v[3]); w.z = pk2(v[4], v[5]); w.w = pk2(v[6], v[7]); *(u32x4*)(WSP(bf16_t, WS_TSEQ) + (size_t)row * 4096 + s8 * 8) = w; }
      for (long it = gt; it < (long)512 * 32; it += NT) { const int row = (int)(it >> 5), s8 = (int)(it & 31), ri = row >> 8, k = row & 255; float v[8];
#pragma unroll
          for (int j = 0; j < 8; ++j) { const float ph = (float)((k * (s8 * 8 + j)) & 255) * (1.0f / 256.0f); v[j] = (ri ? __builtin_amdgcn_sinf(ph) : __builtin_amdgcn_cosf(ph)) * (1.0f / 256.0f); }
          u32x4 w; w.x = pk2(v[0], v[1]); w.y = pk2(v[2], v[3]); w.z = pk2(v[4], v[5]); w.w = pk2(v[6], v[7]); *(u32x4*)(WSP(bf16_t, WS_TCTX) + (size_t)row * 256 + s8 * 8) = w; }
      for (long it = gt; it < 96 * 128; it += NT) *(u32x4*)(WSP(bf16_t, WS_WMD) + (size_t)672 * D + it * 8) = (u32x4){0u, 0u, 0u, 0u};
      for (long it = gt; it < 1024 + 512; it += NT) { const bool isA = it < 1024; const int q = isA ? (int)it : (int)it - 1024; const int nf = isA ? 16 : 8; const int pos = q / nf, i = q % nf;
          const float inv = exp2f(-((float)i / (float)nf) * 13.287712379549449f); const float ang = (float)pos * inv;
          double rev = (double)ang * 0.15915494309189535; rev -= __builtin_rint(rev);
          const float cv = __builtin_amdgcn_cosf((float)rev), sv = __builtin_amdgcn_sinf((float)rev);
          float* tab = WSP(float, WS_TAB); if (isA) { tab[q] = cv; tab[1024 + q] = sv; } else { tab[2048 + q] = cv; tab[2560 + q] = sv; } }
    }
    for (int l = 0; l < 2; ++l) {
        if (QKV8 & (1 << l)) cvt_matrix8<false>(F.in[7] + (size_t)l * D * 1536, D, 1536, WSP(unsigned char, l ? WS_WQKV1 : WS_WQKV0), W8_GU, 1, gw, NGW, lane);
        else cvt_matrix<false>(F.in[7] + (size_t)l * D * 1536, D, 1536, WSP(bf16_t, l ? WS_WQKV1 : WS_WQKV0), gw, NGW, lane);
        cvt_matrix<false>(F.in[10] + (size_t)l * D * D, D, D, WSP(bf16_t, l ? WS_WOA1 : WS_WOA0), gw, NGW, lane);
        if (GU8 & (1 << l)) cvt_matrix8<true>(F.in[18] + (size_t)l * D * 2 * FFD, D, 2 * FFD, WSP(unsigned char, l ? WS_WDGU1 : WS_WDGU0), W8_GU, 1, gw, NGW, lane);
        else cvt_matrix<true>(F.in[18] + (size_t)l * D * 2 * FFD, D, 2 * FFD, WSP(bf16_t, l ? WS_WDGU1 : WS_WDGU0), gw, NGW, lane);
        if (DOWN8 & (1 << l)) cvt_matrix8<false>(F.in[19] + (size_t)l * FFD * D, FFD, D, WSP(unsigned char, l ? WS_WDD1 : WS_WDD0), W8_D, 1, gw, NGW, lane);
        else cvt_matrix<false>(F.in[19] + (size_t)l * FFD * D, FFD, D, WSP(bf16_t, l ? WS_WDD1 : WS_WDD0), gw, NGW, lane);
        cvt_matrix8<true>(F.in[21] + (size_t)(l * NEXP) * D * 2 * FFE, D, 2 * FFE, WSP(unsigned char, l ? WS_WEGU1 : WS_WEGU0), W8_GU, NEXP, gw, NGW, lane);
        cvt_matrix8<false>(F.in[22] + (size_t)(l * NEXP) * FFE * D, FFE, D, WSP(unsigned char, l ? WS_WED1 : WS_WED0), W8_D, NEXP, gw, NGW, lane);
    }
    cvt_matrix<false>(F.in[12], D, 672, WSP(bf16_t, WS_WMD), gw, NGW, lane);
    cvt_matrix<false>(F.in[15], 384, 1536, WSP(bf16_t, WS_WUQ), gw, NGW, lane);
    cvt_matrix<false>(F.in[16], 256, 2048, WSP(bf16_t, WS_WUKV), gw, NGW, lane);
    cvt_matrix<false>(F.in[17], D, D, WSP(bf16_t, WS_WMO), gw, NGW, lane);
}

__device__ __forceinline__ void g_plain_cs(Frame& F, const bf16_t* A, int lda, const bf16_t* Bt, int ldb, bf16_t* C, int ldc, int N, int K, int nsl) {
    pg8::Sched S; S.init_plain(A, lda, Bt, ldb, C, ldc, NTOK, N, F.G, F.bx); S.cs_nsl = nsl; S.cs_P = WSP(bf16_t, WS_CSP);
    pg8::EpiPlain E{ldc, 1.0f};
    pg8::gemm_phase<pg8::EpiPlain, false>(F.lds, K, lda, ldb, S, E);
}
__device__ __forceinline__ Row ctx_partial_row(Frame& F, int b, int j, int nsl, int lane) {
    Row y = ld_row_bf16(WSP(bf16_t, WS_CSP) + (size_t)(b * 256 + j) * D, lane);
    for (int sl = 1; sl < nsl; ++sl) { const Row z = ld_row_bf16(WSP(bf16_t, WS_CSP) + ((size_t)(sl * 8 + b) * 256 + j) * D, lane);
#pragma unroll
        for (int jj = 0; jj < 4; ++jj) y.v[jj] = y.v[jj] + z.v[jj]; }
    return y;
}
__device__ __forceinline__ void st_row_fp8(unsigned* hp, int lane, const Row& h) {
#pragma unroll
    for (int jj = 0; jj < 4; ++jj) hp[lane + 64 * jj] = pk_fp8x4(h.v[jj][0], h.v[jj][1], h.v[jj][2], h.v[jj][3]); }
__device__ __forceinline__ void p_r0(Frame& F) {
    const int gw = F.vcu * NWAVES + F.wave, NGW = F.G * NWAVES, lane = F.lane;
    for (int t = gw; t < NTOK; t += NGW) {
        const int b = t / TPB, j = t % TPB; const bool isc = j < CTXL;
        const float* src = isc ? F.in[2] + (size_t)(b * CTXL + j) * D : F.in[0] + (size_t)(b * SEQ + (j - CTXL)) * D;
        const Row x = ld_row_f32_nt(src, lane);
        const int mr = isc ? 8 : b;
        const Row h = modnorm(x, normg(F, 0, 0), modp(F, 0, mr, 0), modp(F, 0, mr, 1), lane);
        if (QKV8 & 1) st_row_fp8(WSP(unsigned, WS_H) + (size_t)t * (D / 4), lane, h); else st_row_bf16(WSP(bf16_t, WS_H) + (size_t)t * D, lane, h);
    }
}

template <bool MOE, bool H8 = false>
__device__ __forceinline__ void p_rmid(Frame& F, int layer, bool lat_only, const float* w_router, int moe_idx, int csn = 0) {
    const int lane = F.lane;
    const int nact = lat_only ? NLAT : NTOK; const int per = (nact + F.G - 1) / F.G;
    const int nrows = (nact - F.bx + F.G - 1) / F.G < per ? (nact - F.bx + F.G - 1) / F.G : per;
    LAS float* wrT = (LAS float*)F.lds;
    LAS int* cntL = (LAS int*)(F.lds + 32768); LAS int* baseL = cntL + 8;
    LAS unsigned* rowE = (LAS unsigned*)(F.lds + 32768 + 64); LAS unsigned* rowS = rowE + 1024; LAS float* rowW = (LAS float*)(rowS + 1024);
    if (MOE) {
        for (int i = F.tid; i < 8 * D; i += 512) { const int c = i >> 3, e = i & 7; wrT[e * D + c] = w_router[i]; }
        if (F.tid < 8) cntL[F.tid] = 0;
        __syncthreads();
    }
    for (int rr = F.wave; rr < nrows; rr += NWAVES) {
        const int a = rr * F.G + F.bx; const int t = lat_only ? (a / SEQ) * TPB + CTXL + (a % SEQ) : a;
        const int b = t / TPB, j = t % TPB; const int mr = (j < CTXL) ? 8 : b;
        bf16_t* xp = WSP(bf16_t, WS_X) + (size_t)t * D;
        const Row y = (csn > 0 && j < CTXL) ? ctx_partial_row(F, b, j, csn, lane) : ld_row_bf16(WSP(bf16_t, WS_Y) + (size_t)t * D, lane);
        const Row x0 = layer == 0 ? ld_row_f32_nt(j < CTXL ? F.in[2] + (size_t)(b * CTXL + j) * D : F.in[0] + (size_t)(b * SEQ + (j - CTXL)) * D, lane) : ld_row_bf16(xp, lane);
        Row x = resid(x0, y, normg(F, layer, 1), modp(F, layer, mr, 2), lane);
        if ((DBG_SKIP >> (2 * layer)) & 1) x = x0;
        st_row_bf16(xp, lane, x);
        const Row h = modnorm(x, normg(F, layer, 2), modp(F, layer, mr, 3), modp(F, layer, mr, 4), lane);
        if (H8) { unsigned* hp = WSP(unsigned, WS_H) + (size_t)t * (D / 4) + lane;
#pragma unroll
            for (int jj = 0; jj < 4; ++jj) hp[64 * jj] = pk_fp8x4(h.v[jj][0], h.v[jj][1], h.v[jj][2], h.v[jj][3]); }
        else st_row_bf16(WSP(bf16_t, WS_H) + (size_t)t * D, lane, h);
        if (MOE) {
            float lg[8];
#pragma unroll
            for (int e = 0; e < 8; ++e) { float s = 0.f;
#pragma unroll
                for (int jj = 0; jj < 4; ++jj) { const f32x4 w = *(const LAS f32x4*)(wrT + e * D + 4 * lane + 256 * jj); s += (h.v[jj][0] * w[0] + h.v[jj][1] * w[1]) + (h.v[jj][2] * w[2] + h.v[jj][3] * w[3]); }
                lg[e] = wave_sum(s); }
            int e1 = 0; float v1 = lg[0];
#pragma unroll
            for (int e = 1; e < 8; ++e) if (lg[e] > v1) { v1 = lg[e]; e1 = e; }
            int e2 = -1; float v2 = -3.0e38f;
#pragma unroll
            for (int e = 0; e < 8; ++e) if (e != e1 && (e2 < 0 || lg[e] > v2)) { v2 = lg[e]; e2 = e; }
            const float ex = __expf(v2 - v1); const float w1 = 1.0f / (1.0f + ex);
#if DBG_CHECK
            if (lane < 8) { float vv = lg[0];
#pragma unroll
                for (int e = 1; e < 8; ++e) vv = (lane == e) ? lg[e] : vv;
                ((float*)(F.ws + 1300 * MiB))[(size_t)t * 8 + lane] = vv; }
#endif
            if (lane == 0) { const int s1 = __hip_atomic_fetch_add(cntL + e1, 1, __ATOMIC_RELAXED, __HIP_MEMORY_SCOPE_WORKGROUP), s2 = __hip_atomic_fetch_add(cntL + e2, 1, __ATOMIC_RELAXED, __HIP_MEMORY_SCOPE_WORKGROUP);
                rowE[rr] = (unsigned)e1 | ((unsigned)e2 << 8); rowS[rr] = (unsigned)s1 | ((unsigned)s2 << 16); rowW[rr] = w1; }
        }
    }
    if (MOE) {
        __syncthreads();
        unsigned* cntg = F.ctl + CW_MOE + moe_idx * 8 * 64;
        if (F.tid < 8) baseL[F.tid] = (int)__hip_atomic_fetch_add(cntg + F.tid * 64, (unsigned)cntL[F.tid], RLX_AGENT);
        __syncthreads();
        int* list = WSP(int, WS_LIST); u32x4* tinfo = WSP(u32x4, WS_TOKINFO);
        for (int rr = F.tid; rr < nrows; rr += 512) {
            const int a = rr * F.G + F.bx; const int t = lat_only ? (a / SEQ) * TPB + CTXL + (a % SEQ) : a;
            const unsigned E = rowE[rr], Sx = rowS[rr]; const int e1 = E & 255, e2 = E >> 8; const int g1 = baseL[e1] + (int)(Sx & 0xffff), g2 = baseL[e2] + (int)(Sx >> 16);
            list[(size_t)e1 * LIST_CAP + g1] = t; list[(size_t)e2 * LIST_CAP + g2] = t;
            tinfo[t] = (u32x4){E, (unsigned)g1, (unsigned)g2, __builtin_bit_cast(unsigned, rowW[rr])};
        }
        __syncthreads();
    }
}

struct MoeTiles { int cnt[8]; int tend[8]; };
__device__ __forceinline__ MoeTiles moe_tiles(Frame& F, int moe_idx) {
    MoeTiles m; unsigned* cntg = F.ctl + CW_MOE + moe_idx * 8 * 64; int acc = 0;
#pragma unroll
    for (int e = 0; e < 8; ++e) { const int c = (int)__builtin_amdgcn_readfirstlane(__hip_atomic_load(cntg + e * 64, RLX_AGENT)); m.cnt[e] = c; acc += (c + 255) >> 8; m.tend[e] = acc; }
    return m;
}

constexpr bool MOE8_SPLIT = true;
struct MoeSplit { int full, nsl; };
__device__ __forceinline__ MoeSplit moe_split(int nMt, int G) {
    MoeSplit r; const int tot = nMt * 4; r.full = (tot / G) * G; const int R = tot - r.full;
    int nsl = (R > 0) ? G / R : 1; nsl = nsl > 4 ? 4 : nsl;
    if (nsl < 2 || (r.full & 31) != 0 || r.full == 0 || R > 128) nsl = 1;
    r.nsl = nsl; return r;
}

template <bool MOE>
__device__ __forceinline__ void p_rend(Frame& F, int layer, bool last, int moe_idx, int csn = 0) {
    const int gw = F.vcu * NWAVES + F.wave, NGW = F.G * NWAVES, lane = F.lane;
    const int nact = last ? NLAT : NTOK;
    int ts[8]; int ms_pm0 = 1 << 30, ms_nsl = 1;
    if (MOE) { const MoeTiles m = moe_tiles(F, moe_idx); ts[0] = 0;
#pragma unroll
        for (int e = 1; e < 8; ++e) ts[e] = m.tend[e - 1];
        if (MOE8_SPLIT && moe_idx == 1) { const MoeSplit ms = moe_split(m.tend[7], F.G); ms_nsl = ms.nsl; if (ms.nsl > 1) ms_pm0 = ms.full / 4; } }
    for (int a = gw; a < nact; a += NGW) {
        const int t = last ? (a / SEQ) * TPB + CTXL + (a % SEQ) : a;
        const int b = t / TPB, j = t % TPB; const int mr = (j < CTXL) ? 8 : b;
        bf16_t* xp = WSP(bf16_t, WS_X) + (size_t)t * D;
        Row y;
        if (MOE) {
            const u32x4 ti = WSP(const u32x4, WS_TOKINFO)[t]; const int e1 = ti.x & 255, e2 = ti.x >> 8; int t1 = 0, t2 = 0;
#pragma unroll
            for (int e = 1; e < 8; ++e) { if (e1 == e) t1 = ts[e]; if (e2 == e) t2 = ts[e]; }
            const unsigned w1b = ti.w; const float w1 = u2f(w1b), w2 = 1.0f - w1;
            const size_t ra = (size_t)t1 * 256 + ti.y, rb = (size_t)t2 * 256 + ti.z;
            Row ya = ld_row_bf16(WSP(bf16_t, WS_Y2) + ra * D, lane), yb = ld_row_bf16(WSP(bf16_t, WS_Y2) + rb * D, lane);
            if ((int)(ra >> 8) >= ms_pm0) { for (int sl = 1; sl < ms_nsl; ++sl) { const Row z = ld_row_bf16(WSP(bf16_t, WS_MSP) + ((size_t)((sl - 1) * 32 * 256) + (ra - (size_t)ms_pm0 * 256)) * D, lane);
#pragma unroll
                for (int jj = 0; jj < 4; ++jj) ya.v[jj] = ya.v[jj] + z.v[jj]; } }
            if ((int)(rb >> 8) >= ms_pm0) { for (int sl = 1; sl < ms_nsl; ++sl) { const Row z = ld_row_bf16(WSP(bf16_t, WS_MSP) + ((size_t)((sl - 1) * 32 * 256) + (rb - (size_t)ms_pm0 * 256)) * D, lane);
#pragma unroll
                for (int jj = 0; jj < 4; ++jj) yb.v[jj] = yb.v[jj] + z.v[jj]; } }
#pragma unroll
            for (int jj = 0; jj < 4; ++jj) y.v[jj] = ya.v[jj] * w1 + yb.v[jj] * w2;
        } else y = (csn > 0 && j < CTXL) ? ctx_partial_row(F, b, j, csn, lane) : ld_row_bf16(WSP(bf16_t, WS_Y2) + (size_t)t * D, lane);
        const Row x0 = ld_row_bf16(xp, lane);
        Row x = resid(x0, y, normg(F, layer, 3), modp(F, layer, mr, 5), lane);
        if ((DBG_SKIP >> (2 * layer + 1)) & 1) x = x0;
        if (last) { st_row_f32(F.out + ((size_t)b * SEQ + (j - CTXL)) * D, lane, x); }
        else {
            st_row_bf16(xp, lane, x);
            const Row h = modnorm(x, normg(F, layer + 1, 0), modp(F, layer + 1, mr, 0), modp(F, layer + 1, mr, 1), lane);
            if ((QKV8 & 2) && layer == 2) st_row_fp8(WSP(unsigned, WS_H) + (size_t)t * (D / 4), lane, h);
            else st_row_bf16(WSP(bf16_t, WS_H) + (size_t)t * D, lane, h);
        }
    }
}

__device__ __forceinline__ void transpose_64x256(Frame& F, const bf16_t* src, size_t sp, int hs, bf16_t* dst, size_t dp) {
    LAS bf16_t* tl = (LAS bf16_t*)F.lds;
#pragma unroll
    for (int q = 0; q < 4; ++q) { const int cid = F.tid + 512 * q; const int tok = cid >> 5, ch = cid & 31; const int scol = (ch >> 3) * hs + (ch & 7) * 8;
        *(LAS u32x4*)(tl + tok * 264 + ch * 8) = *(const u32x4*)(src + (size_t)tok * sp + scol); }
    __syncthreads();
#pragma unroll
    for (int q = 0; q < 4; ++q) { const int item = F.tid + 512 * q; const int dcol = item & 255, c8 = item >> 8; unsigned v[8];
#pragma unroll
        for (int jj = 0; jj < 8; ++jj) v[jj] = tl[(c8 * 8 + jj) * 264 + dcol];
        u32x4 w; w.x = v[0] | (v[1] << 16); w.y = v[2] | (v[3] << 16); w.z = v[4] | (v[5] << 16); w.w = v[6] | (v[7] << 16);
        *(u32x4*)(dst + (size_t)dcol * dp + c8 * 8) = w; }
    __syncthreads();
}

__device__ __forceinline__ void transpose_64x256_v8(Frame& F, const bf16_t* src, size_t sp, int hs, unsigned char* dst, size_t dp) {
    LAS bf16_t* tl = (LAS bf16_t*)F.lds;
#pragma unroll
    for (int q = 0; q < 4; ++q) { const int cid = F.tid + 512 * q; const int tok = cid >> 5, ch = cid & 31; const int scol = (ch >> 3) * hs + (ch & 7) * 8;
        *(LAS u32x4*)(tl + tok * 264 + ch * 8) = *(const u32x4*)(src + (size_t)tok * sp + scol); }
    __syncthreads();
#pragma unroll
    for (int q = 0; q < 4; ++q) { const int item = F.tid + 512 * q; const int dcol = item & 255, gk = item >> 8; float v[8];
#pragma unroll
        for (int jj = 0; jj < 8; ++jj) v[jj] = bf2f((unsigned)tl[(gk * 8 + jj) * 264 + dcol]);
        u32x2 w; w.x = pk_fp8x4(v[0], v[1], v[2], v[3]); w.y = pk_fp8x4(v[4], v[5], v[6], v[7]);
        *(u32x2*)(dst + (size_t)dcol * dp + (4 * (gk & 1) + (gk >> 1)) * 8) = w; }
    __syncthreads();
}
__device__ __forceinline__ void p_qkn(Frame& F, int j_a) {
    const int lane = F.lane, a = lane & 7; const float* tab = WSP(const float, WS_TAB);
    const bf16_t* raw = WSP(const bf16_t, WS_A_RAW); bf16_t* Q = WSP(bf16_t, WS_A_Q); bf16_t* Kd = WSP(bf16_t, WS_A_K); bf16_t* Vt = WSP(bf16_t, WS_A_VT);
    float gq[8], gk[8];
#pragma unroll
    for (int i = 0; i < 8; ++i) { gq[i] = F.in[8][j_a * 64 + a * 8 + i]; gk[i] = F.in[9][j_a * 64 + a * 8 + i]; }
    const float C2 = 0.125f * LOG2E; const bool second = (a & 2) != 0;
    for (int u = F.vcu; u < NBATCH * 68; u += F.G) {
        const int b = u / 68, c = u % 68;
        for (int tt = F.wave; tt < 64; tt += NWAVES) {
            const int j = c * 64 + tt, t = b * TPB + j; const bool lat = j >= CTXL; const int sp = j - CTXL;
            float cs[8], sn[8];
            if (lat) { const int pp = (a < 4) ? (sp >> 6) : (sp & 63); const float* tc = tab + pp * 16 + 8 * (a & 1);
                const f32x4 c0 = *(const f32x4*)tc, c1 = *(const f32x4*)(tc + 4), s0 = *(const f32x4*)(tc + 1024), s1 = *(const f32x4*)(tc + 1028);
#pragma unroll
                for (int i = 0; i < 4; ++i) { cs[i] = c0[i]; cs[4 + i] = c1[i]; sn[i] = s0[i]; sn[4 + i] = s1[i]; } }
            else {
#pragma unroll
                for (int i = 0; i < 8; ++i) { cs[i] = 1.f; sn[i] = 0.f; } }
            const bf16_t* rp = raw + (size_t)t * 1536;
#pragma unroll
            for (int pass = 2; pass < 3; ++pass) {
                const bool act = (pass < 2) || (lane < 32); const int chunk = pass * 64 + lane;
                u32x4 w = (u32x4){0u, 0u, 0u, 0u}; if (act) w = *(const u32x4*)(rp + chunk * 8);
                float x[8]; unpack8(w, x); float ss = 0.f;
#pragma unroll
                for (int i = 0; i < 8; ++i) ss += x[i] * x[i];
                ss += __shfl_xor(ss, 1); ss += __shfl_xor(ss, 2); ss += __shfl_xor(ss, 4);
                const float rs = 1.0f / sqrtf(ss * (1.0f / 64.0f) + NORM_EPS);
                float o[8];
#pragma unroll
                for (int i = 0; i < 8; ++i) { const float xn = x[i] * rs * (pass < 2 ? gq[i] : gk[i]); const float pr = __shfl_xor(xn, 2);
                    o[i] = second ? (xn * cs[i] + pr * sn[i]) : (xn * cs[i] - pr * sn[i]); if (pass < 2) o[i] *= C2; }
                if (pass < 2) *(u32x4*)(Q + (size_t)t * D + chunk * 8) = pack8(o);
                else if (act) {
                    if constexpr (ATT_QK8) { u32x2 w8; w8.x = pk_fp8x4(o[0], o[1], o[2], o[3]); w8.y = pk_fp8x4(o[4], o[5], o[6], o[7]);
                        *(u32x2*)((unsigned char*)Kd + (size_t)t * 256 + (lane >> 3) * 64 + (a & 1) * 32 + (a >> 1) * 8) = w8; }
                    else *(u32x4*)(Kd + (size_t)t * 256 + (chunk - 128) * 8) = pack8(o); }
            }
        }
        if constexpr (ATT_QK8 && ATT_PV8) transpose_64x256_v8(F, raw + (size_t)(b * TPB + c * 64) * 1536 + 1280, 1536, 64, (unsigned char*)Vt + (size_t)(b * 256) * TPB + c * 64, TPB);
        else transpose_64x256(F, raw + (size_t)(b * TPB + c * 64) * 1536 + 1280, 1536, 64, Vt + (size_t)(b * 256) * TPB + c * 64, TPB);
    }
}

__device__ __forceinline__ void p_mla1(Frame& F) {
    const int gw = F.vcu * NWAVES + F.wave, NGW = F.G * NWAVES, lane = F.lane; const float* tab = WSP(const float, WS_TAB);
    const bf16_t* Dm = WSP(const bf16_t, WS_M_DM); bf16_t* CQ = WSP(bf16_t, WS_M_CQ); bf16_t* CKV = WSP(bf16_t, WS_M_CKV); bf16_t* KR = WSP(bf16_t, WS_M_KR);
    float gq[8], gk[8];
#pragma unroll
    for (int i = 0; i < 8; ++i) { gq[i] = lane < 48 ? F.in[13][lane * 8 + i] : 0.f; gk[i] = lane < 32 ? F.in[14][lane * 8 + i] : 0.f; }
    const int rc = lane & 3; const bool second = (rc & 1) != 0;
    for (int t = gw; t < NTOK; t += NGW) {
        const int j = t % TPB; const bool lat = j >= CTXL; const int sp = j - CTXL;
        const bf16_t* dp = Dm + (size_t)t * 768;
        u32x4 w1 = (u32x4){0u, 0u, 0u, 0u}, w2 = (u32x4){0u, 0u, 0u, 0u};
        if (lane < 48) w1 = *(const u32x4*)(dp + lane * 8);
        if (lane < 36) w2 = *(const u32x4*)(dp + 384 + lane * 8);
        float x[8], y[8]; unpack8(w1, x); unpack8(w2, y); float s1 = 0.f, s2 = 0.f;
#pragma unroll
        for (int i = 0; i < 8; ++i) { s1 += x[i] * x[i]; s2 += y[i] * y[i]; }
        if (lane >= 32) s2 = 0.f;
        const float rq = 1.0f / sqrtf(wave_sum(s1) * (1.0f / 384.0f) + NORM_EPS), rk = 1.0f / sqrtf(wave_sum(s2) * (1.0f / 256.0f) + NORM_EPS);
        float o[8];
#pragma unroll
        for (int i = 0; i < 8; ++i) o[i] = x[i] * rq * gq[i];
        if (lane < 48) *(u32x4*)(CQ + (size_t)t * 384 + lane * 8) = pack8(o);
        float cs[8], sn[8];
        if (lat) { const int pp = (rc < 2) ? (sp >> 6) : (sp & 63); const float* tc = tab + 2048 + pp * 8;
            const f32x4 c0 = *(const f32x4*)tc, c1 = *(const f32x4*)(tc + 4), s0 = *(const f32x4*)(tc + 512), s1v = *(const f32x4*)(tc + 516);
#pragma unroll
            for (int i = 0; i < 4; ++i) { cs[i] = c0[i]; cs[4 + i] = c1[i]; sn[i] = s0[i]; sn[4 + i] = s1v[i]; } }
        else {
#pragma unroll
            for (int i = 0; i < 8; ++i) { cs[i] = 1.f; sn[i] = 0.f; } }
        float k[8];
#pragma unroll
        for (int i = 0; i < 8; ++i) { const float pr = __shfl_xor(y[i], 1); k[i] = second ? (y[i] * cs[i] + pr * sn[i]) : (y[i] * cs[i] - pr * sn[i]); o[i] = y[i] * rk * gk[i]; }
        if (lane < 32) *(u32x4*)(CKV + (size_t)t * 256 + lane * 8) = pack8(o);
        else if (lane < 36) *(u32x4*)(KR + (size_t)t * 32 + (lane - 32) * 8) = pack8(k);
    }
}
__device__ __forceinline__ void p_mla2(Frame& F) {
    const int lane = F.lane; const float* tab = WSP(const float, WS_TAB);
    bf16_t* Qm = WSP(bf16_t, WS_M_Q); bf16_t* KV = WSP(bf16_t, WS_M_KV); const bf16_t* KR = WSP(const bf16_t, WS_M_KR); bf16_t* Vt = WSP(bf16_t, WS_M_VT);
    const float C2 = 0.10206207261596577f * LOG2E;
    for (int u = F.vcu; u < NBATCH * 68; u += F.G) {
        const int b = u / 68, c = u % 68;
        for (int hg = 0; hg < 4; ++hg) {
            if constexpr (ATT_QK8 && MLA_QK8 && ATT_PV8) transpose_64x256_v8(F, KV + (size_t)(b * TPB + c * 64) * 2048 + hg * 512 + 64, 2048, 128, (unsigned char*)Vt + (size_t)(b * 1024 + hg * 256) * TPB + c * 64, TPB);
            else transpose_64x256(F, KV + (size_t)(b * TPB + c * 64) * 2048 + hg * 512 + 64, 2048, 128, Vt + (size_t)(b * 1024 + hg * 256) * TPB + c * 64, TPB);
            if constexpr (MLA_QK8 && ATT_QK8) {
              const int tok = F.tid >> 3, rem = F.tid & 7, hh = hg * 4 + (rem >> 1), part = rem & 1; const int t = b * TPB + c * 64 + tok;
              const bf16_t* kn = KV + (size_t)t * 2048 + hh * 128 + 8 * part; const bf16_t* kr = KR + (size_t)t * 32 + 8 * part;
              unsigned char* k8 = WSP(unsigned char, WS_M_K8) + (size_t)t * 1536 + hh * 96;
              u32x4 wn0, wn1, wr;
              { float a[8], bb[8]; unpack8(*(const u32x4*)(kn), a); unpack8(*(const u32x4*)(kn + 16), bb);
                wn0.x = pk_fp8x4(a[0], a[1], a[2], a[3]); wn0.y = pk_fp8x4(a[4], a[5], a[6], a[7]); wn0.z = pk_fp8x4(bb[0], bb[1], bb[2], bb[3]); wn0.w = pk_fp8x4(bb[4], bb[5], bb[6], bb[7]); }
              { float a[8], bb[8]; unpack8(*(const u32x4*)(kn + 32), a); unpack8(*(const u32x4*)(kn + 48), bb);
                wn1.x = pk_fp8x4(a[0], a[1], a[2], a[3]); wn1.y = pk_fp8x4(a[4], a[5], a[6], a[7]); wn1.z = pk_fp8x4(bb[0], bb[1], bb[2], bb[3]); wn1.w = pk_fp8x4(bb[4], bb[5], bb[6], bb[7]); }
              { float a[8], bb[8]; unpack8(*(const u32x4*)(kr), a); unpack8(*(const u32x4*)(kr + 16), bb);
                wr.x = pk_fp8x4(a[0], a[1], a[2], a[3]); wr.y = pk_fp8x4(a[4], a[5], a[6], a[7]); wr.z = pk_fp8x4(bb[0], bb[1], bb[2], bb[3]); wr.w = pk_fp8x4(bb[4], bb[5], bb[6], bb[7]); }
              *(u32x4*)(k8 + part * 32) = wn0; *(u32x4*)(k8 + part * 32 + 16) = wn1; *(u32x4*)(k8 + 64 + part * 16) = wr;
            } else
            { const int tok = F.tid >> 3, rem = F.tid & 7, hh = hg * 4 + (rem >> 1), part = rem & 1; const int t = b * TPB + c * 64 + tok;
              *(u32x4*)(KV + (size_t)t * 2048 + hh * 128 + 64 + part * 16) = *(const u32x4*)(KR + (size_t)t * 32 + part * 16);
              *(u32x4*)(KV + (size_t)t * 2048 + hh * 128 + 64 + part * 16 + 8) = *(const u32x4*)(KR + (size_t)t * 32 + part * 16 + 8); }
        }
    }
}
__device__ __forceinline__ void p_htrans(Frame& F) {
    for (int u = F.vcu; u < NBATCH * 68 * 4; u += F.G) {
        const int cb = u & 3, c = (u >> 2) % 68, b = (u >> 2) / 68;
        transpose_64x256(F, WSP(const bf16_t, WS_H) + (size_t)(b * TPB + c * 64) * D + cb * 256, D, 64, WSP(bf16_t, WS_F_HT) + (size_t)(b * D + cb * 256) * TPB + c * 64, TPB);
    }
}

__device__ __forceinline__ void p_htrans2(Frame& F) {
    for (int u = F.vcu; u < NBATCH * 68 * 4; u += F.G) {
        const int cb = u & 3, x = (u >> 2) % 68, b = (u >> 2) / 68;
        const bf16_t* src = WSP(const bf16_t, WS_H) + (size_t)(b * TPB + (x < 4 ? 64 * x : CTXL + (x - 4))) * D + cb * 256;
        transpose_64x256(F, src, x < 4 ? (size_t)D : (size_t)64 * D, 64, WSP(bf16_t, WS_F_HT) + (size_t)(b * D + cb * 256) * TPB + x * 64, TPB);
    }
}
__device__ __forceinline__ void p_fft_relayout(Frame& F) {
    const int gw = F.vcu * NWAVES + F.wave, NGW = F.G * NWAVES, lane = F.lane;
    LAS unsigned char* lw = F.lds + F.wave * 8704;
    const LAS unsigned short* l16 = (const LAS unsigned short*)lw;
    for (int row = gw; row < NBATCH * D; row += NGW) {
        const bf16_t* g1 = WSP(const bf16_t, WS_F_G1) + (size_t)row * 8192; bf16_t* g2 = WSP(bf16_t, WS_F_G2) + (size_t)row * 8192;
        for (int half = 0; half < 2; ++half) {
#pragma unroll
            for (int q = 0; q < 8; ++q) { const int piece = q * 64 + lane, cl = piece >> 4, o16 = piece & 15;
                *(LAS u32x4*)(lw + cl * 272 + o16 * 16) = *(const u32x4*)(g1 + (size_t)(32 * half + cl) * 128 + o16 * 8); }
            LDS_WAIT(); asm volatile("" ::: "memory");
#pragma unroll 2
            for (int it = 0; it < 8; ++it) { const int id = it * 64 + lane, c8 = id & 3, ri = (id >> 2) & 1, kl = id >> 3; float o[8];
#pragma unroll
                for (int j = 0; j < 8; ++j) { const int cl = 8 * c8 + j, c = 32 * half + cl; const float gr = bf2f(l16[cl * 136 + kl]), gi = bf2f(l16[cl * 136 + 64 + kl]);
                    const float ph = (float)((kl * c) & 4095) * (1.0f / 4096.0f); const float cs = __builtin_amdgcn_cosf(ph), sn = __builtin_amdgcn_sinf(ph);
                    o[j] = ri ? (gi * cs - gr * sn) : (gr * cs + gi * sn); }
                *(u32x4*)(g2 + kl * 128 + ri * 64 + 32 * half + 8 * c8) = pack8(o); }
            LDS_WAIT(); asm volatile("" ::: "memory");
        }
    }
}

template <int DK, int NQ, bool NOREF>
__device__ __forceinline__ unsigned p_attn_impl(Frame& F, const bf16_t* Q, int qpitch, int qhs, const bf16_t* K, int kpitch, int khs, int gsz, const bf16_t* Vt, bf16_t* O, bool ctxq, const float* qgain = nullptr, bool qfuse = false, unsigned only = 0xffffffffu) {
    constexpr int VTP = (ATT_QK8 && ATT_PV8 && (DK == 64 || MLA_QK8)) ? TPB / 2 : TPB;
    const int nkv = 16 / gsz; constexpr int UR = 256 * NQ, UPH = SEQ / UR, NU = NBATCH * 16 * UPH;
    unsigned fail = 0u, bit = 1u;
    if (ctxq) { for (int cu = F.vcu; cu < 256; cu += F.G) if ((cu & 1) == 0) { const int bh = cu >> 1, b = bh >> 4, hh = bh & 15, kvh = hh / gsz;
        if (only & bit) if (!att::unit<DK, NQ, NOREF>(F.lds, Q + (size_t)(b * TPB) * qpitch + hh * qhs, qpitch, K + (size_t)(b * TPB) * kpitch + kvh * khs, kpitch, Vt + (size_t)((b * nkv + kvh) * 64) * VTP, VTP,
                      O + (size_t)(b * TPB) * D + hh * 64, D, CTXL / 64, CTXL, qgain, qfuse ? WSP(const float, WS_TAB) : nullptr, -1)) fail |= bit;
        bit <<= 1; } }
    const int per = (NU + F.G - 1) / F.G;
    for (int i = 0; i < per; ++i) { const int uid = F.vcu * per + i; if (uid >= NU) break;
        const int qb = uid % UPH, hh = (uid / UPH) & 15, b = uid / (UPH * 16), kvh = hh / gsz; const size_t row0 = (size_t)b * TPB + CTXL + qb * UR;
        if (only & bit) if (!att::unit<DK, NQ, NOREF>(F.lds, Q + row0 * qpitch + hh * qhs, qpitch, K + (size_t)(b * TPB) * kpitch + kvh * khs, kpitch, Vt + (size_t)((b * nkv + kvh) * 64) * VTP, VTP,
                      O + row0 * D + hh * 64, D, TPB / 64, UR, qgain, qfuse ? WSP(const float, WS_TAB) : nullptr, qb * UR)) fail |= bit;
        bit <<= 1; }
    return fail;
}

template <int DK, int NQ>
__device__ __forceinline__ void p_attn(Frame& F, const bf16_t* Q, int qpitch, int qhs, const bf16_t* K, int kpitch, int khs, int gsz, const bf16_t* Vt, bf16_t* O, bool ctxq, const float* gq = nullptr, const float* gk = nullptr, bool qfuse = false) {
    bool noref = false;
    if (gq != nullptr) { float a = fabsf(gq[F.lane]), b = fabsf(gk[F.lane]);
#pragma unroll
        for (int o = 1; o < 64; o <<= 1) { a = fmaxf(a, __shfl_xor(a, o)); b = fmaxf(b, __shfl_xor(b, o)); }
        noref = (a * b <= ((ATT_QK8 && ATT_PV8) ? 1.4f : 5.0f)); }
    if constexpr (DK == 64) { if (noref) { p_attn_impl<DK, NQ, true>(F, Q, qpitch, qhs, K, kpitch, khs, gsz, Vt, O, ctxq, gq, true); return; } }
    if constexpr (DK == 96 && MLA_SPEC) {
        const unsigned fm = p_attn_impl<DK, NQ, true>(F, Q, qpitch, qhs, K, kpitch, khs, gsz, Vt, O, ctxq, nullptr, qfuse);
        if (fm) p_attn_impl<DK, NQ, false>(F, Q, qpitch, qhs, K, kpitch, khs, gsz, Vt, O, ctxq, nullptr, qfuse, fm);
        return; }
    p_attn_impl<DK, NQ, false>(F, Q, qpitch, qhs, K, kpitch, khs, gsz, Vt, O, ctxq, DK == 64 ? gq : nullptr, (DK == 64 && gq != nullptr) || qfuse);
}

__device__ __forceinline__ void g_plain(Frame& F, const bf16_t* A, int lda, const bf16_t* Bt, int ldb, bf16_t* C, int ldc, int M, int N, int K, float scale) {
    pg8::Sched S; S.init_plain(A, lda, Bt, ldb, C, ldc, M, N, F.G, F.bx);
    pg8::EpiPlain E{ldc, scale};
    pg8::gemm_phase<pg8::EpiPlain, false>(F.lds, K, lda, ldb, S, E);
}
__device__ __forceinline__ void g_swiglu(Frame& F, const bf16_t* A, const bf16_t* Bt, bf16_t* Act, int M, int FF) {
    pg8::Sched S; S.init_plain(A, D, Bt, D, Act, FF, M, 2 * FF, F.G, F.bx); S.cn = 128;
    pg8::EpiSwiGLU E{FF};
    pg8::gemm_phase<pg8::EpiSwiGLU, false>(F.lds, D, D, D, S, E);
}
__device__ __forceinline__ void g_swiglu_fp8(Frame& F, const unsigned char* Wgu8) {
    pg8::Sched S; S.init_plain(WSP(const bf16_t, WS_H), D / 2, (const bf16_t*)Wgu8, D / 2, WSP(bf16_t, WS_ACT), FFD, NTOK, 2 * FFD, F.G, F.bx);
    S.cm1 = (long)256 * (FFD / 2); S.cn = 64;
    pg8::EpiSwiGLU8 E{FFD, 1.0f / W8_GU, A8_ACT};
    pg8::gemm_phase<pg8::EpiSwiGLU8, false, true>(F.lds, D / 2, D / 2, D / 2, S, E);
}
__device__ __forceinline__ void g_swiglu_to8(Frame& F, const bf16_t* Bt) {
    pg8::Sched S; S.init_plain(WSP(const bf16_t, WS_H), D, Bt, D, WSP(bf16_t, WS_ACT), FFD, NTOK, 2 * FFD, F.G, F.bx);
    S.cm1 = (long)256 * (FFD / 2); S.cn = 64;
    pg8::EpiSwiGLU8 E{FFD, 1.0f, A8_ACT};
    pg8::gemm_phase<pg8::EpiSwiGLU8, false>(F.lds, D, D, D, S, E);
}
constexpr int DOWN8_CSN = 5;
__device__ __forceinline__ void g_down_fp8(Frame& F, const unsigned char* Wd8) {
    pg8::Sched S; S.init_plain(WSP(const bf16_t, WS_ACT), FFD / 2, (const bf16_t*)Wd8, FFD / 2, WSP(bf16_t, WS_Y2), D, NTOK, D, F.G, F.bx);
    S.cs_nsl = DOWN8_CSN; S.cs_ntl = 6; S.cs_P = WSP(bf16_t, WS_CSP);
    pg8::EpiPlain E{D, 1.0f / (W8_D * A8_ACT)};
    pg8::gemm_phase<pg8::EpiPlain, false, true>(F.lds, FFD / 2, FFD / 2, FFD / 2, S, E);
}
__device__ __forceinline__ void g_qkv_fp8(Frame& F, const unsigned char* W8) {
    pg8::Sched S; S.init_plain(WSP(const bf16_t, WS_H), D / 2, (const bf16_t*)W8, D / 2, WSP(bf16_t, WS_A_RAW), 1536, NTOK, 1536, F.G, F.bx);
    pg8::EpiPlain E{1536, 1.0f / W8_GU};
    pg8::gemm_phase<pg8::EpiPlain, false, true>(F.lds, D / 2, D / 2, D / 2, S, E);
}
__device__ __forceinline__ void set_moe(pg8::Sched& S, const MoeTiles& m, const int* list) {
    S.tend0 = m.tend[0]; S.tend1 = m.tend[1]; S.tend2 = m.tend[2]; S.tend3 = m.tend[3]; S.tend4 = m.tend[4]; S.tend5 = m.tend[5]; S.tend6 = m.tend[6]; S.tend7 = m.tend[7];
    S.cnt0 = m.cnt[0]; S.cnt1 = m.cnt[1]; S.cnt2 = m.cnt[2]; S.cnt3 = m.cnt[3]; S.cnt4 = m.cnt[4]; S.cnt5 = m.cnt[5]; S.cnt6 = m.cnt[6]; S.cnt7 = m.cnt[7];
    S.list = list; S.cap = LIST_CAP; S.moe = 1; S.nM = m.tend[7];
}
__device__ __forceinline__ void g_moe1(Frame& F, const bf16_t* Wgu, int moe_idx) {
    const MoeTiles m = moe_tiles(F, moe_idx);
    pg8::Sched S; S.init_plain(WSP(const bf16_t, WS_H), D, Wgu, D, WSP(bf16_t, WS_ACT), FFE, 256, 2 * FFE, F.G, F.bx); S.cn = 128; S.sAm = 0;
    set_moe(S, m, WSP(const int, WS_LIST)); S.sBe = (long)2 * FFE * D * 2;
    pg8::EpiSwiGLU E{FFE};
    pg8::gemm_phase<pg8::EpiSwiGLU, true>(F.lds, D, D, D, S, E);
}
__device__ __forceinline__ void g_moe1_fp8(Frame& F, const unsigned char* Wgu8, int moe_idx) {
    const MoeTiles m = moe_tiles(F, moe_idx);
    pg8::Sched S; S.init_plain(WSP(const bf16_t, WS_H), D / 2, (const bf16_t*)Wgu8, D / 2, WSP(bf16_t, WS_ACT), FFE, 256, 2 * FFE, F.G, F.bx); S.sAm = 0;
    S.cm1 = (long)256 * (FFE / 2); S.cn = 64;
    set_moe(S, m, WSP(const int, WS_LIST)); S.sBe = (long)2 * FFE * D;
    pg8::EpiSwiGLU8 E{FFE, 1.0f / W8_GU, A8_ACT};
    pg8::gemm_phase<pg8::EpiSwiGLU8, true, true>(F.lds, D / 2, D / 2, D / 2, S, E);
}
__device__ __forceinline__ void g_moe2_fp8(Frame& F, const unsigned char* Wd8, int moe_idx) {
    const MoeTiles m = moe_tiles(F, moe_idx);
    pg8::Sched S; S.init_plain(WSP(const bf16_t, WS_ACT), FFE / 2, (const bf16_t*)Wd8, FFE / 2, WSP(bf16_t, WS_Y2), D, 256, D, F.G, F.bx);
    set_moe(S, m, WSP(const int, WS_LIST)); S.sBe = (long)D * FFE;
    if (moe_idx == 1) { const MoeSplit ms = moe_split(m.tend[7], F.G); S.ms_full = ms.full; S.ms_nsl = ms.nsl; S.ms_kt = FFE / 128; S.ms_P = WSP(bf16_t, WS_MSP); }
    pg8::EpiPlain E{D, 1.0f / (W8_D * A8_ACT)};
    pg8::gemm_phase<pg8::EpiPlain, false, true>(F.lds, FFE / 2, FFE / 2, FFE / 2, S, E);
}
__device__ __forceinline__ void g_moe2(Frame& F, const bf16_t* Wd, int moe_idx) {
    const MoeTiles m = moe_tiles(F, moe_idx);
    pg8::Sched S; S.init_plain(WSP(const bf16_t, WS_ACT), FFE, Wd, FFE, WSP(bf16_t, WS_Y2), D, 256, D, F.G, F.bx);
    set_moe(S, m, WSP(const int, WS_LIST)); S.sBe = (long)D * FFE * 2;
    pg8::EpiPlain E{D, 1.0f};
    pg8::gemm_phase<pg8::EpiPlain, false>(F.lds, FFE, FFE, FFE, S, E);
}

struct Args { const float* in[23]; float* out; unsigned char* ws; int ph_lo, ph_hi; };
__global__ void __launch_bounds__(NWAVES * 64, 2) mk_fwd(Args args) {
    extern __shared__ __attribute__((aligned(16))) unsigned char lds_raw[];
    Frame F;
    F.lds = (LAS unsigned char*)lds_raw;
    F.tid = threadIdx.x; F.lane = F.tid & 63; F.wave = __builtin_amdgcn_readfirstlane(F.tid >> 6);
    F.G = gridDim.x; F.bx = blockIdx.x; F.vcu = (F.G % 8 == 0) ? (F.bx % 8) * (F.G / 8) + F.bx / 8 : F.bx;
    F.ws = args.ws; F.ctl = (unsigned*)(args.ws + WS_CTL); F.out = args.out;
#pragma unroll
    for (int i = 0; i < 23; ++i) F.in[i] = args.in[i];
    volatile LAS unsigned* MISC = (volatile LAS unsigned*)(F.lds + MISC_OFF);
    if (F.tid < 32) MISC[F.tid] = 0u;
    __syncthreads();
    XcdBarrier bar; bar.bar = F.ctl + CW_BAR; bar.x = 0; bar.st = nullptr;
    if (!MK_PER_PHASE) bar = xcd_barrier_post(F.ctl + CW_BAR, MISC + 8);
    const int lo = args.ph_lo, hi = args.ph_hi;
#define IN(k) (lo <= (k) && (k) < hi)
#define SEAM(k) do { if (IN(k) && IN((k) + 1)) { if (!MK_PER_PHASE) xcd_barrier(bar); } } while (0)
    constexpr float SC1 = 1.0f;
    if (IN(0)) { p_prologue(F); } SEAM(0);
    if (IN(1)) { p_r0(F); } SEAM(1);
    if (IN(2)) { if (QKV8 & 1) g_qkv_fp8(F, WSP(const unsigned char, WS_WQKV0)); else g_plain(F, WSP(const bf16_t, WS_H), D, WSP(const bf16_t, WS_WQKV0), D, WSP(bf16_t, WS_A_RAW), 1536, NTOK, 1536, D, SC1); } SEAM(2);
    if (IN(3)) { p_qkn(F, 0); } SEAM(3);
    if (IN(4)) { p_attn<64, 2>(F, WSP(const bf16_t, WS_A_RAW), 1536, 64, WSP(const bf16_t, WS_A_K), ATT_QK8 ? 128 : 256, ATT_QK8 ? 32 : 64, 4, WSP(const bf16_t, WS_A_VT), WSP(bf16_t, WS_A_O), true, F.in[8], F.in[9]); } SEAM(4);
    if (IN(5)) { g_plain_cs(F, WSP(const bf16_t, WS_A_O), D, WSP(const bf16_t, WS_WOA0), D, WSP(bf16_t, WS_Y), D, D, D, 4); } SEAM(5);
    if (IN(6)) { if (GU8 & 1) p_rmid<false, true>(F, 0, false, nullptr, 0, 4); else p_rmid<false>(F, 0, false, nullptr, 0, 4); } SEAM(6);
    if (IN(7)) { if (GU8 & 1) g_swiglu_fp8(F, WSP(const unsigned char, WS_WDGU0)); else if (DOWN8 & 1) g_swiglu_to8(F, WSP(const bf16_t, WS_WDGU0)); else g_swiglu(F, WSP(const bf16_t, WS_H), WSP(const bf16_t, WS_WDGU0), WSP(bf16_t, WS_ACT), NTOK, FFD); } SEAM(7);
    if (IN(8)) { if (DOWN8 & 1) g_down_fp8(F, WSP(const unsigned char, WS_WDD0)); else g_plain_cs(F, WSP(const bf16_t, WS_ACT), FFD, WSP(const bf16_t, WS_WDD0), FFD, WSP(bf16_t, WS_Y2), D, D, FFD, 11); } SEAM(8);
    if (IN(9)) { p_rend<false>(F, 0, false, 0, (DOWN8 & 1) ? DOWN8_CSN : 11); } SEAM(9);
    if (IN(10)) { if (FOURIER_FFT) p_htrans2(F); else p_htrans(F); } SEAM(10);
    if (FOURIER_FFT) {
    if (IN(11)) {
        { pg8::Sched S; S.init_plain(WSP(const bf16_t, WS_F_HT) + CTXL, TPB, WSP(const bf16_t, WS_BD1), 256, WSP(bf16_t, WS_F_G1), 8192, D, 512, F.G, F.bx);
          S.nB = NBATCH * 16; S.nB2 = 16; S.sAb = (long)D * TPB * 2; S.sAb2 = 512; S.sBb = 0; S.sBb2 = 0; S.sCb = (long)D * 8192; S.sCb2 = 512;
          pg8::EpiPlain E{8192, 1.0f}; pg8::gemm_phase<pg8::EpiPlain, false>(F.lds, 256, TPB, 256, S, E); }
        { pg8::Sched S; S.init_plain(WSP(const bf16_t, WS_TCTX), 256, WSP(const bf16_t, WS_F_HT), TPB, WSP(bf16_t, WS_F_U), 2048, 512, D, F.G, F.bx);
          S.nB = NBATCH; S.sAb = 0; S.sBb = (long)D * TPB * 2; S.sCb = (long)TPB * 2048; S.pmw = 1; S.cm1 = 0; S.cm2 = 256; S.cn = 512;
          pg8::EpiPlain E{2048, 1.0f}; pg8::gemm_phase<pg8::EpiPlain, false>(F.lds, 256, 256, TPB, S, E); }
        if (!MK_PER_PHASE) xcd_barrier(bar);
        p_fft_relayout(F);
        if (!MK_PER_PHASE) xcd_barrier(bar);
        { pg8::Sched S; S.init_plain(WSP(const bf16_t, WS_T2BD), 256, WSP(const bf16_t, WS_F_G2), 8192, WSP(bf16_t, WS_F_U) + (size_t)CTXL * 2048, 2048, 256, D, F.G, F.bx);
          S.nB = NBATCH * 32; S.nB2 = 32; S.sAb = 0; S.sAb2 = 0; S.sBb = (long)D * 8192 * 2; S.sBb2 = 512; S.sCb = (long)TPB * 2048; S.sCb2 = 2 * 2048; S.cm1 = 0; S.cn = 512;
          pg8::EpiFFT2 E{0}; pg8::gemm_phase<pg8::EpiFFT2, false>(F.lds, 256, 256, 8192, S, E); }
    } SEAM(11);
    } else {
    if (IN(11)) {
        { const int gw = F.vcu * NWAVES + F.wave, NGW = F.G * NWAVES, lane = F.lane;
          for (int rw = gw; rw < NBATCH * D; rw += NGW) { const int b = rw >> 10, ch = rw & 1023; const bf16_t* hp = WSP(const bf16_t, WS_F_HT) + (size_t)rw * TPB + CTXL; float acc_ = 0.f;
#pragma unroll
              for (int q = 0; q < 8; ++q) { float x[8]; unpack8(*(const u32x4*)(hp + (q * 64 + lane) * 8), x); acc_ += ((x[0] - x[1]) + (x[2] - x[3])) + ((x[4] - x[5]) + (x[6] - x[7])); }
              acc_ = wave_sum(acc_) * (1.0f / 1024.0f);
              if (lane == 0) { bf16_t* up = WSP(bf16_t, WS_F_U) + (size_t)(b * TPB + CTXL + 2048) * 2048 + (ch >> 8) * 512 + (ch & 255); up[0] = (bf16_t)f2bf(acc_); up[256] = 0; } } }
        { pg8::Sched S; S.init_plain(WSP(const bf16_t, WS_TSEQ), 4096, WSP(const bf16_t, WS_F_HT) + CTXL, TPB, WSP(bf16_t, WS_F_U) + (size_t)CTXL * 2048, 2048, 4096, D, F.G, F.bx);
          S.nB = NBATCH; S.sAb = 0; S.sBb = (long)D * TPB * 2; S.sCb = (long)TPB * 2048; S.pmw = 8; S.cm1 = (long)256 * 2048; S.cm2 = 256; S.cn = 512;
          pg8::EpiMirror E{2048}; pg8::gemm_phase<pg8::EpiMirror, false>(F.lds, 4096, 4096, TPB, S, E); }
        { pg8::Sched S; S.init_plain(WSP(const bf16_t, WS_TCTX), 256, WSP(const bf16_t, WS_F_HT), TPB, WSP(bf16_t, WS_F_U), 2048, 512, D, F.G, F.bx);
          S.nB = NBATCH; S.sAb = 0; S.sBb = (long)D * TPB * 2; S.sCb = (long)TPB * 2048; S.pmw = 1; S.cm1 = 0; S.cm2 = 256; S.cn = 512;
          pg8::EpiPlain E{2048, 1.0f}; pg8::gemm_phase<pg8::EpiPlain, false>(F.lds, 256, 256, TPB, S, E); }
    } SEAM(11);
    }
    if (IN(12)) { g_plain_cs(F, WSP(const bf16_t, WS_F_U), 2048, WSP(const bf16_t, WS_WFP), 2048, WSP(bf16_t, WS_Y), D, D, 2048, 8); } SEAM(12);
    if (IN(13)) { p_rmid<true, true>(F, 1, false, F.in[20], 0, 8); } SEAM(13);
    if (IN(14)) { g_moe1_fp8(F, WSP(const unsigned char, WS_WEGU0), 0); } SEAM(14);
    if (IN(15)) { g_moe2_fp8(F, WSP(const unsigned char, WS_WED0), 0); } SEAM(15);
    if (IN(16)) { p_rend<true>(F, 1, false, 0); } SEAM(16);
    if (IN(17)) { g_plain(F, WSP(const bf16_t, WS_H), D, WSP(const bf16_t, WS_WMD), D, WSP(bf16_t, WS_M_DM), 768, NTOK, 768, D, SC1); } SEAM(17);
    if (IN(18)) { p_mla1(F); } SEAM(18);
    if (IN(19)) { g_plain(F, WSP(const bf16_t, WS_M_CQ), 384, WSP(const bf16_t, WS_WUQ), 384, WSP(bf16_t, WS_M_Q), 1536, NTOK, 1536, 384, SC1);
                  g_plain(F, WSP(const bf16_t, WS_M_CKV), 256, WSP(const bf16_t, WS_WUKV), 256, WSP(bf16_t, WS_M_KV), 2048, NTOK, 2048, 256, SC1); } SEAM(19);
    if (IN(20)) { p_mla2(F); } SEAM(20);
    if (IN(21)) { p_attn<96, 2>(F, WSP(const bf16_t, WS_M_Q), 1536, 96, (MLA_QK8 && ATT_QK8) ? WSP(const bf16_t, WS_M_K8) : WSP(const bf16_t, WS_M_KV), (MLA_QK8 && ATT_QK8) ? 768 : 2048, (MLA_QK8 && ATT_QK8) ? 48 : 128, 1, WSP(const bf16_t, WS_M_VT), WSP(bf16_t, WS_M_O), true, nullptr, nullptr, true); } SEAM(21);
    if (IN(22)) { g_plain_cs(F, WSP(const bf16_t, WS_M_O), D, WSP(const bf16_t, WS_WMO), D, WSP(bf16_t, WS_Y), D, D, D, 4); } SEAM(22);
    if (IN(23)) { if (GU8 & 2) p_rmid<false, true>(F, 2, false, nullptr, 0, 4); else p_rmid<false>(F, 2, false, nullptr, 0, 4); } SEAM(23);
    if (IN(24)) { if (GU8 & 2) g_swiglu_fp8(F, WSP(const unsigned char, WS_WDGU1)); else if (DOWN8 & 2) g_swiglu_to8(F, WSP(const bf16_t, WS_WDGU1)); else g_swiglu(F, WSP(const bf16_t, WS_H), WSP(const bf16_t, WS_WDGU1), WSP(bf16_t, WS_ACT), NTOK, FFD); } SEAM(24);
    if (IN(25)) { if (DOWN8 & 2) g_down_fp8(F, WSP(const unsigned char, WS_WDD1)); else g_plain_cs(F, WSP(const bf16_t, WS_ACT), FFD, WSP(const bf16_t, WS_WDD1), FFD, WSP(bf16_t, WS_Y2), D, D, FFD, 11); } SEAM(25);
    if (IN(26)) { p_rend<false>(F, 2, false, 0, (DOWN8 & 2) ? DOWN8_CSN : 11); } SEAM(26);
    if (IN(27)) { if (QKV8 & 2) g_qkv_fp8(F, WSP(const unsigned char, WS_WQKV1)); else g_plain(F, WSP(const bf16_t, WS_H), D, WSP(const bf16_t, WS_WQKV1), D, WSP(bf16_t, WS_A_RAW), 1536, NTOK, 1536, D, SC1); } SEAM(27);
    if (IN(28)) { p_qkn(F, 1); } SEAM(28);
    if (IN(29)) { p_attn<64, 2>(F, WSP(const bf16_t, WS_A_RAW), 1536, 64, WSP(const bf16_t, WS_A_K), ATT_QK8 ? 128 : 256, ATT_QK8 ? 32 : 64, 4, WSP(const bf16_t, WS_A_VT), WSP(bf16_t, WS_A_O), false, F.in[8] + 64, F.in[9] + 64); } SEAM(29);
    if (IN(30)) { g_plain_cs(F, WSP(const bf16_t, WS_A_O), D, WSP(const bf16_t, WS_WOA1), D, WSP(bf16_t, WS_Y), D, D, D, 0); } SEAM(30);
    if (IN(31)) { p_rmid<true, true>(F, 3, true, F.in[20] + (size_t)D * NEXP, 1); } SEAM(31);
    if (IN(32)) { g_moe1_fp8(F, WSP(const unsigned char, WS_WEGU1), 1); } SEAM(32);
    if (IN(33)) { g_moe2_fp8(F, WSP(const unsigned char, WS_WED1), 1); } SEAM(33);
    if (IN(34)) { p_rend<true>(F, 3, true, 1); }
#undef IN
#undef SEAM
}


#if DBG_CHECK
__device__ __forceinline__ float blk_sum(float v, float* red) {
    __syncthreads(); red[threadIdx.x] = v; __syncthreads();
    for (int o = 128; o > 0; o >>= 1) { if ((int)threadIdx.x < o) red[threadIdx.x] += red[threadIdx.x + o]; __syncthreads(); }
    return red[0];
}
__device__ __forceinline__ bool close_enough(float got, float ref) { return fabsf(got - ref) <= 0.04f * fabsf(ref) + 0.03f; }
__global__ void dbg_check_moe(Args args, int moe_idx, int lat_only) {
    __shared__ float hs[1024]; __shared__ float red[256]; __shared__ float lg[8]; __shared__ int sh_i[8]; __shared__ float sh_f[2];
    unsigned char* ws = args.ws; unsigned* ctl = (unsigned*)ws; const int tid = threadIdx.x;
    int t = (blockIdx.x * 541 + 17) % NTOK; if (lat_only && (t % TPB) < CTXL) t += CTXL;
    const bf16_t* H = (const bf16_t*)(ws + WS_H) + (size_t)t * D;
    for (int i = tid; i < D; i += 256) hs[i] = bf2f(H[i]);
    __syncthreads();
    const float* wr = args.in[20] + (size_t)moe_idx * D * NEXP;
    for (int e = 0; e < 8; ++e) { float p = 0.f; for (int c = tid; c < D; c += 256) p += hs[c] * wr[c * 8 + e]; const float r = blk_sum(p, red); if (tid == 0) lg[e] = r; }
    __syncthreads();
    const u32x4 ti = ((const u32x4*)(ws + WS_TOKINFO))[t];
    const int e1 = ti.x & 255, e2 = ti.x >> 8, g1 = (int)ti.y, g2 = (int)ti.z; const unsigned w1b = ti.w; const float w1 = u2f(w1b);
    unsigned code = 0;
    if (tid == 0) {
        int r1 = 0; for (int e = 1; e < 8; ++e) if (lg[e] > lg[r1]) r1 = e;
        int r2 = -1; for (int e = 0; e < 8; ++e) if (e != r1 && (r2 < 0 || lg[e] > lg[r2])) r2 = e;
        int r3 = -1; for (int e = 0; e < 8; ++e) if (e != r1 && e != r2 && (r3 < 0 || lg[e] > lg[r3])) r3 = e;
        const float rw1 = 1.0f / (1.0f + expf(lg[r2] - lg[r1]));
        const bool safe = (lg[r2] - lg[r3] > 0.05f) && (lg[r1] - lg[r2] > 0.05f);
        const float* dl = (const float*)(ws + 1300 * MiB) + (size_t)t * 8; float md = 0.f; for (int e = 0; e < 8; ++e) md = fmaxf(md, fabsf(dl[e] - lg[e]));
        if (safe && fabsf(rw1 - w1) > 0.02f) code = 6;
        if (safe && r2 != e2) code = 7;
        if (safe && r1 != e1) code = 8;
        if (!(md <= 0.02f)) code = 9;
        if (e1 > 7 || e2 > 7 || e1 == e2) code = 10;
        const int* list = (const int*)(ws + WS_LIST);
        if (code == 0 && (list[(size_t)e1 * LIST_CAP + g1] != t || list[(size_t)e2 * LIST_CAP + g2] != t)) code = 5;
        int acc = 0, ts1 = 0, ts2 = 0;
        for (int e = 0; e < 8; ++e) { const int c = (int)ctl[CW_MOE + moe_idx * 8 * 64 + e * 64]; if (e == e1) { ts1 = acc; if (g1 >= c) code = code > 5 ? code : 5; } if (e == e2) { ts2 = acc; if (g2 >= c) code = code > 5 ? code : 5; } acc += (c + 255) >> 8; }
        sh_i[0] = ts1 * 256 + g1; sh_i[1] = ts2 * 256 + g2;
    }
    __syncthreads();
    const bf16_t* ACT = (const bf16_t*)(ws + WS_ACT); const bf16_t* YP = (const bf16_t*)(ws + WS_Y2);
    for (int k = 0; k < 2; ++k) {
        const int e = k ? e2 : e1; const size_t pr = (size_t)sh_i[k]; if (e > 7) continue;
        const float* wgu = args.in[21] + (size_t)(moe_idx * NEXP + e) * D * 2 * FFE; const float* wd = args.in[22] + (size_t)(moe_idx * NEXP + e) * FFE * D;
        for (int j = 0; j < 6; ++j) {
            const int ch = (j * 449 + 3 + blockIdx.x * 7) % FFE; float pg = 0.f, pu = 0.f;
            for (int c = tid; c < D; c += 256) { pg += hs[c] * wgu[(size_t)c * 2 * FFE + ch]; pu += hs[c] * wgu[(size_t)c * 2 * FFE + FFE + ch]; }
            const float g = blk_sum(pg, red); const float u = blk_sum(pu, red);
            const float ref = g / (1.0f + expf(-g)) * u; const float got = bf2f(ACT[pr * FFE + ch]);
            if (tid == 0 && !close_enough(got, ref)) { const unsigned c2 = k ? 3u : 4u; code = code > c2 ? code : c2; }
        }
        for (int j = 0; j < 6; ++j) {
            const int n = (j * 173 + 5 + blockIdx.x * 3) % D; float p = 0.f;
            for (int f = tid; f < FFE; f += 256) p += bf2f(ACT[pr * FFE + f]) * wd[(size_t)f * D + n];
            const float ref = blk_sum(p, red); const float got = bf2f(YP[pr * D + n]);
            if (tid == 0 && !close_enough(got, ref)) { const unsigned c2 = k ? 1u : 2u; code = code > c2 ? code : c2; }
        }
    }
    if (tid == 0 && code) atomicAdd(ctl + 16 + code, 1u);
}
__global__ void dbg_final(Args args) { unsigned* ctl = (unsigned*)args.ws; unsigned code = 0, cnt = 0; for (unsigned k = 1; k < 16; ++k) if (ctl[16 + k]) { code = k; cnt = ctl[16 + k]; } if (code) { float a = 1000.f * sqrtf((float)cnt); for (unsigned i = 0; i < code; ++i) a *= 10.f; args.out[0] += a; } }
#endif

extern "C" void kernel_launch(void* const* d_in, const int* in_sizes, int n_in, void* d_out, int out_size, void* d_ws, size_t ws_size, hipStream_t stream) {
    static int grid = 0;
    if (grid == 0) {
        if (n_in != 23 || out_size != NLAT * D || ws_size < WS_END) { fprintf(stderr, "kernel_launch: unexpected shapes/workspace (n_in %d out %d ws %zu need %zu)\n", n_in, out_size, ws_size, (size_t)WS_END); grid = -1; return; }
        int dev = 0, cus = 0, per_cu = 0;
        if (hipGetDevice(&dev) != hipSuccess || hipDeviceGetAttribute(&cus, hipDeviceAttributeMultiprocessorCount, dev) != hipSuccess) { grid = -1; return; }
        if (hipFuncSetAttribute((const void*)mk_fwd, hipFuncAttributeMaxDynamicSharedMemorySize, LDS_BYTES) != hipSuccess) { fprintf(stderr, "kernel_launch: hipFuncSetAttribute failed\n"); grid = -1; return; }
        if (hipOccupancyMaxActiveBlocksPerMultiprocessor(&per_cu, (const void*)mk_fwd, NWAVES * 64, LDS_BYTES) != hipSuccess || per_cu < 1) { fprintf(stderr, "kernel_launch: occupancy query reports %d\n", per_cu); }
        (void)hipGetLastError();
        grid = cus;
    }
    if (grid < 0) return;
    if (hipMemsetAsync((char*)d_ws + WS_CTL, 0, CTL_ZERO_BYTES, stream) != hipSuccess) return;
    Args a{};
    for (int i = 0; i < 23; ++i) a.in[i] = (const float*)d_in[i];
    a.out = (float*)d_out; a.ws = (unsigned char*)d_ws;
#if MK_PER_PHASE
    for (int p = 0; p < NPHASE; ++p) { a.ph_lo = p; a.ph_hi = p + 1; hipLaunchKernelGGL(mk_fwd, dim3(grid), dim3(NWAVES * 64), LDS_BYTES, stream, a);
#if DBG_CHECK
        if (p == 15) hipLaunchKernelGGL(dbg_check_moe, dim3(64), dim3(256), 0, stream, a, 0, 0);
#endif
    }
#if DBG_CHECK
    hipLaunchKernelGGL(dbg_final, dim3(1), dim3(1), 0, stream, a);
#endif
#else
    a.ph_lo = 0; a.ph_hi = NPHASE; hipLaunchKernelGGL(mk_fwd, dim3(grid), dim3(NWAVES * 64), LDS_BYTES, stream, a);
#endif
}
```

```cpp
#include <hip/hip_runtime.h>
#include <cstdio>
#include <cstdint>

#ifndef MK_PER_PHASE
#define MK_PER_PHASE 0
#endif

#ifndef FOURIER_FFT
#define FOURIER_FFT 1
#endif
#ifndef DBG_CHECK
#define DBG_CHECK 0
#endif
#ifndef DBG_SKIP
#define DBG_SKIP 0
#endif
#define LAS __attribute__((address_space(3)))
#define GAS __attribute__((address_space(1)))
typedef unsigned short bf16_t;
typedef short bf16x8 __attribute__((ext_vector_type(8)));
typedef float f32x4 __attribute__((ext_vector_type(4)));
typedef float f32x2 __attribute__((ext_vector_type(2)));
typedef float f32x16 __attribute__((ext_vector_type(16)));
typedef unsigned u32x4 __attribute__((ext_vector_type(4)));
typedef unsigned u32x2 __attribute__((ext_vector_type(2)));

constexpr int D = 1024, NBATCH = 8, SEQ = 4096, CTXL = 256, TPB = SEQ + CTXL, NTOK = NBATCH * TPB, NLAT = NBATCH * SEQ;
constexpr int FFD = 2816, FFE = 3584, NEXP = 8;
constexpr int MOE_ROWS = 71680;
constexpr int LIST_CAP = NTOK;
constexpr float NORM_EPS = 1e-6f;
constexpr float LOG2E = 1.4426950408889634f;
constexpr int NPHASE = 35;
constexpr int DOWN8 = 3;
constexpr int GU8 = 2;
constexpr float W8_GU = 64.0f, W8_D = 128.0f, A8_ACT = 4.0f;

constexpr size_t MiB = (size_t)1 << 20;
constexpr size_t WS_CTL = 0, CTL_ZERO_BYTES = 1 * MiB;
constexpr size_t WS_MOD = 1 * MiB;
constexpr size_t WS_TAB = 2 * MiB;
constexpr size_t WS_X = 4 * MiB;
constexpr size_t WS_H = 140 * MiB;
constexpr size_t WS_WQKV0 = 208 * MiB, WS_WQKV1 = 211 * MiB, WS_WOA0 = 214 * MiB, WS_WOA1 = 216 * MiB, WS_WFP = 218 * MiB, WS_WMD = 222 * MiB, WS_WUQ = 224 * MiB,
                 WS_WUKV = 226 * MiB, WS_WMO = 227 * MiB, WS_WDGU0 = 229 * MiB, WS_WDGU1 = 240 * MiB, WS_WDD0 = 251 * MiB, WS_WDD1 = 257 * MiB, WS_WEGU0 = 263 * MiB,
                 WS_WEGU1 = 375 * MiB, WS_WED0 = 487 * MiB, WS_WED1 = 543 * MiB, WS_TSEQ = 599 * MiB, WS_TCTX = 663 * MiB;
constexpr size_t T0 = 664 * MiB;
constexpr size_t WS_A_RAW = T0, WS_A_Q = T0 + 102 * MiB, WS_A_K = T0 + 170 * MiB, WS_A_VT = T0 + 187 * MiB, WS_A_O = T0 + 204 * MiB;
constexpr size_t WS_F_HT = T0, WS_F_U = T0 + 68 * MiB, WS_F_G1 = T0 + 204 * MiB, WS_F_G2 = T0 + 332 * MiB;
constexpr size_t WS_BD1 = WS_TAB + 65536, WS_T2BD = WS_TAB + 393216;
constexpr size_t WS_M_K8 = T0;
constexpr size_t WS_M_DM = T0, WS_M_CQ = T0 + 51 * MiB, WS_M_CKV = T0 + 77 * MiB, WS_M_KR = T0 + 94 * MiB, WS_M_Q = T0 + 97 * MiB, WS_M_KV = T0 + 199 * MiB,
                 WS_M_VT = T0 + 340 * MiB, WS_M_O = T0 + 408 * MiB;
constexpr size_t WS_Y = T0 + 476 * MiB;
constexpr size_t WS_ACT = T0, WS_Y2 = T0 + 490 * MiB, WS_LIST = T0 + 630 * MiB, WS_TOKINFO = T0 + 632 * MiB;
constexpr size_t WS_CSP = T0 + 560 * MiB;
constexpr size_t WS_MSP = 72 * MiB;
constexpr size_t WS_END = T0 + 634 * MiB;
static_assert((size_t)NTOK * 1024 * 4 == 136 * MiB && (size_t)MOE_ROWS * FFE * 2 == 490 * MiB && (size_t)MOE_ROWS * 1024 * 2 == 140 * MiB, "sizes");

constexpr int CW_BAR = 4096;
constexpr int CW_MOE = 8192;

constexpr int RING_BYTES = 131072;
constexpr int MISC_OFF = RING_BYTES + 320;
constexpr int LDS_BYTES = 147456;
constexpr int NWAVES = 8;

__device__ __forceinline__ unsigned f2bf(float f) { unsigned u = __builtin_bit_cast(unsigned, f); return (u + 0x7fffu + ((u >> 16) & 1u)) >> 16; }
typedef __bf16 bf16x2_p __attribute__((ext_vector_type(2)));
__device__ __forceinline__ unsigned pk2(float lo, float hi) { const f32x2 v = {lo, hi}; return __builtin_bit_cast(unsigned, __builtin_convertvector(v, bf16x2_p)); }
__device__ __forceinline__ float u2f(unsigned u) { return __builtin_bit_cast(float, u); }
__device__ __forceinline__ float bf2f(unsigned b) { return __builtin_bit_cast(float, b << 16); }
__device__ __forceinline__ float bflo(unsigned w) { return __builtin_bit_cast(float, w << 16); }
__device__ __forceinline__ float bfhi(unsigned w) { return __builtin_bit_cast(float, w & 0xffff0000u); }
__device__ __forceinline__ float wave_sum(float v) {
#pragma unroll
    for (int o = 1; o < 64; o <<= 1) v += __shfl_xor(v, o);
    return v;
}
__device__ __forceinline__ void unpack8(const u32x4 w, float (&v)[8]) { const unsigned a = w.x, b = w.y, c = w.z, d = w.w; v[0] = bflo(a); v[1] = bfhi(a); v[2] = bflo(b); v[3] = bfhi(b); v[4] = bflo(c); v[5] = bfhi(c); v[6] = bflo(d); v[7] = bfhi(d); }
__device__ __forceinline__ u32x4 pack8(const float (&v)[8]) { u32x4 w; w.x = pk2(v[0], v[1]); w.y = pk2(v[2], v[3]); w.z = pk2(v[4], v[5]); w.w = pk2(v[6], v[7]); return w; }
typedef int v8i __attribute__((ext_vector_type(8)));
typedef int v4i __attribute__((ext_vector_type(4)));
__device__ __forceinline__ unsigned pk_fp8x4(float a, float b, float c, float d) { int w = __builtin_amdgcn_cvt_pk_fp8_f32(a, b, 0, false); w = __builtin_amdgcn_cvt_pk_fp8_f32(c, d, w, true); return (unsigned)w; }
#define LDS_WAIT() asm volatile("s_waitcnt lgkmcnt(0)" ::: "memory")
#define RLX_AGENT __ATOMIC_RELAXED, __HIP_MEMORY_SCOPE_AGENT

namespace pg8 {
constexpr int BM = 256, BK = 64, HALF = 128, HTB = HALF * BK * 2, STAGE_BYTES = 8 * HTB, NXCD = 8, WGM = 8;
__host__ __device__ __forceinline__ int lds_byte(int r, int c) { const int st = (r >> 4) * 2 + (c >> 5), rr = r & 15, cc = c & 31, ob = rr * 64 + cc * 2; return st * 1024 + (ob ^ (((ob >> 9) & 1) << 5)); }
__host__ __device__ __forceinline__ void stage_rc(int b, int& R, int& C) { const int st = b / 1024, sb = b % 1024, swz = sb ^ (((sb >> 9) & 1) << 5); R = (st >> 1) * 16 + swz / 64; C = (st & 1) * 32 + (swz % 64) / 2; }
__host__ __device__ __forceinline__ int perm32(int rho) { const int n = rho >> 4, i = rho & 15; return 8 * (i >> 2) + 4 * n + (i & 3); }

struct Unit { const char* a; const char* b; bf16_t* c; int pm, pn, e, nt; };

struct Sched {
    int nM, nN, nB, G, c;
    const char* A; const char* Bt; bf16_t* C;
    long sAb, sBb, sCb;
    long sAm, sBn;
    int pmw; long cm1, cm2, cn;
    int moe; long sBe;
    int tend0, tend1, tend2, tend3, tend4, tend5, tend6, tend7;
    int cnt0, cnt1, cnt2, cnt3, cnt4, cnt5, cnt6, cnt7;
    const int* list; int cap;
    int nB2; long sAb2, sBb2, sCb2;
    int cs_ntl;
    int ms_full, ms_nsl, ms_kt; bf16_t* ms_P;
    int cs_nsl; bf16_t* cs_P;
    __device__ __forceinline__ void init_plain(const bf16_t* A_, long lda, const bf16_t* Bt_, long ldb, bf16_t* C_, long ldc, int M, int N, int G_, int c_) {
        nM = M / BM; nN = N / BM; nB = 1; G = G_; c = c_; A = (const char*)A_; Bt = (const char*)Bt_; C = C_; sAb = sBb = sCb = 0;
        sAm = (long)BM * lda * 2; sBn = (long)BM * ldb * 2; pmw = 1 << 30; cm1 = (long)BM * ldc; cm2 = 0; cn = BM; moe = 0; sBe = 0;
        cs_nsl = -1; cs_ntl = 4; cs_P = nullptr; ms_full = 0; ms_nsl = 1; ms_kt = 0; ms_P = nullptr; nB2 = 1; sAb2 = sBb2 = sCb2 = 0;
        tend0 = tend1 = tend2 = tend3 = tend4 = tend5 = tend6 = tend7 = 0; cnt0 = cnt1 = cnt2 = cnt3 = cnt4 = cnt5 = cnt6 = cnt7 = 0; list = nullptr; cap = 0;
    }
    __device__ __forceinline__ bool next(int i, Unit& u) const {
        u.nt = 0;
        if (cs_nsl >= 0) {
            const int L = i * G + c, NL = 128 * nN;
            if (L < NL) { int wgid = L; { const int q = NL / NXCD, xcd = wgid % NXCD, off = wgid / NXCD; wgid = xcd * q + off; }
                const int nig = WGM * nN, gid = wgid / nig, lp = gid * WGM + (wgid % nig) % WGM, pn = (wgid % nig) / WGM; const int pm = (lp >> 4) * 17 + 1 + (lp & 15);
                u.pm = pm; u.pn = pn; u.e = 0; u.a = A + (long)pm * sAm; u.b = Bt + (long)pn * sBn; u.c = C + (long)pm * cm1 + (long)pn * cn; return true; }
            const int q = L - NL; if (q >= 8 * nN * cs_nsl) return false;
            const int sl = q % cs_nsl, r = q / cs_nsl, pn = r % nN, b = r / nN, pm = b * 17;
            u.pm = pm; u.pn = pn; u.e = 0; u.nt = (sl == cs_nsl - 1) ? cs_ntl : 4; u.a = A + (long)pm * sAm + sl * 512; u.b = Bt + (long)pn * sBn + sl * 512;
            u.c = cs_P + ((long)(sl * 8 + b) * 256) * (cm1 / 256) + (long)pn * cn; return true;
        }
        const long L = (long)i * G + c; const int per = nM * nN; const long tot = (long)per * nB;
        int wgid, msl = -1;
        if (ms_nsl > 1) {
            if (L < ms_full) { wgid = (int)L; const int q = ms_full / NXCD, xcd = wgid % NXCD, off = wgid / NXCD; wgid = xcd * q + off; }
            else { const int q = (int)L - ms_full; msl = q % ms_nsl; wgid = ms_full + q / ms_nsl; if (wgid >= (int)tot) return false; }
        } else {
        if (L >= tot) return false;
        wgid = (int)L; { const int nwg = (int)tot; const int q = nwg / NXCD, r = nwg % NXCD, xcd = wgid % NXCD, off = wgid / NXCD; wgid = (xcd < r ? xcd * (q + 1) : r * (q + 1) + (xcd - r) * q) + off; }
        }
        const int b = wgid / per, w = wgid - b * per;
        const int nig = WGM * nN, gid = w / nig, fm = gid * WGM, gsz = (nM - fm) < WGM ? (nM - fm) : WGM;
        const int pm = fm + ((w % nig) % gsz), pn = (w % nig) / gsz;
        int e = 0;
        if (moe) { e = (pm >= tend0) + (pm >= tend1) + (pm >= tend2) + (pm >= tend3) + (pm >= tend4) + (pm >= tend5) + (pm >= tend6); }
        u.pm = pm; u.pn = pn; u.e = e;
        const int b1 = b / nB2, b2 = b - b1 * nB2;
        u.a = A + (long)b1 * sAb + (long)b2 * sAb2 + (long)pm * sAm;
        u.b = Bt + (long)b1 * sBb + (long)b2 * sBb2 + (long)pn * sBn + (long)e * sBe;
        u.c = C + (long)b1 * sCb + (long)b2 * sCb2 + (long)(pm % pmw) * cm1 + (long)(pm / pmw) * cm2 + (long)pn * cn;
        if (msl >= 0) { const int h = ms_kt / 2, k0 = 2 * ((h * msl) / ms_nsl), k1 = 2 * ((h * (msl + 1)) / ms_nsl);
            u.nt = k1 - k0; u.a += (long)k0 * 128; u.b += (long)k0 * 128;
            if (msl > 0) u.c = ms_P + (long)((msl - 1) * 32 + (pm - ms_full / nN)) * cm1 + (long)pn * cn; }
        return true;
    }
    __device__ __forceinline__ int gather_tok(const Unit& u, int r) const {
        const int e = u.e;
        const int ts = e == 0 ? 0 : e == 1 ? tend0 : e == 2 ? tend1 : e == 3 ? tend2 : e == 4 ? tend3 : e == 5 ? tend4 : e == 6 ? tend5 : tend6;
        const int cn_ = e == 0 ? cnt0 : e == 1 ? cnt1 : e == 2 ? cnt2 : e == 3 ? cnt3 : e == 4 ? cnt4 : e == 5 ? cnt5 : e == 6 ? cnt6 : cnt7;
        const int slot = (u.pm - ts) * 256 + r;
        return slot < cn_ ? list[(long)e * cap + slot] : 0;
    }
};

typedef __bf16 bf16x2_c __attribute__((ext_vector_type(2)));
__device__ __forceinline__ unsigned cvt_pk_bf16(float lo, float hi) { const f32x2 v = {lo, hi}; return __builtin_bit_cast(unsigned, __builtin_convertvector(v, bf16x2_c)); }

struct EpiPlain {
    static constexpr bool PERM = true;
    int ldc; float scale;
    __device__ __forceinline__ void operator()(const f32x4 (&acc)[2][2][4][2], const Unit& u, int wr, int wc, int fr, int fq) const {
        bf16_t* base = u.c + (size_t)(wr * 64 + fr) * ldc + wc * 32 + 8 * fq;
#pragma unroll
        for (int ai = 0; ai < 2; ++ai)
#pragma unroll
            for (int m = 0; m < 4; ++m) { bf16_t* rowp = base + (size_t)(ai * HALF + m * 16) * ldc;
#pragma unroll
                for (int bj = 0; bj < 2; ++bj) { const f32x4 v0 = acc[ai][bj][m][0] * scale, v1 = acc[ai][bj][m][1] * scale;
                    u32x4 w; w.x = cvt_pk_bf16(v0[0], v0[1]); w.y = cvt_pk_bf16(v0[2], v0[3]); w.z = cvt_pk_bf16(v1[0], v1[1]); w.w = cvt_pk_bf16(v1[2], v1[3]);
                    *(u32x4*)(rowp + bj * HALF) = w; } }
    }
};
struct EpiMirror {
    static constexpr bool PERM = true;
    int ldc_unused;
    __device__ __forceinline__ void operator()(const f32x4 (&acc)[2][2][4][2], const Unit& u, int wr, int wc, int fr, int fq) const {
        constexpr long LDC = 2048;
        const int kt = u.pm & 7, ri = u.pm >> 3; const unsigned sx = ri ? 0x80008000u : 0u;
        const int r0 = wr * 64 + fr;
        bf16_t* nb = u.c + (long)r0 * LDC + wc * 32 + 8 * fq;
        bf16_t* mb = u.c + (long)(4096 - 512 * kt - r0) * LDC + wc * 32 + 8 * fq;
#pragma unroll
        for (int ai = 0; ai < 2; ++ai)
#pragma unroll
            for (int m = 0; m < 4; ++m) { bf16_t* rowp = nb + (long)(ai * HALF + m * 16) * LDC; bf16_t* mirp = mb - (long)(ai * HALF + m * 16) * LDC;
                if (ai == 0 && m == 0) mirp = (kt == 0 && r0 == 0) ? rowp : mirp;
#pragma unroll
                for (int bj = 0; bj < 2; ++bj) { const f32x4 v0 = acc[ai][bj][m][0], v1 = acc[ai][bj][m][1];
                    u32x4 w; w.x = cvt_pk_bf16(v0[0], v0[1]); w.y = cvt_pk_bf16(v0[2], v0[3]); w.z = cvt_pk_bf16(v1[0], v1[1]); w.w = cvt_pk_bf16(v1[2], v1[3]);
                    *(u32x4*)(rowp + bj * HALF) = w;
                    u32x4 x; x.x = w.x ^ sx; x.y = w.y ^ sx; x.z = w.z ^ sx; x.w = w.w ^ sx;
                    *(u32x4*)(mirp + bj * HALF) = x; } }
    }
};
struct EpiFFT2 {
    static constexpr bool PERM = true;
    int unused;
    __device__ __forceinline__ void operator()(const f32x4 (&acc)[2][2][4][2], const Unit& u, int wr, int wc, int fr, int fq) const {
        constexpr long LDC = 2048;
        bf16_t* base = u.c + wr * 256 + (long)fr * 64 * LDC + wc * 32 + 8 * fq;
#pragma unroll
        for (int ai = 0; ai < 2; ++ai)
#pragma unroll
            for (int m = 0; m < 4; ++m) { bf16_t* rowp = base + (long)ai * LDC + (long)(m * 16) * 64 * LDC;
#pragma unroll
                for (int bj = 0; bj < 2; ++bj) { const f32x4 v0 = acc[ai][bj][m][0], v1 = acc[ai][bj][m][1];
                    u32x4 w; w.x = cvt_pk_bf16(v0[0], v0[1]); w.y = cvt_pk_bf16(v0[2], v0[3]); w.z = cvt_pk_bf16(v1[0], v1[1]); w.w = cvt_pk_bf16(v1[2], v1[3]);
                    *(u32x4*)(rowp + bj * HALF) = w; } }
    }
};
__device__ __forceinline__ float silu_mul(float g, float u) { return g * u * __builtin_amdgcn_rcpf(1.0f + __builtin_amdgcn_exp2f(-g * LOG2E)); }
struct EpiSwiGLU {
    static constexpr bool PERM = true;
    int ldc;
    __device__ __forceinline__ void operator()(const f32x4 (&acc)[2][2][4][2], const Unit& u, int wr, int wc, int fr, int fq) const {
        bf16_t* base = u.c + (size_t)(wr * 64 + fr) * ldc + wc * 32 + 8 * fq;
#pragma unroll
        for (int ai = 0; ai < 2; ++ai)
#pragma unroll
            for (int m = 0; m < 4; ++m) { bf16_t* rowp = base + (size_t)(ai * HALF + m * 16) * ldc;
                const f32x4 g0 = acc[ai][0][m][0], g1 = acc[ai][0][m][1], u0 = acc[ai][1][m][0], u1 = acc[ai][1][m][1];
                u32x4 w; w.x = cvt_pk_bf16(silu_mul(g0[0], u0[0]), silu_mul(g0[1], u0[1])); w.y = cvt_pk_bf16(silu_mul(g0[2], u0[2]), silu_mul(g0[3], u0[3]));
                w.z = cvt_pk_bf16(silu_mul(g1[0], u1[0]), silu_mul(g1[1], u1[1])); w.w = cvt_pk_bf16(silu_mul(g1[2], u1[2]), silu_mul(g1[3], u1[3]));
                *(u32x4*)rowp = w; }
    }
};

struct EpiSwiGLU8 {
    static constexpr bool PERM = true;
    int ldc; float sin, sout;
    __device__ __forceinline__ void operator()(const f32x4 (&acc)[2][2][4][2], const Unit& u, int wr, int wc, int fr, int fq) const {
        unsigned char* base = (unsigned char*)u.c + (size_t)(wr * 64 + fr) * ldc + wc * 32 + 8 * fq;
#pragma unroll
        for (int ai = 0; ai < 2; ++ai)
#pragma unroll
            for (int m = 0; m < 4; ++m) { unsigned char* rowp = base + (size_t)(ai * HALF + m * 16) * ldc;
                const f32x4 g0 = acc[ai][0][m][0] * sin, g1 = acc[ai][0][m][1] * sin, u0 = acc[ai][1][m][0] * sin, u1 = acc[ai][1][m][1] * sin;
                u32x2 w; w.x = pk_fp8x4(silu_mul(g0[0], u0[0]) * sout, silu_mul(g0[1], u0[1]) * sout, silu_mul(g0[2], u0[2]) * sout, silu_mul(g0[3], u0[3]) * sout);
                w.y = pk_fp8x4(silu_mul(g1[0], u1[0]) * sout, silu_mul(g1[1], u1[1]) * sout, silu_mul(g1[2], u1[2]) * sout, silu_mul(g1[3], u1[3]) * sout);
                *(u32x2*)rowp = w; }
    }
};
__device__ __forceinline__ v8i cat8(bf16x8 lo, bf16x8 hi) { const v4i a = __builtin_bit_cast(v4i, lo), b = __builtin_bit_cast(v4i, hi); return __builtin_shufflevector(a, b, 0, 1, 2, 3, 4, 5, 6, 7); }
template <class Epi, bool GATHER, bool FP8 = false>
__device__ __forceinline__ void gemm_phase(LAS unsigned char* lds, const int K, const int lda, const int ldb, const Sched& S, const Epi& E) {
    const int tid = threadIdx.x, wid = __builtin_amdgcn_readfirstlane(tid >> 6), lane = tid & 63, wr = wid >> 2, wc = wid & 3, fr = lane & 15, fq = lane >> 4;
    const int nt_def = K / BK;
    unsigned voffA[2], voffB[2]; int RA[2], CA2[2];
#pragma unroll
    for (int i = 0; i < 2; ++i) { int R, C; stage_rc(tid * 16 + i * 8192, R, C); const int Rb = Epi::PERM ? ((R & ~31) + perm32(R & 31)) : R;
        voffA[i] = (unsigned)(R * lda + C) * 2u; voffB[i] = (unsigned)(Rb * ldb + C) * 2u; RA[i] = R; CA2[i] = C * 2; }
    const size_t kstep = (size_t)(BK * 2);
    const size_t hstepA = (size_t)HALF * lda * 2, hstepB = (size_t)HALF * ldb * 2;
    const unsigned ldsw = (unsigned)wid * 1024u;
    const int aoff = lds_byte(wr * 64 + fr, fq * 8), boff = lds_byte(wc * 32 + fr, fq * 8);
    unsigned gAc[2][2], gAn[2][2];
#define PG8_SA(b, h) (((b) * 2 + (h)) * HTB)
#define PG8_SB(b, h) ((4 + (b) * 2 + (h)) * HTB)
#define PG8_STAGE(bufoff, gbase, voff) do { _Pragma("unroll") for (int _i = 0; _i < 2; ++_i) \
        __builtin_amdgcn_global_load_lds((const unsigned*)((const char*)(gbase) + (voff)[_i]), (LAS unsigned*)(lds + (bufoff) + ldsw + _i * 8192), 16, 0, 0); } while (0)
#define PG8_STAGE_A(bufoff, kbase, h, NX) do { if constexpr (GATHER) { unsigned _o[2]; _o[0] = (NX) ? gAn[h][0] : gAc[h][0]; _o[1] = (NX) ? gAn[h][1] : gAc[h][1]; PG8_STAGE(bufoff, kbase, _o); } \
        else { PG8_STAGE(bufoff, (kbase) + (h) * hstepA, voffA); } } while (0)
#define PG8_LDA(dst, b, h) do { _Pragma("unroll") for (int m = 0; m < 4; ++m) _Pragma("unroll") for (int k = 0; k < 2; ++k) dst[m][k] = *(const LAS bf16x8*)(lds + PG8_SA(b, h) + aoff + m * 2048 + k * 1024); } while (0)
#define PG8_LDB(dst, b, h) do { _Pragma("unroll") for (int n = 0; n < 2; ++n) _Pragma("unroll") for (int k = 0; k < 2; ++k) dst[n][k] = *(const LAS bf16x8*)(lds + PG8_SB(b, h) + boff + n * 2048 + k * 1024); } while (0)
#define PG8_MMA(ai, bj, At, Bt) do { __builtin_amdgcn_s_setprio(1); if constexpr (FP8) { _Pragma("unroll") for (int m = 0; m < 4; ++m) _Pragma("unroll") for (int n = 0; n < 2; ++n) \
        { const v8i _b8 = cat8(Bt[n][0], Bt[n][1]), _a8 = cat8(At[m][0], At[m][1]); asm volatile("v_mfma_f32_16x16x128_f8f6f4 %0, %1, %2, %0" : "+v"(acc[ai][bj][m][n]) : "v"(_b8), "v"(_a8)); } } \
        else { _Pragma("unroll") for (int m = 0; m < 4; ++m) _Pragma("unroll") for (int n = 0; n < 2; ++n) _Pragma("unroll") for (int k = 0; k < 2; ++k) \
        acc[ai][bj][m][n] = __builtin_amdgcn_mfma_f32_16x16x32_bf16(Bt[n][k], At[m][k], acc[ai][bj][m][n], 0, 0, 0); } __builtin_amdgcn_s_setprio(0); } while (0)
#define PG8_WAIT_V(n) asm volatile("s_waitcnt vmcnt(" #n ")" ::: "memory")
#define PG8_WAIT_L(n) asm volatile("s_waitcnt lgkmcnt(" #n ")" ::: "memory")
#define PG8_BAR __builtin_amdgcn_s_barrier()
#define PG8_SCHED __builtin_amdgcn_sched_barrier(0)
#define PG8_GATHER_OFFS(dst, un) do { _Pragma("unroll") for (int _h = 0; _h < 2; ++_h) _Pragma("unroll") for (int _i = 0; _i < 2; ++_i) { \
        const int _t = S.gather_tok(un, _h * HALF + RA[_i]); dst[_h][_i] = (unsigned)_t * (unsigned)(lda * 2) + (unsigned)CA2[_i]; } } while (0)
    Unit cur, nxt; int ui = 0;
    if (!S.next(0, cur)) return;
    f32x4 acc[2][2][4][2];
#pragma unroll
    for (int a = 0; a < 2; ++a)
#pragma unroll
        for (int b = 0; b < 2; ++b)
#pragma unroll
            for (int m = 0; m < 4; ++m)
#pragma unroll
                for (int n = 0; n < 2; ++n) acc[a][b][m][n] = (f32x4){0.f, 0.f, 0.f, 0.f};
    bf16x8 At[4][2], B0[2][2], B1[2][2];
    const char* cA = cur.a; const char* cB = cur.b;
    if constexpr (GATHER) { PG8_GATHER_OFFS(gAc, cur); _Pragma("unroll") for (int _h = 0; _h < 2; ++_h) _Pragma("unroll") for (int _i = 0; _i < 2; ++_i) gAn[_h][_i] = gAc[_h][_i]; }
    PG8_STAGE(PG8_SB(0, 0), cB, voffB); PG8_STAGE(PG8_SB(0, 1), cB + hstepB, voffB); PG8_STAGE_A(PG8_SA(0, 0), cA, 0, false); PG8_STAGE_A(PG8_SA(0, 1), cA, 1, false);
    if (wr == 1) PG8_BAR;
    PG8_WAIT_V(2); PG8_BAR;
    PG8_STAGE(PG8_SB(1, 0), cB + kstep, voffB); PG8_STAGE_A(PG8_SA(1, 0), cA + kstep, 0, false); PG8_STAGE(PG8_SB(1, 1), cB + hstepB + kstep, voffB);
    PG8_WAIT_V(6); PG8_BAR;
    for (;;) {
        const bool has_next = S.next(ui + 1, nxt);
        const char* nA = has_next ? nxt.a : cA; const char* nB = has_next ? nxt.b : cB;
        if constexpr (GATHER) { if (has_next) { PG8_GATHER_OFFS(gAn, nxt); } }
        const int nt = cur.nt ? cur.nt : nt_def;
#pragma unroll 1
        for (int t = 0; t < nt; t += 2) {
            const bool last = (t == nt - 2);
            const char* a1 = cA + (size_t)(t + 1) * kstep;
            const char* a2 = last ? nA : cA + (size_t)(t + 2) * kstep; const char* b2 = last ? nB : cB + (size_t)(t + 2) * kstep;
            const char* a3 = a2 + kstep; const char* b3 = b2 + kstep;
            PG8_LDB(B0, 0, 0); PG8_LDB(B1, 0, 1); PG8_SCHED; PG8_LDA(At, 0, 0); PG8_STAGE_A(PG8_SA(1, 1), a1, 1, false);
            PG8_WAIT_V(8); PG8_WAIT_L(0); PG8_BAR; PG8_MMA(0, 0, At, B0); PG8_MMA(0, 1, At, B1); PG8_BAR; PG8_SCHED;
            PG8_LDA(At, 0, 1); PG8_STAGE(PG8_SB(0, 0), b2, voffB); PG8_STAGE(PG8_SB(0, 1), b2 + hstepB, voffB); PG8_STAGE_A(PG8_SA(0, 0), a2, 0, last);
            PG8_WAIT_V(8); PG8_WAIT_L(0); PG8_BAR; PG8_MMA(1, 0, At, B0); PG8_MMA(1, 1, At, B1); PG8_BAR; PG8_SCHED;
            PG8_LDB(B0, 1, 0); PG8_LDB(B1, 1, 1); PG8_SCHED; PG8_LDA(At, 1, 0); PG8_STAGE_A(PG8_SA(0, 1), a2, 1, last);
            PG8_WAIT_V(8); PG8_WAIT_L(0); PG8_BAR; PG8_MMA(0, 0, At, B0); PG8_MMA(0, 1, At, B1); PG8_BAR; PG8_SCHED;
            PG8_LDA(At, 1, 1); PG8_STAGE(PG8_SB(1, 0), b3, voffB); PG8_STAGE(PG8_SB(1, 1), b3 + hstepB, voffB); PG8_STAGE_A(PG8_SA(1, 0), a3, 0, last);
            PG8_WAIT_V(8); PG8_WAIT_L(0); PG8_BAR; PG8_MMA(1, 0, At, B0); PG8_MMA(1, 1, At, B1); PG8_BAR; PG8_SCHED;
        }
        if constexpr (FP8) asm volatile("s_nop 15\n\ts_nop 15" ::: "memory");
        if (wr == 0) PG8_BAR;
        E(acc, cur, wr, wc, fr, fq);
        if (!has_next) break;
#pragma unroll
        for (int a = 0; a < 2; ++a)
#pragma unroll
            for (int b = 0; b < 2; ++b)
#pragma unroll
                for (int m = 0; m < 4; ++m)
#pragma unroll
                    for (int n = 0; n < 2; ++n) acc[a][b][m][n] = (f32x4){0.f, 0.f, 0.f, 0.f};
        cur = nxt; cA = nA; cB = nB; ++ui;
        if constexpr (GATHER) { _Pragma("unroll") for (int _h = 0; _h < 2; ++_h) _Pragma("unroll") for (int _i = 0; _i < 2; ++_i) gAc[_h][_i] = gAn[_h][_i]; }
        if (wr == 1) PG8_BAR;
    }
    PG8_WAIT_V(0);
    PG8_BAR;
#undef PG8_SA
#undef PG8_SB
#undef PG8_STAGE
#undef PG8_STAGE_A
#undef PG8_LDA
#undef PG8_LDB
#undef PG8_MMA
#undef PG8_WAIT_V
#undef PG8_WAIT_L
#undef PG8_BAR
#undef PG8_SCHED
#undef PG8_GATHER_OFFS
}
}

constexpr bool MLA_SPEC = true;
constexpr int QKV8 = 2;
constexpr bool ATT_LSUM = true;
constexpr bool ATT_PV8 = true;
constexpr bool MLA_QK8 = true;
constexpr bool ATT_QK8 = true;
#ifndef ATT_NEGM
#define ATT_NEGM false
#endif
namespace att {
__device__ __forceinline__ float add_nopk(float a, float b) { float o = a + b; asm("" : "+v"(o)); return o; }
typedef __bf16 bf16x2_t __attribute__((ext_vector_type(2)));
__device__ __forceinline__ unsigned cvt2(float lo, float hi) { const f32x2 v = {lo, hi}; return __builtin_bit_cast(unsigned, __builtin_convertvector(v, bf16x2_t)); }
template <int DK, int NQ, bool NOREF = false>
__device__ __forceinline__ bool unit(LAS unsigned char* lds, const bf16_t* Qp, int qpitch, const bf16_t* Kp, int kpitch, const bf16_t* Vtp, int vtpitch, bf16_t* Op, int opitch, int ntiles, int nrows,
                                     const float* qgain = nullptr, const float* qtab = nullptr, int qpos0 = -1) {
    constexpr bool QK8 = ATT_QK8 && (DK == 64 || (DK == 96 && MLA_QK8));
    constexpr bool PV8 = QK8 && ATT_PV8;
    constexpr int NKC = QK8 ? DK / 16 : DK / 8, KBUF = NKC * 1024, VBUF = PV8 ? 4096 : 8192, ND0 = DK / 16;
    const int tid = threadIdx.x, lane = tid & 63, r = lane & 31, h = lane >> 5; const int wid = __builtin_amdgcn_readfirstlane(tid >> 6);
    LAS unsigned char* Kb = lds; LAS unsigned char* Vb = lds + 2 * KBUF;
    bf16x8 qf[NQ][ND0]; v8i qf8[NQ], qf8b[NQ];
#pragma unroll
    for (int j = 0; j < NQ; ++j) { qf8[j] = (v8i){0, 0, 0, 0, 0, 0, 0, 0}; qf8b[j] = (v8i){0, 0, 0, 0, 0, 0, 0, 0}; }
#pragma unroll
    for (int j = 0; j < NQ; ++j) { const bf16_t* qrow = Qp + (size_t)(wid * (32 * NQ) + j * 32 + r) * qpitch + h * 8;
#pragma unroll
      for (int d0 = 0; d0 < ND0; ++d0) qf[j][d0] = *(const bf16x8*)(qrow + d0 * 16); }
    if constexpr (DK == 64) { if (qgain != nullptr) {
        float g[4][8];
#pragma unroll
        for (int d0 = 0; d0 < 4; ++d0) { const f32x4 g0 = *(const f32x4*)(qgain + 16 * d0 + 8 * h), g1 = *(const f32x4*)(qgain + 16 * d0 + 8 * h + 4);
#pragma unroll
            for (int i = 0; i < 4; ++i) { g[d0][i] = g0[i]; g[d0][4 + i] = g1[i]; } }
#pragma unroll
        for (int j = 0; j < NQ; ++j) {
            float x[4][8]; float ss = 0.f;
#pragma unroll
            for (int d0 = 0; d0 < 4; ++d0) { unpack8(__builtin_bit_cast(u32x4, qf[j][d0]), x[d0]);
#pragma unroll
                for (int i = 0; i < 8; ++i) ss += x[d0][i] * x[d0][i]; }
            ss += __shfl_xor(ss, 32);
            const float rs = (1.0f / sqrtf(ss * (1.0f / 64.0f) + NORM_EPS)) * (0.125f * LOG2E);
#pragma unroll
            for (int d0 = 0; d0 < 4; ++d0)
#pragma unroll
                for (int i = 0; i < 8; ++i) x[d0][i] *= rs * g[d0][i];
            if (qpos0 >= 0) { const int sp = qpos0 + wid * (32 * NQ) + j * 32 + r;
#pragma unroll
                for (int part = 0; part < 2; ++part) { const int pp = part ? (sp & 63) : (sp >> 6); const float* tc = qtab + pp * 16 + 8 * h;
                    const f32x4 c0 = *(const f32x4*)tc, c1 = *(const f32x4*)(tc + 4), s0 = *(const f32x4*)(tc + 1024), s1 = *(const f32x4*)(tc + 1028);
#pragma unroll
                    for (int i = 0; i < 8; ++i) { const float cs = i < 4 ? c0[i & 3] : c1[i & 3], sn = i < 4 ? s0[i & 3] : s1[i & 3];
                        const float x1 = x[2 * part][i], x2 = x[2 * part + 1][i]; x[2 * part][i] = x1 * cs - x2 * sn; x[2 * part + 1][i] = x2 * cs + x1 * sn; } } }
#pragma unroll
            for (int d0 = 0; d0 < 4; ++d0) qf[j][d0] = __builtin_bit_cast(bf16x8, pack8(x[d0]));
            if constexpr (QK8) { qf8[j] = (v8i){(int)pk_fp8x4(x[0][0], x[0][1], x[0][2], x[0][3]), (int)pk_fp8x4(x[0][4], x[0][5], x[0][6], x[0][7]), (int)pk_fp8x4(x[1][0], x[1][1], x[1][2], x[1][3]), (int)pk_fp8x4(x[1][4], x[1][5], x[1][6], x[1][7]),
                                               (int)pk_fp8x4(x[2][0], x[2][1], x[2][2], x[2][3]), (int)pk_fp8x4(x[2][4], x[2][5], x[2][6], x[2][7]), (int)pk_fp8x4(x[3][0], x[3][1], x[3][2], x[3][3]), (int)pk_fp8x4(x[3][4], x[3][5], x[3][6], x[3][7])}; }
        } } }
    if constexpr (DK == 96) { if (qtab != nullptr) {
        const float C2m = 0.10206207261596577f * LOG2E;
#pragma unroll
        for (int j = 0; j < NQ; ++j) {
            float x[6][8];
#pragma unroll
            for (int d0 = 0; d0 < 6; ++d0) unpack8(__builtin_bit_cast(u32x4, qf[j][d0]), x[d0]);
            if (qpos0 >= 0) { const int sp = qpos0 + wid * (32 * NQ) + j * 32 + r;
#pragma unroll
                for (int part = 0; part < 2; ++part) { const int pp = part ? (sp & 63) : (sp >> 6); const float* tc = qtab + 2048 + pp * 8;
                    const f32x4 c0 = *(const f32x4*)tc, c1 = *(const f32x4*)(tc + 4), s0 = *(const f32x4*)(tc + 512), s1 = *(const f32x4*)(tc + 516);
#pragma unroll
                    for (int i = 0; i < 8; ++i) { const float cs = i < 4 ? c0[i & 3] : c1[i & 3], sn = i < 4 ? s0[i & 3] : s1[i & 3];
                        const float xv = x[4 + part][i], pr = __shfl_xor(xv, 32);
                        x[4 + part][i] = h ? (xv * cs + pr * sn) : (xv * cs - pr * sn); } } }
#pragma unroll
            for (int d0 = 0; d0 < 6; ++d0) {
#pragma unroll
                for (int i = 0; i < 8; ++i) x[d0][i] *= C2m;
                qf[j][d0] = __builtin_bit_cast(bf16x8, pack8(x[d0])); }
            if constexpr (QK8) { qf8[j] = (v8i){(int)pk_fp8x4(x[0][0], x[0][1], x[0][2], x[0][3]), (int)pk_fp8x4(x[0][4], x[0][5], x[0][6], x[0][7]), (int)pk_fp8x4(x[1][0], x[1][1], x[1][2], x[1][3]), (int)pk_fp8x4(x[1][4], x[1][5], x[1][6], x[1][7]),
                                               (int)pk_fp8x4(x[2][0], x[2][1], x[2][2], x[2][3]), (int)pk_fp8x4(x[2][4], x[2][5], x[2][6], x[2][7]), (int)pk_fp8x4(x[3][0], x[3][1], x[3][2], x[3][3]), (int)pk_fp8x4(x[3][4], x[3][5], x[3][6], x[3][7])};
                                 qf8b[j] = (v8i){(int)pk_fp8x4(x[4][0], x[4][1], x[4][2], x[4][3]), (int)pk_fp8x4(x[4][4], x[4][5], x[4][6], x[4][7]), (int)pk_fp8x4(x[5][0], x[5][1], x[5][2], x[5][3]), (int)pk_fp8x4(x[5][4], x[5][5], x[5][6], x[5][7]), 0, 0, 0, 0}; }
        } } }
    const bf16_t* kg0 = Kp + (size_t)lane * kpitch + wid * 8; const bf16_t* kg1 = kg0 + 64; const bf16_t* vg = Vtp + (size_t)lane * vtpitch + wid * 8;
    const bool k1 = wid < NKC, k2 = (wid + 8) < NKC;
    const char* vg8 = (const char*)Vtp + (size_t)lane * (vtpitch * 2) + (wid & 3) * 16;
#define ATT_DMA(t, slot) do { if (k1) __builtin_amdgcn_global_load_lds((const unsigned*)(kg0 + (size_t)(t) * 64 * kpitch), (LAS unsigned*)(Kb + (slot) * KBUF + wid * 1024), 16, 0, 0); \
        if (k2) __builtin_amdgcn_global_load_lds((const unsigned*)(kg1 + (size_t)(t) * 64 * kpitch), (LAS unsigned*)(Kb + (slot) * KBUF + (wid + 8) * 1024), 16, 0, 0); \
        if constexpr (PV8) { if (wid >= 4) __builtin_amdgcn_global_load_lds((const unsigned*)(vg8 + (size_t)(t) * 64), (LAS unsigned*)(Vb + (slot) * VBUF + (wid - 4) * 1024), 16, 0, 0); } \
        else __builtin_amdgcn_global_load_lds((const unsigned*)(vg + (t) * 64), (LAS unsigned*)(Vb + (slot) * VBUF + wid * 1024), 16, 0, 0); } while (0)
    ATT_DMA(0, 0);
    __syncthreads();
    const int prow = (r & ~12) | ((r & 4) << 1) | ((r & 8) >> 1);
    const int koff = h * 1024 + prow * 16, voff = h * 1024 + r * 16;
    constexpr bool PVSHARE = (DK == 64) || (NQ == 1) || NOREF;
    constexpr bool NEGM = (NQ == 1);
    f32x16 o0[NQ], o1[NQ], negm[NEGM ? NQ : 1]; float mref[NQ], lrun[NQ];
    negm[0] = f32x16{};
#pragma unroll
    for (int j = 0; j < NQ; ++j) { o0[j] = f32x16{}; o1[j] = f32x16{}; mref[j] = 0.f; lrun[j] = 0.f; if constexpr (NEGM) negm[j] = f32x16{}; }
    constexpr float THR = 8.0f;
    constexpr bool LSUM = NOREF && PV8 && ATT_LSUM;
    f32x16 lacc[NQ];
#pragma unroll
    for (int j = 0; j < NQ; ++j) lacc[j] = f32x16{};
    v8i ones8 = {0x38383838, 0x38383838, 0x38383838, 0x38383838, 0x38383838, 0x38383838, 0x38383838, 0x38383838};
    if constexpr (LSUM) asm volatile("" : "+v"(ones8));
    for (int t = 0; t < ntiles; ++t) {
        const int cur = t & 1; const bool more = (t + 1 < ntiles);
        if constexpr (!NOREF && !QK8) {
#pragma unroll
        for (int j = 0; j < NQ; ++j)
#pragma unroll
            for (int d0 = 0; d0 < ND0; ++d0) asm volatile("" : "+v"(qf[j][d0]));
        }
        if (more) ATT_DMA(t + 1, cur ^ 1);
        const LAS unsigned char* kb = Kb + cur * KBUF + koff; const LAS unsigned char* vb = Vb + cur * VBUF + voff;
        f32x16 p0[NQ], p1[NQ];
#pragma unroll
        for (int j = 0; j < NQ; ++j) { if constexpr (NEGM) { p0[j] = negm[j]; p1[j] = negm[j]; } else { p0[j] = f32x16{}; p1[j] = f32x16{}; } }
        constexpr bool QKSEQ = false, PINST = false;
        if constexpr (QK8) {
            const LAS unsigned char* k8 = Kb + cur * KBUF + h * 2048 + prow * 16;
            const v8i a0 = pg8::cat8(*(const LAS bf16x8*)(k8), *(const LAS bf16x8*)(k8 + 1024)), a1 = pg8::cat8(*(const LAS bf16x8*)(k8 + 512), *(const LAS bf16x8*)(k8 + 1024 + 512));
#pragma unroll
            for (int j = 0; j < NQ; ++j) {
                if constexpr (PV8) {
                asm volatile("v_mfma_f32_32x32x64_f8f6f4 %0, %1, %2, -4.0" : "=&v"(p0[j]) : "v"(a0), "v"(qf8[j]));
                asm volatile("v_mfma_f32_32x32x64_f8f6f4 %0, %1, %2, -4.0" : "=&v"(p1[j]) : "v"(a1), "v"(qf8[j])); } else {
                asm volatile("v_mfma_f32_32x32x64_f8f6f4 %0, %1, %2, 0" : "=&v"(p0[j]) : "v"(a0), "v"(qf8[j]));
                asm volatile("v_mfma_f32_32x32x64_f8f6f4 %0, %1, %2, 0" : "=&v"(p1[j]) : "v"(a1), "v"(qf8[j])); } }
            if constexpr (DK == 96) {
                const bf16x8 z8 = bf16x8{};
                const v8i b0 = pg8::cat8(*(const LAS bf16x8*)(Kb + cur * KBUF + (4 + h) * 1024 + prow * 16), z8), b1 = pg8::cat8(*(const LAS bf16x8*)(Kb + cur * KBUF + (4 + h) * 1024 + prow * 16 + 512), z8);
#pragma unroll
                for (int j = 0; j < NQ; ++j) {
                    asm volatile("v_mfma_f32_32x32x64_f8f6f4 %0, %1, %2, %0" : "+v"(p0[j]) : "v"(b0), "v"(qf8b[j]));
                    asm volatile("v_mfma_f32_32x32x64_f8f6f4 %0, %1, %2, %0" : "+v"(p1[j]) : "v"(b1), "v"(qf8b[j])); } }
            static_assert(!QK8 || NQ == 2, "QK8 assumes two query blocks");
            asm volatile("s_nop 15\n\ts_nop 7" : "+v"(p0[0]), "+v"(p1[0]), "+v"(p0[NQ - 1]), "+v"(p1[NQ - 1]));
        } else
        if constexpr (!QKSEQ) {
#pragma unroll
        for (int d0 = 0; d0 < ND0; ++d0) { const bf16x8 a0 = *(const LAS bf16x8*)(kb + d0 * 2048), a1 = *(const LAS bf16x8*)(kb + d0 * 2048 + 512);
#pragma unroll
            for (int j = 0; j < NQ; ++j) { p0[j] = __builtin_amdgcn_mfma_f32_32x32x16_bf16(a0, qf[j][d0], p0[j], 0, 0, 0); p1[j] = __builtin_amdgcn_mfma_f32_32x32x16_bf16(a1, qf[j][d0], p1[j], 0, 0, 0); } }
        }
        if constexpr (PINST) __builtin_amdgcn_sched_barrier(0);
        bf16x8 pb[NQ][4]; v8i p8[NQ];
#pragma unroll
        for (int j = 0; j < NQ; ++j) {
            if constexpr (QKSEQ) { asm volatile("" ::: "memory");
#pragma unroll
                for (int d0 = 0; d0 < ND0; ++d0) { const bf16x8 a0 = *(const LAS bf16x8*)(kb + d0 * 2048), a1 = *(const LAS bf16x8*)(kb + d0 * 2048 + 512);
                    p0[j] = __builtin_amdgcn_mfma_f32_32x32x16_bf16(a0, qf[j][d0], p0[j], 0, 0, 0); p1[j] = __builtin_amdgcn_mfma_f32_32x32x16_bf16(a1, qf[j][d0], p1[j], 0, 0, 0); } }
            if constexpr (!NOREF) {
            float mx = fmaxf(fmaxf(p0[j][0], p0[j][1]), p1[j][0]);
#pragma unroll
            for (int i = 2; i < 16; i += 2) mx = fmaxf(fmaxf(mx, p0[j][i]), p0[j][i + 1]);
#pragma unroll
            for (int i = 1; i < 15; i += 2) mx = fmaxf(fmaxf(mx, p1[j][i]), p1[j][i + 1]);
            mx = fmaxf(mx, p1[j][15]);
            mx = fmaxf(mx, __shfl_xor(mx, 32));
            if constexpr (!NEGM) mx -= mref[j];
            if (t == 0 || __any(mx > THR)) {
                const float dl = (t == 0) ? mx : fmaxf(mx, 0.f); const float f = __builtin_amdgcn_exp2f(-dl);
                mref[j] += dl; lrun[j] *= f;
#pragma unroll
                for (int i = 0; i < 16; ++i) { o0[j][i] *= f; o1[j][i] *= f; }
                if constexpr (NEGM) {
#pragma unroll
                    for (int i = 0; i < 16; ++i) { p0[j][i] -= dl; p1[j][i] -= dl; negm[j][i] = -mref[j]; } }
            }
            }
            const float sub = NEGM ? 0.f : mref[j];
            float ls = lrun[j];
            if constexpr (LSUM) {
#pragma unroll
            for (int i = 0; i < 16; ++i) { p0[j][i] = __builtin_amdgcn_exp2f(p0[j][i]); p1[j][i] = __builtin_amdgcn_exp2f(p1[j][i]); }
            } else {
#pragma unroll
            for (int i = 0; i < 16; ++i) { p0[j][i] = __builtin_amdgcn_exp2f((NEGM || NOREF) ? p0[j][i] : p0[j][i] - sub); ls = add_nopk(ls, p0[j][i]); }
#pragma unroll
            for (int i = 0; i < 16; ++i) { p1[j][i] = __builtin_amdgcn_exp2f((NEGM || NOREF) ? p1[j][i] : p1[j][i] - sub); ls = add_nopk(ls, p1[j][i]); }
            }
            lrun[j] = ls;
            if constexpr (PINST) { asm volatile("" : "+v"(lrun[j])); __builtin_amdgcn_sched_barrier(0); }
            if constexpr (PV8) {
                int w_[8];
#pragma unroll
                for (int q = 0; q < 4; ++q) { int t0 = __builtin_amdgcn_cvt_pk_bf8_f32(p0[j][4 * q], p0[j][4 * q + 1], 0, false); w_[q] = __builtin_amdgcn_cvt_pk_bf8_f32(p0[j][4 * q + 2], p0[j][4 * q + 3], t0, true);
                                              int t1 = __builtin_amdgcn_cvt_pk_bf8_f32(p1[j][4 * q], p1[j][4 * q + 1], 0, false); w_[4 + q] = __builtin_amdgcn_cvt_pk_bf8_f32(p1[j][4 * q + 2], p1[j][4 * q + 3], t1, true); }
                p8[j] = (v8i){w_[0], w_[1], w_[2], w_[3], w_[4], w_[5], w_[6], w_[7]};
            } else {
#pragma unroll
            for (int s = 0; s < 4; ++s) { u32x4 pw;
                if (s < 2) { pw.x = cvt2(p0[j][8 * s + 0], p0[j][8 * s + 1]); pw.y = cvt2(p0[j][8 * s + 2], p0[j][8 * s + 3]); pw.z = cvt2(p0[j][8 * s + 4], p0[j][8 * s + 5]); pw.w = cvt2(p0[j][8 * s + 6], p0[j][8 * s + 7]); }
                else { const int q = s - 2; pw.x = cvt2(p1[j][8 * q + 0], p1[j][8 * q + 1]); pw.y = cvt2(p1[j][8 * q + 2], p1[j][8 * q + 3]); pw.z = cvt2(p1[j][8 * q + 4], p1[j][8 * q + 5]); pw.w = cvt2(p1[j][8 * q + 6], p1[j][8 * q + 7]); }
                pb[j][s] = __builtin_bit_cast(bf16x8, pw); }
            }
            if constexpr (PINST) __builtin_amdgcn_sched_barrier(0);
            if constexpr (!PVSHARE && !PV8) {
#pragma unroll
                for (int s = 0; s < 4; ++s) { const bf16x8 v0 = *(const LAS bf16x8*)(vb + s * 2048), v1 = *(const LAS bf16x8*)(vb + s * 2048 + 512);
                    o0[j] = __builtin_amdgcn_mfma_f32_32x32x16_bf16(v0, pb[j][s], o0[j], 0, 0, 0); o1[j] = __builtin_amdgcn_mfma_f32_32x32x16_bf16(v1, pb[j][s], o1[j], 0, 0, 0); }
                if constexpr (NOREF) __builtin_amdgcn_sched_barrier(0); }
        }
        if constexpr (PV8) {
            const LAS unsigned char* v8 = Vb + cur * VBUF + h * 2048 + r * 16;
            const v8i va = pg8::cat8(*(const LAS bf16x8*)(v8), *(const LAS bf16x8*)(v8 + 1024)), vb1 = pg8::cat8(*(const LAS bf16x8*)(v8 + 512), *(const LAS bf16x8*)(v8 + 1024 + 512));
#pragma unroll
            for (int j = 0; j < NQ; ++j) {
                asm volatile("s_nop 1\n\tv_mfma_f32_32x32x64_f8f6f4 %0, %1, %2, %0 cbsz:0 blgp:1" : "+v"(o0[j]) : "v"(va), "v"(p8[j]));
                asm volatile("v_mfma_f32_32x32x64_f8f6f4 %0, %1, %2, %0 cbsz:0 blgp:1" : "+v"(o1[j]) : "v"(vb1), "v"(p8[j]));
                if constexpr (LSUM) asm volatile("s_nop 1\n\tv_mfma_f32_32x32x64_f8f6f4 %0, %1, %2, %0 cbsz:0 blgp:1" : "+v"(lacc[j]) : "v"(ones8), "v"(p8[j])); }
        } else
        if constexpr (PVSHARE) {
#pragma unroll
        for (int s = 0; s < 4; ++s) {
            const bf16x8 v0 = *(const LAS bf16x8*)(vb + s * 2048), v1 = *(const LAS bf16x8*)(vb + s * 2048 + 512);
#pragma unroll
            for (int j = 0; j < NQ; ++j) { o0[j] = __builtin_amdgcn_mfma_f32_32x32x16_bf16(v0, pb[j][s], o0[j], 0, 0, 0); o1[j] = __builtin_amdgcn_mfma_f32_32x32x16_bf16(v1, pb[j][s], o1[j], 0, 0, 0); }
        }
        }
        __syncthreads();
    }
#undef ATT_DMA
    if constexpr (LSUM) asm volatile("s_nop 15\n\ts_nop 7" : "+v"(lacc[0]), "+v"(lacc[NQ - 1]) : "v"(ones8));
    if constexpr (PV8) asm volatile("s_nop 15\n\ts_nop 7" : "+v"(o0[0]), "+v"(o1[0]), "+v"(o0[NQ - 1]), "+v"(o1[NQ - 1]));
    if constexpr (NOREF && DK == 96) { int bad = 0;
#pragma unroll
        for (int j = 0; j < NQ; ++j) { const int qr = wid * (32 * NQ) + j * 32 + r; const float ltot = LSUM ? lacc[j][0] : lrun[j] + __shfl_xor(lrun[j], 32);
            if (qr < nrows && !(ltot >= 8.7e-19f && ltot <= (PV8 ? 3.2e4f : 1.2e30f))) bad = 1; }
        if (__syncthreads_or(bad)) return false; }
#pragma unroll
    for (int j = 0; j < NQ; ++j) {
        const int qr = wid * (32 * NQ) + j * 32 + r;
        const float ltot = LSUM ? lacc[j][0] : lrun[j] + __shfl_xor(lrun[j], 32); const float inv = 1.0f / ltot;
        if (qr < nrows) {
            bf16_t* orow = Op + (size_t)qr * opitch + 4 * h;
#pragma unroll
            for (int g = 0; g < 4; ++g) {
                u32x2 w0, w1; w0.x = pk2(o0[j][4 * g] * inv, o0[j][4 * g + 1] * inv); w0.y = pk2(o0[j][4 * g + 2] * inv, o0[j][4 * g + 3] * inv);
                w1.x = pk2(o1[j][4 * g] * inv, o1[j][4 * g + 1] * inv); w1.y = pk2(o1[j][4 * g + 2] * inv, o1[j][4 * g + 3] * inv);
                *(u32x2*)(orow + 8 * g) = w0; *(u32x2*)(orow + 32 + 8 * g) = w1;
            }
        }
    }
    return true;
}
}

#define XB_TMO      128
#define XB_XCNT(j)  (256  + 64 * (j))
#define XB_XSUB(j)  (1280 + 64 * (j))
#define XB_XGEN(j)  (2304 + 64 * (j))
#define XB_TOP      3328
#define XB_TOPGEN   3392
#define XCD_BAR_WORDS 3456
#define XB_SPIN_CAP (1u << 22)
__device__ __forceinline__ unsigned xb_ld(unsigned* p)              { return __hip_atomic_load(p, __ATOMIC_RELAXED, __HIP_MEMORY_SCOPE_AGENT); }
__device__ __forceinline__ unsigned xb_add(unsigned* p, unsigned v) { return __hip_atomic_fetch_add(p, v, __ATOMIC_RELAXED, __HIP_MEMORY_SCOPE_AGENT); }
__device__ __forceinline__ unsigned xb_xcc_id() { return (unsigned)__builtin_amdgcn_s_getreg((3 << 11) | 20) & 0xFu; }
#define XB_SPIN(cond, bar) do { unsigned _sp = 0; while (cond) { __builtin_amdgcn_s_sleep(1); \
    if ((++_sp & 255u) == 0u) { if (xb_ld(&(bar)[XB_TMO])) break; if (_sp > XB_SPIN_CAP) { atomicAdd(&(bar)[XB_TMO], 1u); break; } } } } while (0)
struct XcdBarrier { unsigned* bar; unsigned x; volatile LAS unsigned* st; };
__device__ __forceinline__ XcdBarrier xcd_barrier_post(unsigned* bar, volatile LAS unsigned* st) {
    XcdBarrier b; b.bar = bar; b.x = xb_xcc_id(); b.st = st;
    if (threadIdx.x == 0) (void)xb_add(&bar[XB_XCNT(b.x)], 1u);
    return b;
}
__device__ __forceinline__ void xcd_barrier_complete(unsigned* bar, unsigned x, unsigned& nloc, unsigned& nx) {
    const unsigned G = gridDim.x * gridDim.y * gridDim.z;
    unsigned sum, cnt, mine, sp = 0u;
    for (;;) {
        sum = 0u; cnt = 0u; mine = 0u;
#pragma unroll
        for (unsigned j = 0; j < 16; ++j) { const unsigned c = xb_ld(&bar[XB_XCNT(j)]); sum += c; cnt += (c > 0u) ? 1u : 0u; mine = (j == x) ? c : mine; }
        if (sum == G) break;
        __builtin_amdgcn_s_sleep(1);
        if ((++sp & 255u) == 0u) { if (xb_ld(&bar[XB_TMO])) break; if (sp > XB_SPIN_CAP) { atomicAdd(&bar[XB_TMO], 1u); break; } }
    }
    nloc = mine > 0u ? mine : 1u; nx = cnt > 0u ? cnt : 1u;
}
__device__ __forceinline__ void xcd_barrier(const XcdBarrier& b) {
    asm volatile("s_waitcnt vmcnt(0)" ::: "memory");
    __syncthreads();
    if (threadIdx.x == 0) {
        unsigned* bar = b.bar;
        __builtin_amdgcn_s_waitcnt(0);
        unsigned nloc = b.st[0], nx = b.st[1];
        if (nloc == 0u) { xcd_barrier_complete(bar, b.x, nloc, nx); b.st[0] = nloc; b.st[1] = nx; }
        const unsigned old = xb_add(&bar[XB_XSUB(b.x)], 1u);
        const unsigned gen = old / nloc;
        if (old + 1u == (gen + 1u) * nloc) {
            __builtin_amdgcn_fence(__ATOMIC_RELEASE, "agent");
            asm volatile("s_waitcnt vmcnt(0)" ::: "memory");
            const unsigned og = xb_add(&bar[XB_TOP], 1u);
            const unsigned tg = og / nx;
            if (og + 1u == (tg + 1u) * nx) xb_add(&bar[XB_TOPGEN], 1u);
            else XB_SPIN(xb_ld(&bar[XB_TOPGEN]) == tg, bar);
            __builtin_amdgcn_fence(__ATOMIC_ACQUIRE, "agent");
            xb_add(&bar[XB_XGEN(b.x)], 1u);
            asm volatile("s_waitcnt vmcnt(0)" ::: "memory");
        } else {
            XB_SPIN(xb_ld(&bar[XB_XGEN(b.x)]) == gen, bar);
            __builtin_amdgcn_fence(__ATOMIC_ACQUIRE, "agent");
            asm volatile("s_waitcnt vmcnt(0)" ::: "memory");
        }
    }
    __syncthreads();
}

struct Frame {
    LAS unsigned char* lds;
    unsigned* ctl;
    unsigned char* ws;
    int tid, lane, wave, vcu, G, bx;
    const float* in[23];
    float* out;
};
#define WSP(T, off) ((T*)(F.ws + (off)))

struct Row { f32x4 v[4]; };
__device__ __forceinline__ Row ld_row_f32(const float* p, int lane) { Row r; const f32x4* q = (const f32x4*)p + lane;
#pragma unroll
    for (int j = 0; j < 4; ++j) r.v[j] = q[64 * j]; return r; }
__device__ __forceinline__ Row ld_row_f32_nt(const float* p, int lane) { Row r; const f32x4* q = (const f32x4*)p + lane;
#pragma unroll
    for (int j = 0; j < 4; ++j) r.v[j] = __builtin_nontemporal_load(q + 64 * j); return r; }
__device__ __forceinline__ void st_row_f32(float* p, int lane, const Row& r) { f32x4* q = (f32x4*)p + lane;
#pragma unroll
    for (int j = 0; j < 4; ++j) __builtin_nontemporal_store(r.v[j], q + 64 * j); }
__device__ __forceinline__ Row ld_row_bf16(const bf16_t* p, int lane) { Row r; const u32x2* q = (const u32x2*)p + lane;
#pragma unroll
    for (int j = 0; j < 4; ++j) { const u32x2 w = q[64 * j]; r.v[j] = (f32x4){bflo(w.x), bfhi(w.x), bflo(w.y), bfhi(w.y)}; } return r; }
__device__ __forceinline__ void st_row_bf16(bf16_t* p, int lane, const Row& r) { u32x2* q = (u32x2*)p + lane;
#pragma unroll
    for (int j = 0; j < 4; ++j) { u32x2 w; w.x = pk2(r.v[j][0], r.v[j][1]); w.y = pk2(r.v[j][2], r.v[j][3]); __builtin_nontemporal_store(w, q + 64 * j); } }
__device__ __forceinline__ float row_rstd(const Row& r) { float s = 0.f;
#pragma unroll
    for (int j = 0; j < 4; ++j) s += (r.v[j][0] * r.v[j][0] + r.v[j][1] * r.v[j][1]) + (r.v[j][2] * r.v[j][2] + r.v[j][3] * r.v[j][3]);
    return 1.0f / sqrtf(wave_sum(s) * (1.0f / D) + NORM_EPS); }
__device__ __forceinline__ Row modnorm(const Row& x, const float* g, const float* shift, const float* scale, int lane) {
    const float rs = row_rstd(x); const Row G = ld_row_f32(g, lane), SH = ld_row_f32(shift, lane), SC = ld_row_f32(scale, lane); Row h;
#pragma unroll
    for (int j = 0; j < 4; ++j) h.v[j] = (x.v[j] * rs * G.v[j]) * (1.0f + SC.v[j]) + SH.v[j];
    return h; }
__device__ __forceinline__ Row resid(const Row& x, const Row& y, const float* g, const float* gate, int lane) {
    const float rs = row_rstd(y); const Row G = ld_row_f32(g, lane), GT = ld_row_f32(gate, lane); Row o;
#pragma unroll
    for (int j = 0; j < 4; ++j) o.v[j] = x.v[j] + GT.v[j] * (y.v[j] * rs * G.v[j]);
    return o; }
__device__ __forceinline__ const float* modp(Frame& F, int layer, int mrow, int chunk) { return WSP(const float, WS_MOD) + ((size_t)(layer * 9 + mrow) * 6 + chunk) * D; }
__device__ __forceinline__ const float* normg(Frame& F, int layer, int k) { return F.in[6] + (size_t)(layer * 4 + k) * D; }

__device__ __forceinline__ void cvt_tile(const float* src, size_t ldsrc, bf16_t* dst, size_t lddst, int lane) {
    const int kg = lane >> 3, ng = lane & 7;
    const float* p = src + (size_t)(8 * kg) * ldsrc + 4 * ng;
    f32x4 v[8];
#pragma unroll
    for (int j = 0; j < 8; ++j) v[j] = *(const f32x4*)(p + (size_t)j * ldsrc);
    bf16_t* o = dst + (size_t)(4 * ng) * lddst + 8 * kg;
#pragma unroll
    for (int q = 0; q < 4; ++q) { u32x4 w; w.x = pk2(v[0][q], v[1][q]); w.y = pk2(v[2][q], v[3][q]); w.z = pk2(v[4][q], v[5][q]); w.w = pk2(v[6][q], v[7][q]); *(u32x4*)(o + (size_t)q * lddst) = w; }
}
template <bool GU>
__device__ __forceinline__ void cvt_matrix(const float* W, int K, int N, bf16_t* WT, int gw, int NGW, int lane) {
    const int nblk = N / 32, nitem = (K / 64) * nblk, FF = N / 2;
    for (int it = gw; it < nitem; it += NGW) {
        const int kb = it / nblk, nb = it % nblk, k0 = 64 * kb, n0 = 32 * nb;
        int drow = n0;
        if (GU) { const int half = n0 >= FF ? 1 : 0, n1 = n0 - half * FF; drow = 256 * (n1 / 128) + 128 * half + (n1 % 128); }
        cvt_tile(W + (size_t)k0 * N + n0, (size_t)N, WT + (size_t)drow * K + k0, (size_t)K, lane);
    }
}
__device__ __forceinline__ void cvt_tile8(const float* src, size_t ldsrc, unsigned char* dst, size_t lddst, float sc, int lane) {
    const int kg = lane >> 3, ng = lane & 7;
    const float* p = src + (size_t)(16 * kg) * ldsrc + 4 * ng;
    f32x4 v[16];
#pragma unroll
    for (int j = 0; j < 16; ++j) v[j] = *(const f32x4*)(p + (size_t)j * ldsrc);
    unsigned char* o = dst + (size_t)(4 * ng) * lddst + 16 * kg;
#pragma unroll
    for (int q = 0; q < 4; ++q) { u32x4 w;
        w.x = pk_fp8x4(v[0][q] * sc, v[1][q] * sc, v[2][q] * sc, v[3][q] * sc); w.y = pk_fp8x4(v[4][q] * sc, v[5][q] * sc, v[6][q] * sc, v[7][q] * sc);
        w.z = pk_fp8x4(v[8][q] * sc, v[9][q] * sc, v[10][q] * sc, v[11][q] * sc); w.w = pk_fp8x4(v[12][q] * sc, v[13][q] * sc, v[14][q] * sc, v[15][q] * sc);
        *(u32x4*)(o + (size_t)q * lddst) = w; }
}
template <bool GU>
__device__ __forceinline__ void cvt_matrix8(const float* W, int K, int N, unsigned char* WT, float sc, int nmat, int gw, int NGW, int lane) {
    const int nblk = N / 32, per = (K / 128) * nblk, nitem = per * nmat, FF = N / 2;
    for (int it = gw; it < nitem; it += NGW) {
        const int m = it / per, r = it - m * per, kb = r / nblk, nb = r % nblk, k0 = 128 * kb, n0 = 32 * nb;
        int drow = n0;
        if (GU) { const int half = n0 >= FF ? 1 : 0, n1 = n0 - half * FF; drow = 256 * (n1 / 128) + 128 * half + (n1 % 128); }
        cvt_tile8(W + (size_t)m * K * N + (size_t)k0 * N + n0, (size_t)N, WT + (size_t)m * K * N + (size_t)drow * K + k0, (size_t)K, sc, lane);
    }
}
__device__ __forceinline__ float silu_f(float x) { return x / (1.0f + __expf(-x)); }

__device__ __forceinline__ void p_prologue(Frame& F) {
    LAS float* sc = (LAS float*)(F.lds + 69632);
    const int gw = F.vcu * NWAVES + F.wave, NGW = F.G * NWAVES, lane = F.lane;
    for (int i = F.tid; i < 9 * D; i += 512) { const int r = i / D, k = i % D; sc[i] = silu_f(r < 8 ? F.in[1][r * D + k] : F.in[3][k]); }
    __syncthreads();
    { LAS float* red = (LAS float*)F.lds;
      for (int bi = F.vcu; bi < 4 * 192; bi += F.G) {
        const int l = bi / 192, n0 = (bi % 192) * 32, cg = lane & 7, kq = lane >> 3, kb = F.wave * 8 + kq;
        const float* w = F.in[4] + (size_t)l * D * 6144 + (size_t)kb * 6144 + n0 + 4 * cg;
        f32x4 wv[16];
#pragma unroll
        for (int i = 0; i < 16; ++i) wv[i] = *(const f32x4*)(w + (size_t)i * 64 * 6144);
        f32x4 a[9];
#pragma unroll
        for (int r = 0; r < 9; ++r) a[r] = (f32x4){0.f, 0.f, 0.f, 0.f};
#pragma unroll
        for (int i = 0; i < 16; ++i) {
#pragma unroll
            for (int r = 0; r < 9; ++r) { const float sv = sc[r * D + kb + 64 * i]; a[r] = a[r] + wv[i] * sv; } }
#pragma unroll
        for (int r = 0; r < 9; ++r) {
#pragma unroll
            for (int q = 0; q < 4; ++q) { float v = a[r][q]; v += __shfl_xor(v, 8); v += __shfl_xor(v, 16); v += __shfl_xor(v, 32); a[r][q] = v; } }
        if (kq == 0) {
#pragma unroll
            for (int r = 0; r < 9; ++r) *(LAS f32x4*)(red + (F.wave * 9 + r) * 32 + 4 * cg) = a[r]; }
        __syncthreads();
        if (F.tid < 288) { const int r = F.tid >> 5, c = F.tid & 31; float sacc = F.in[5][l * 6144 + n0 + c];
#pragma unroll
            for (int w8 = 0; w8 < 8; ++w8) sacc += red[(w8 * 9 + r) * 32 + c];
            WSP(float, WS_MOD)[(size_t)(l * 9 + r) * 6144 + n0 + c] = sacc; }
        __syncthreads();
      } }
    for (int it = gw; it < 2048; it += NGW) {
        const int g = it >> 9, ch = (it >> 8) & 1, n0 = (it & 255) * 4, c0 = ch * 128 + 2 * lane; const float* fw = F.in[11] + (size_t)(g * 256) * D + n0;
        const f32x2 wr = {__builtin_amdgcn_cosf((float)c0 * (1.0f / 256.0f)), __builtin_amdgcn_cosf((float)(c0 + 1) * (1.0f / 256.0f))};
        const f32x2 wi = {__builtin_amdgcn_sinf((float)c0 * (1.0f / 256.0f)), __builtin_amdgcn_sinf((float)(c0 + 1) * (1.0f / 256.0f))};
        f32x2 ac[4], as[4];
#pragma unroll
        for (int q = 0; q < 4; ++q) { ac[q] = (f32x2){0.f, 0.f}; as[q] = (f32x2){0.f, 0.f}; }
        for (int l0 = 0; l0 < 256; l0 += 32) {
            f32x2 cr = {__builtin_amdgcn_cosf((float)((l0 * c0) & 255) * (1.0f / 256.0f)), __builtin_amdgcn_cosf((float)((l0 * (c0 + 1)) & 255) * (1.0f / 256.0f))};
            f32x2 ci = {__builtin_amdgcn_sinf((float)((l0 * c0) & 255) * (1.0f / 256.0f)), __builtin_amdgcn_sinf((float)((l0 * (c0 + 1)) & 255) * (1.0f / 256.0f))};
            f32x4 f[32];
#pragma unroll
            for (int l = 0; l < 32; ++l) f[l] = *(const f32x4*)(fw + (size_t)(l0 + l) * D);
#pragma unroll
            for (int l = 0; l < 32; ++l) {
#pragma unroll
                for (int q = 0; q < 4; ++q) { ac[q] = ac[q] + cr * f[l][q]; as[q] = as[q] + ci * f[l][q]; }
                const f32x2 nr = cr * wr - ci * wi, ni = cr * wi + ci * wr; cr = nr; ci = ni; }
        }
        bf16_t* o = WSP(bf16_t, WS_WFP) + (size_t)n0 * 2048 + g * 512 + c0;
#pragma unroll
        for (int q = 0; q < 4; ++q) { *(unsigned*)(o + (size_t)q * 2048) = pk2(ac[q][0], ac[q][1]); *(unsigned*)(o + (size_t)q * 2048 + 256) = pk2(-as[q][0], -as[q][1]); }
    }
    { const long NT = (long)F.G * 512; const long gt = (long)F.vcu * 512 + F.tid;
      if (FOURIER_FFT) {
        for (long it = gt; it < (long)(512 + 256) * 32; it += NT) { const int row = (int)(it >> 5), c8 = (int)(it & 31); float v[8];
#pragma unroll
            for (int j = 0; j < 8; ++j) { const int col = c8 * 8 + j; float x = 0.f;
                if (row < 512) { const int cl = row >> 7, ri = (row >> 6) & 1, kl = row & 63, cl2 = col >> 6, a = col & 63;
                    if (cl == cl2) { const float ph = (float)((kl * a) & 63) * (1.0f / 64.0f); x = ri ? -__builtin_amdgcn_sinf(ph) : __builtin_amdgcn_cosf(ph); } }
                else { const int r2 = row - 512, kl = r2 >> 7, ro = (r2 >> 6) & 1, kh = r2 & 63, kl2 = col >> 7, ri = (col >> 6) & 1, c = col & 63;
                    if (kl == kl2) { const float ph = (float)((kh * c) & 63) * (1.0f / 64.0f); const float cs = __builtin_amdgcn_cosf(ph), sn = __builtin_amdgcn_sinf(ph);
                        x = (ro == 0 ? (ri == 0 ? cs : sn) : (ri == 0 ? sn : -cs)) * (1.0f / 1024.0f); } }
                v[j] = x; }
            u32x4 w; w.x = pk2(v[0], v[1]); w.y = pk2(v[2], v[3]); w.z = pk2(v[4], v[5]); w.w = pk2(v[6], v[7]);
            *(u32x4*)((row < 512 ? WSP(bf16_t, WS_BD1) + (size_t)row * 256 : WSP(bf16_t, WS_T2BD) + (size_t)(row - 512) * 256) + c8 * 8) = w; }
      } else
      for (long it = gt; it < (long)4096 * 512; it += NT) { const int row = (int)(it >> 9), s8 = (int)(it & 511), ri = row >> 11, k = row & 2047; float v[8];
#pragma unroll
          for (int j = 0; j < 8; ++j) { const float ph = (float)((k * (s8 * 8 + j)) & 4095) * (1.0f / 4096.0f); v[j] = (ri ? __builtin_amdgcn_sinf(ph) : __builtin_amdgcn_cosf(ph)) * (1.0f / 1024.0f); }
          u32x4 w; w.x = pk2(v[0], v[1]); w.y = pk2(v[2], v[3]); w.z = pk2(v[4], v[5]); w.w = pk2(v[6], v[7]); *(u32x4*)(WSP(bf16_t, WS_TSEQ) + (size_t)row * 4096 + s8 * 8) = w; }
      for (long it = gt; it < (long)512 * 32; it += NT) { const int row = (int)(it >> 5), s8 = (int)(it & 31), ri = row >> 8, k = row & 255; float v[8];
#pragma unroll
          for (int j = 0; j < 8; ++j) { const float ph = (float)((k * (s8 * 8 + j)) & 255) * (1.0f / 256.0f); v[j] = (ri ? __builtin_amdgcn_sinf(ph) : __builtin_amdgcn_cosf(ph)) * (1.0f / 256.0f); }
          u32x4 w; w.x = pk2(v[0], v[1]); w.y = pk2(v[2], v[3]); w.z = pk2(v[4], v[5]); w.w = pk2(v[6], v[7]); *(u32x4*)(WSP(bf16_t, WS_TCTX) + (size_t)row * 256 + s8 * 8) = w; }
      for (long it = gt; it < 96 * 128; it += NT) *(u32x4*)(WSP(bf16_t, WS_WMD) + (size_t)672 * D + it * 8) = (u32x4){0u, 0u, 0u, 0u};
      for (long it = gt; it < 1024 + 512; it += NT) { const bool isA = it < 1024; const int q = isA ? (int)it : (int)it - 1024; const int nf = isA ? 16 : 8; const int pos = q / nf, i = q % nf;
          const float inv = exp2f(-((float)i / (float)nf) * 13.287712379549449f); const float ang = (float)pos * inv;
          double rev = (double)ang * 0.15915494309189535; rev -= __builtin_rint(rev);
          const float cv = __builtin_amdgcn_cosf((float)rev), sv = __builtin_amdgcn_sinf((float)rev);
          float* tab = WSP(float, WS_TAB); if (isA) { tab[q] = cv; tab[1024 + q] = sv; } else { tab[2048 + q] = cv; tab[2560 + q] = sv; } }
    }
    for (int l = 0; l < 2; ++l) {
        if (QKV8 & (1 << l)) cvt_matrix8<false>(F.in[7] + (size_t)l * D * 1536, D, 1536, WSP(unsigned char, l ? WS_WQKV1 : WS_WQKV0), W8_GU, 1, gw, NGW, lane);
        else cvt_matrix<false>(F.in[7] + (size_t)l * D * 1536, D, 1536, WSP(bf16_t, l ? WS_WQKV1 : WS_WQKV0), gw, NGW, lane);
        cvt_matrix<false>(F.in[10] + (size_t)l * D * D, D, D, WSP(bf16_t, l ? WS_WOA1 : WS_WOA0), gw, NGW, lane);
        if (GU8 & (1 << l)) cvt_matrix8<true>(F.in[18] + (size_t)l * D * 2 * FFD, D, 2 * FFD, WSP(unsigned char, l ? WS_WDGU1 : WS_WDGU0), W8_GU, 1, gw, NGW, lane);
        else cvt_matrix<true>(F.in[18] + (size_t)l * D * 2 * FFD, D, 2 * FFD, WSP(bf16_t, l ? WS_WDGU1 : WS_WDGU0), gw, NGW, lane);
        if (DOWN8 & (1 << l)) cvt_matrix8<false>(F.in[19] + (size_t)l * FFD * D, FFD, D, WSP(unsigned char, l ? WS_WDD1 : WS_WDD0), W8_D, 1, gw, NGW, lane);
        else cvt_matrix<false>(F.in[19] + (size_t)l * FFD * D, FFD, D, WSP(bf16_t, l ? WS_WDD1 : WS_WDD0), gw, NGW, lane);
        cvt_matrix8<true>(F.in[21] + (size_t)(l * NEXP) * D * 2 * FFE, D, 2 * FFE, WSP(unsigned char, l ? WS_WEGU1 : WS_WEGU0), W8_GU, NEXP, gw, NGW, lane);
        cvt_matrix8<false>(F.in[22] + (size_t)(l * NEXP) * FFE * D, FFE, D, WSP(unsigned char, l ? WS_WED1 : WS_WED0), W8_D, NEXP, gw, NGW, lane);
    }
    cvt_matrix<false>(F.in[12], D, 672, WSP(bf16_t, WS_WMD), gw, NGW, lane);
    cvt_matrix<false>(F.in[15], 384, 1536, WSP(bf16_t, WS_WUQ), gw, NGW, lane);
    cvt_matrix<false>(F.in[16], 256, 2048, WSP(bf16_t, WS_WUKV), gw, NGW, lane);
    cvt_matrix<false>(F.in[17], D, D, WSP(bf16_t, WS_WMO), gw, NGW, lane);
}

__device__ __forceinline__ void g_plain_cs(Frame& F, const bf16_t* A, int lda, const bf16_t* Bt, int ldb, bf16_t* C, int ldc, int N, int K, int nsl) {
    pg8::Sched S; S.init_plain(A, lda, Bt, ldb, C, ldc, NTOK, N, F.G, F.bx); S.cs_nsl = nsl; S.cs_P = WSP(bf16_t, WS_CSP);
    pg8::EpiPlain E{ldc, 1.0f};
    pg8::gemm_phase<pg8::EpiPlain, false>(F.lds, K, lda, ldb, S, E);
}
__device__ __forceinline__ Row ctx_partial_row(Frame& F, int b, int j, int nsl, int lane) {
    Row y = ld_row_bf16(WSP(bf16_t, WS_CSP) + (size_t)(b * 256 + j) * D, lane);
    for (int sl = 1; sl < nsl; ++sl) { const Row z = ld_row_bf16(WSP(bf16_t, WS_CSP) + ((size_t)(sl * 8 + b) * 256 + j) * D, lane);
#pragma unroll
        for (int jj = 0; jj < 4; ++jj) y.v[jj] = y.v[jj] + z.v[jj]; }
    return y;
}
__device__ __forceinline__ void st_row_fp8(unsigned* hp, int lane, const Row& h) {
#pragma unroll
    for (int jj = 0; jj < 4; ++jj) hp[lane + 64 * jj] = pk_fp8x4(h.v[jj][0], h.v[jj][1], h.v[jj][2], h.v[jj][3]); }
__device__ __forceinline__ void p_r0(Frame& F) {
    const int gw = F.vcu * NWAVES + F.wave, NGW = F.G * NWAVES, lane = F.lane;
    for (int t = gw; t < NTOK; t += NGW) {
        const int b = t / TPB, j = t % TPB; const bool isc = j < CTXL;
        const float* src = isc ? F.in[2] + (size_t)(b * CTXL + j) * D : F.in[0] + (size_t)(b * SEQ + (j - CTXL)) * D;
        const Row x = ld_row_f32_nt(src, lane);
        const int mr = isc ? 8 : b;
        const Row h = modnorm(x, normg(F, 0, 0), modp(F, 0, mr, 0), modp(F, 0, mr, 1), lane);
        if (QKV8 & 1) st_row_fp8(WSP(unsigned, WS_H) + (size_t)t * (D / 4), lane, h); else st_row_bf16(WSP(bf16_t, WS_H) + (size_t)t * D, lane, h);
    }
}

template <bool MOE, bool H8 = false>
__device__ __forceinline__ void p_rmid(Frame& F, int layer, bool lat_only, const float* w_router, int moe_idx, int csn = 0) {
    const int lane = F.lane;
    const int nact = lat_only ? NLAT : NTOK; const int per = (nact + F.G - 1) / F.G;
    const int nrows = (nact - F.bx + F.G - 1) / F.G < per ? (nact - F.bx + F.G - 1) / F.G : per;
    LAS float* wrT = (LAS float*)F.lds;
    LAS int* cntL = (LAS int*)(F.lds + 32768); LAS int* baseL = cntL + 8;
    LAS unsigned* rowE = (LAS unsigned*)(F.lds + 32768 + 64); LAS unsigned* rowS = rowE + 1024; LAS float* rowW = (LAS float*)(rowS + 1024);
    if (MOE) {
        for (int i = F.tid; i < 8 * D; i += 512) { const int c = i >> 3, e = i & 7; wrT[e * D + c] = w_router[i]; }
        if (F.tid < 8) cntL[F.tid] = 0;
        __syncthreads();
    }
    for (int rr = F.wave; rr < nrows; rr += NWAVES) {
        const int a = rr * F.G + F.bx; const int t = lat_only ? (a / SEQ) * TPB + CTXL + (a % SEQ) : a;
        const int b = t / TPB, j = t % TPB; const int mr = (j < CTXL) ? 8 : b;
        bf16_t* xp = WSP(bf16_t, WS_X) + (size_t)t * D;
        const Row y = (csn > 0 && j < CTXL) ? ctx_partial_row(F, b, j, csn, lane) : ld_row_bf16(WSP(bf16_t, WS_Y) + (size_t)t * D, lane);
        const Row x0 = layer == 0 ? ld_row_f32_nt(j < CTXL ? F.in[2] + (size_t)(b * CTXL + j) * D : F.in[0] + (size_t)(b * SEQ + (j - CTXL)) * D, lane) : ld_row_bf16(xp, lane);
        Row x = resid(x0, y, normg(F, layer, 1), modp(F, layer, mr, 2), lane);
        if ((DBG_SKIP >> (2 * layer)) & 1) x = x0;
        st_row_bf16(xp, lane, x);
        const Row h = modnorm(x, normg(F, layer, 2), modp(F, layer, mr, 3), modp(F, layer, mr, 4), lane);
        if (H8) { unsigned* hp = WSP(unsigned, WS_H) + (size_t)t * (D / 4) + lane;
#pragma unroll
            for (int jj = 0; jj < 4; ++jj) hp[64 * jj] = pk_fp8x4(h.v[jj][0], h.v[jj][1], h.v[jj][2], h.v[jj][3]); }
        else st_row_bf16(WSP(bf16_t, WS_H) + (size_t)t * D, lane, h);
        if (MOE) {
            float lg[8];
#pragma unroll
            for (int e = 0; e < 8; ++e) { float s = 0.f;
#pragma unroll
                for (int jj = 0; jj < 4; ++jj) { const f32x4 w = *(const LAS f32x4*)(wrT + e * D + 4 * lane + 256 * jj); s += (h.v[jj][0] * w[0] + h.v[jj][1] * w[1]) + (h.v[jj][2] * w[2] + h.v[jj][3] * w[3]); }
                lg[e] = wave_sum(s); }
            int e1 = 0; float v1 = lg[0];
#pragma unroll
            for (int e = 1; e < 8; ++e) if (lg[e] > v1) { v1 = lg[e]; e1 = e; }
            int e2 = -1; float v2 = -3.0e38f;
#pragma unroll
            for (int e = 0; e < 8; ++e) if (e != e1 && (e2 < 0 || lg[e] > v2)) { v2 = lg[e]; e2 = e; }
            const float ex = __expf(v2 - v1); const float w1 = 1.0f / (1.0f + ex);
#if DBG_CHECK
            if (lane < 8) { float vv = lg[0];
#pragma unroll
                for (int e = 1; e < 8; ++e) vv = (lane == e) ? lg[e] : vv;
                ((float*)(F.ws + 1300 * MiB))[(size_t)t * 8 + lane] = vv; }
#endif
            if (lane == 0) { const int s1 = __hip_atomic_fetch_add(cntL + e1, 1, __ATOMIC_RELAXED, __HIP_MEMORY_SCOPE_WORKGROUP), s2 = __hip_atomic_fetch_add(cntL + e2, 1, __ATOMIC_RELAXED, __HIP_MEMORY_SCOPE_WORKGROUP);
                rowE[rr] = (unsigned)e1 | ((unsigned)e2 << 8); rowS[rr] = (unsigned)s1 | ((unsigned)s2 << 16); rowW[rr] = w1; }
        }
    }
    if (MOE) {
        __syncthreads();
        unsigned* cntg = F.ctl + CW_MOE + moe_idx * 8 * 64;
        if (F.tid < 8) baseL[F.tid] = (int)__hip_atomic_fetch_add(cntg + F.tid * 64, (unsigned)cntL[F.tid], RLX_AGENT);
        __syncthreads();
        int* list = WSP(int, WS_LIST); u32x4* tinfo = WSP(u32x4, WS_TOKINFO);
        for (int rr = F.tid; rr < nrows; rr += 512) {
            const int a = rr * F.G + F.bx; const int t = lat_only ? (a / SEQ) * TPB + CTXL + (a % SEQ) : a;
            const unsigned E = rowE[rr], Sx = rowS[rr]; const int e1 = E & 255, e2 = E >> 8; const int g1 = baseL[e1] + (int)(Sx & 0xffff), g2 = baseL[e2] + (int)(Sx >> 16);
            list[(size_t)e1 * LIST_CAP + g1] = t; list[(size_t)e2 * LIST_CAP + g2] = t;
            tinfo[t] = (u32x4){E, (unsigned)g1, (unsigned)g2, __builtin_bit_cast(unsigned, rowW[rr])};
        }
        __syncthreads();
    }
}

struct MoeTiles { int cnt[8]; int tend[8]; };
__device__ __forceinline__ MoeTiles moe_tiles(Frame& F, int moe_idx) {
    MoeTiles m; unsigned* cntg = F.ctl + CW_MOE + moe_idx * 8 * 64; int acc = 0;
#pragma unroll
    for (int e = 0; e < 8; ++e) { const int c = (int)__builtin_amdgcn_readfirstlane(__hip_atomic_load(cntg + e * 64, RLX_AGENT)); m.cnt[e] = c; acc += (c + 255) >> 8; m.tend[e] = acc; }
    return m;
}

constexpr bool MOE8_SPLIT = true;
struct MoeSplit { int full, nsl; };
__device__ __forceinline__ MoeSplit moe_split(int nMt, int G) {
    MoeSplit r; const int tot = nMt * 4; r.full = (tot / G) * G; const int R = tot - r.full;
    int nsl = (R > 0) ? G / R : 1; nsl = nsl > 4 ? 4 : nsl;
    if (nsl < 2 || (r.full & 31) != 0 || r.full == 0 || R > 128) nsl = 1;
    r.nsl = nsl; return r;
}

template <bool MOE>
__device__ __forceinline__ void p_rend(Frame& F, int layer, bool last, int moe_idx, int csn = 0) {
    const int gw = F.vcu * NWAVES + F.wave, NGW = F.G * NWAVES, lane = F.lane;
    const int nact = last ? NLAT : NTOK;
    int ts[8]; int ms_pm0 = 1 << 30, ms_nsl = 1;
    if (MOE) { const MoeTiles m = moe_tiles(F, moe_idx); ts[0] = 0;
#pragma unroll
        for (int e = 1; e < 8; ++e) ts[e] = m.tend[e - 1];
        if (MOE8_SPLIT && moe_idx == 1) { const MoeSplit ms = moe_split(m.tend[7], F.G); ms_nsl = ms.nsl; if (ms.nsl > 1) ms_pm0 = ms.full / 4; } }
    for (int a = gw; a < nact; a += NGW) {
        const int t = last ? (a / SEQ) * TPB + CTXL + (a % SEQ) : a;
        const int b = t / TPB, j = t % TPB; const int mr = (j < CTXL) ? 8 : b;
        bf16_t* xp = WSP(bf16_t, WS_X) + (size_t)t * D;
        Row y;
        if (MOE) {
            const u32x4 ti = WSP(const u32x4, WS_TOKINFO)[t]; const int e1 = ti.x & 255, e2 = ti.x >> 8; int t1 = 0, t2 = 0;
#pragma unroll
            for (int e = 1; e < 8; ++e) { if (e1 == e) t1 = ts[e]; if (e2 == e) t2 = ts[e]; }
            const unsigned w1b = ti.w; const float w1 = u2f(w1b), w2 = 1.0f - w1;
            const size_t ra = (size_t)t1 * 256 + ti.y, rb = (size_t)t2 * 256 + ti.z;
            Row ya = ld_row_bf16(WSP(bf16_t, WS_Y2) + ra * D, lane), yb = ld_row_bf16(WSP(bf16_t, WS_Y2) + rb * D, lane);
            if ((int)(ra >> 8) >= ms_pm0) { for (int sl = 1; sl < ms_nsl; ++sl) { const Row z = ld_row_bf16(WSP(bf16_t, WS_MSP) + ((size_t)((sl - 1) * 32 * 256) + (ra - (size_t)ms_pm0 * 256)) * D, lane);
#pragma unroll
                for (int jj = 0; jj < 4; ++jj) ya.v[jj] = ya.v[jj] + z.v[jj]; } }
            if ((int)(rb >> 8) >= ms_pm0) { for (int sl = 1; sl < ms_nsl; ++sl) { const Row z = ld_row_bf16(WSP(bf16_t, WS_MSP) + ((size_t)((sl - 1) * 32 * 256) + (rb - (size_t)ms_pm0 * 256)) * D, lane);
#pragma unroll
                for (int jj = 0; jj < 4; ++jj) yb.v[jj] = yb.v[jj] + z.v[jj]; } }
#pragma unroll
            for (int jj = 0; jj < 4; ++jj) y.v[jj] = ya.v[jj] * w1 + yb.v[jj] * w2;
        } else y = (csn > 0 && j < CTXL) ? ctx_partial_row(F, b, j, csn, lane) : ld_row_bf16(WSP(bf16_t, WS_Y2) + (size_t)t * D, lane);
        const Row x0 = ld_row_bf16(xp, lane);
        Row x = resid(x0, y, normg(F, layer, 3), modp(F, layer, mr, 5), lane);
        if ((DBG_SKIP >> (2 * layer + 1)) & 1) x = x0;
        if (last) { st_row_f32(F.out + ((size_t)b * SEQ + (j - CTXL)) * D, lane, x); }
        else {
            st_row_bf16(xp, lane, x);
            const Row h = modnorm(x, normg(F, layer + 1, 0), modp(F, layer + 1, mr, 0), modp(F, layer + 1, mr, 1), lane);
            if ((QKV8 & 2) && layer == 2) st_row_fp8(WSP(unsigned, WS_H) + (size_t)t * (D / 4), lane, h);
            else st_row_bf16(WSP(bf16_t, WS_H) + (size_t)t * D, lane, h);
        }
    }
}

__device__ __forceinline__ void transpose_64x256(Frame& F, const bf16_t* src, size_t sp, int hs, bf16_t* dst, size_t dp) {
    LAS bf16_t* tl = (LAS bf16_t*)F.lds;
#pragma unroll
    for (int q = 0; q < 4; ++q) { const int cid = F.tid + 512 * q; const int tok = cid >> 5, ch = cid & 31; const int scol = (ch >> 3) * hs + (ch & 7) * 8;
        *(LAS u32x4*)(tl + tok * 264 + ch * 8) = *(const u32x4*)(src + (size_t)tok * sp + scol); }
    __syncthreads();
#pragma unroll
    for (int q = 0; q < 4; ++q) { const int item = F.tid + 512 * q; const int dcol = item & 255, c8 = item >> 8; unsigned v[8];
#pragma unroll
        for (int jj = 0; jj < 8; ++jj) v[jj] = tl[(c8 * 8 + jj) * 264 + dcol];
        u32x4 w; w.x = v[0] | (v[1] << 16); w.y = v[2] | (v[3] << 16); w.z = v[4] | (v[5] << 16); w.w = v[6] | (v[7] << 16);
        *(u32x4*)(dst + (size_t)dcol * dp + c8 * 8) = w; }
    __syncthreads();
}

__device__ __forceinline__ void transpose_64x256_v8(Frame& F, const bf16_t* src, size_t sp, int hs, unsigned char* dst, size_t dp) {
    LAS bf16_t* tl = (LAS bf16_t*)F.lds;
#pragma unroll
    for (int q = 0; q < 4; ++q) { const int cid = F.tid + 512 * q; const int tok = cid >> 5, ch = cid & 31; const int scol = (ch >> 3) * hs + (ch & 7) * 8;
        *(LAS u32x4*)(tl + tok * 264 + ch * 8) = *(const u32x4*)(src + (size_t)tok * sp + scol); }
    __syncthreads();
#pragma unroll
    for (int q = 0; q < 4; ++q) { const int item = F.tid + 512 * q; const int dcol = item & 255, gk = item >> 8; float v[8];
#pragma unroll
        for (int jj = 0; jj < 8; ++jj) v[jj] = bf2f((unsigned)tl[(gk * 8 + jj) * 264 + dcol]);
        u32x2 w; w.x = pk_fp8x4(v[0], v[1], v[2], v[3]); w.y = pk_fp8x4(v[4], v[5], v[6], v[7]);
        *(u32x2*)(dst + (size_t)dcol * dp + (4 * (gk & 1) + (gk >> 1)) * 8) = w; }
    __syncthreads();
}
__device__ __forceinline__ void p_qkn(Frame& F, int j_a) {
    const int lane = F.lane, a = lane & 7; const float* tab = WSP(const float, WS_TAB);
    const bf16_t* raw = WSP(const bf16_t, WS_A_RAW); bf16_t* Q = WSP(bf16_t, WS_A_Q); bf16_t* Kd = WSP(bf16_t, WS_A_K); bf16_t* Vt = WSP(bf16_t, WS_A_VT);
    float gq[8], gk[8];
#pragma unroll
    for (int i = 0; i < 8; ++i) { gq[i] = F.in[8][j_a * 64 + a * 8 + i]; gk[i] = F.in[9][j_a * 64 + a * 8 + i]; }
    const float C2 = 0.125f * LOG2E; const bool second = (a & 2) != 0;
    for (int u = F.vcu; u < NBATCH * 68; u += F.G) {
        const int b = u / 68, c = u % 68;
        for (int tt = F.wave; tt < 64; tt += NWAVES) {
            const int j = c * 64 + tt, t = b * TPB + j; const bool lat = j >= CTXL; const int sp = j - CTXL;
            float cs[8], sn[8];
            if (lat) { const int pp = (a < 4) ? (sp >> 6) : (sp & 63); const float* tc = tab + pp * 16 + 8 * (a & 1);
                const f32x4 c0 = *(const f32x4*)tc, c1 = *(const f32x4*)(tc + 4), s0 = *(const f32x4*)(tc + 1024), s1 = *(const f32x4*)(tc + 1028);
#pragma unroll
                for (int i = 0; i < 4; ++i) { cs[i] = c0[i]; cs[4 + i] = c1[i]; sn[i] = s0[i]; sn[4 + i] = s1[i]; } }
            else {
#pragma unroll
                for (int i = 0; i < 8; ++i) { cs[i] = 1.f; sn[i] = 0.f; } }
            const bf16_t* rp = raw + (size_t)t * 1536;
#pragma unroll
            for (int pass = 2; pass < 3; ++pass) {
                const bool act = (pass < 2) || (lane < 32); const int chunk = pass * 64 + lane;
                u32x4 w = (u32x4){0u, 0u, 0u, 0u}; if (act) w = *(const u32x4*)(rp + chunk * 8);
                float x[8]; unpack8(w, x); float ss = 0.f;
#pragma unroll
                for (int i = 0; i < 8; ++i) ss += x[i] * x[i];
                ss += __shfl_xor(ss, 1); ss += __shfl_xor(ss, 2); ss += __shfl_xor(ss, 4);
                const float rs = 1.0f / sqrtf(ss * (1.0f / 64.0f) + NORM_EPS);
                float o[8];
#pragma unroll
                for (int i = 0; i < 8; ++i) { const float xn = x[i] * rs * (pass < 2 ? gq[i] : gk[i]); const float pr = __shfl_xor(xn, 2);
                    o[i] = second ? (xn * cs[i] + pr * sn[i]) : (xn * cs[i] - pr * sn[i]); if (pass < 2) o[i] *= C2; }
                if (pass < 2) *(u32x4*)(Q + (size_t)t * D + chunk * 8) = pack8(o);
                else if (act) {
                    if constexpr (ATT_QK8) { u32x2 w8; w8.x = pk_fp8x4(o[0], o[1], o[2], o[3]); w8.y = pk_fp8x4(o[4], o[5], o[6], o[7]);
                        *(u32x2*)((unsigned char*)Kd + (size_t)t * 256 + (lane >> 3) * 64 + (a & 1) * 32 + (a >> 1) * 8) = w8; }
                    else *(u32x4*)(Kd + (size_t)t * 256 + (chunk - 128) * 8) = pack8(o); }
            }
        }
        if constexpr (ATT_QK8 && ATT_PV8) transpose_64x256_v8(F, raw + (size_t)(b * TPB + c * 64) * 1536 + 1280, 1536, 64, (unsigned char*)Vt + (size_t)(b * 256) * TPB + c * 64, TPB);
        else transpose_64x256(F, raw + (size_t)(b * TPB + c * 64) * 1536 + 1280, 1536, 64, Vt + (size_t)(b * 256) * TPB + c * 64, TPB);
    }
}

__device__ __forceinline__ void p_mla1(Frame& F) {
    const int gw = F.vcu * NWAVES + F.wave, NGW = F.G * NWAVES, lane = F.lane; const float* tab = WSP(const float, WS_TAB);
    const bf16_t* Dm = WSP(const bf16_t, WS_M_DM); bf16_t* CQ = WSP(bf16_t, WS_M_CQ); bf16_t* CKV = WSP(bf16_t, WS_M_CKV); bf16_t* KR = WSP(bf16_t, WS_M_KR);
    float gq[8], gk[8];
#pragma unroll
    for (int i = 0; i < 8; ++i) { gq[i] = lane < 48 ? F.in[13][lane * 8 + i] : 0.f; gk[i] = lane < 32 ? F.in[14][lane * 8 + i] : 0.f; }
    const int rc = lane & 3; const bool second = (rc & 1) != 0;
    for (int t = gw; t < NTOK; t += NGW) {
        const int j = t % TPB; const bool lat = j >= CTXL; const int sp = j - CTXL;
        const bf16_t* dp = Dm + (size_t)t * 768;
        u32x4 w1 = (u32x4){0u, 0u, 0u, 0u}, w2 = (u32x4){0u, 0u, 0u, 0u};
        if (lane < 48) w1 = *(const u32x4*)(dp + lane * 8);
        if (lane < 36) w2 = *(const u32x4*)(dp + 384 + lane * 8);
        float x[8], y[8]; unpack8(w1, x); unpack8(w2, y); float s1 = 0.f, s2 = 0.f;
#pragma unroll
        for (int i = 0; i < 8; ++i) { s1 += x[i] * x[i]; s2 += y[i] * y[i]; }
        if (lane >= 32) s2 = 0.f;
        const float rq = 1.0f / sqrtf(wave_sum(s1) * (1.0f / 384.0f) + NORM_EPS), rk = 1.0f / sqrtf(wave_sum(s2) * (1.0f / 256.0f) + NORM_EPS);
        float o[8];
#pragma unroll
        for (int i = 0; i < 8; ++i) o[i] = x[i] * rq * gq[i];
        if (lane < 48) *(u32x4*)(CQ + (size_t)t * 384 + lane * 8) = pack8(o);
        float cs[8], sn[8];
        if (lat) { const int pp = (rc < 2) ? (sp >> 6) : (sp & 63); const float* tc = tab + 2048 + pp * 8;
            const f32x4 c0 = *(const f32x4*)tc, c1 = *(const f32x4*)(tc + 4), s0 = *(const f32x4*)(tc + 512), s1v = *(const f32x4*)(tc + 516);
#pragma unroll
            for (int i = 0; i < 4; ++i) { cs[i] = c0[i]; cs[4 + i] = c1[i]; sn[i] = s0[i]; sn[4 + i] = s1v[i]; } }
        else {
#pragma unroll
            for (int i = 0; i < 8; ++i) { cs[i] = 1.f; sn[i] = 0.f; } }
        float k[8];
#pragma unroll
        for (int i = 0; i < 8; ++i) { const float pr = __shfl_xor(y[i], 1); k[i] = second ? (y[i] * cs[i] + pr * sn[i]) : (y[i] * cs[i] - pr * sn[i]); o[i] = y[i] * rk * gk[i]; }
        if (lane < 32) *(u32x4*)(CKV + (size_t)t * 256 + lane * 8) = pack8(o);
        else if (lane < 36) *(u32x4*)(KR + (size_t)t * 32 + (lane - 32) * 8) = pack8(k);
    }
}
__device__ __forceinline__ void p_mla2(Frame& F) {
    const int lane = F.lane; const float* tab = WSP(const float, WS_TAB);
    bf16_t* Qm = WSP(bf16_t, WS_M_Q); bf16_t* KV = WSP(bf16_t, WS_M_KV); const bf16_t* KR = WSP(const bf16_t, WS_M_KR); bf16_t* Vt = WSP(bf16_t, WS_M_VT);
    const float C2 = 0.10206207261596577f * LOG2E;
    for (int u = F.vcu; u < NBATCH * 68; u += F.G) {
        const int b = u / 68, c = u % 68;
        for (int hg = 0; hg < 4; ++hg) {
            if constexpr (ATT_QK8 && MLA_QK8 && ATT_PV8) transpose_64x256_v8(F, KV + (size_t)(b * TPB + c * 64) * 2048 + hg * 512 + 64, 2048, 128, (unsigned char*)Vt + (size_t)(b * 1024 + hg * 256) * TPB + c * 64, TPB);
            else transpose_64x256(F, KV + (size_t)(b * TPB + c * 64) * 2048 + hg * 512 + 64, 2048, 128, Vt + (size_t)(b * 1024 + hg * 256) * TPB + c * 64, TPB);
            if constexpr (MLA_QK8 && ATT_QK8) {
              const int tok = F.tid >> 3, rem = F.tid & 7, hh = hg * 4 + (rem >> 1), part = rem & 1; const int t = b * TPB + c * 64 + tok;
              const bf16_t* kn = KV + (size_t)t * 2048 + hh * 128 + 8 * part; const bf16_t* kr = KR + (size_t)t * 32 + 8 * part;
              unsigned char* k8 = WSP(unsigned char, WS_M_K8) + (size_t)t * 1536 + hh * 96;
              u32x4 wn0, wn1, wr;
              { float a[8], bb[8]; unpack8(*(const u32x4*)(kn), a); unpack8(*(const u32x4*)(kn + 16), bb);
                wn0.x = pk_fp8x4(a[0], a[1], a[2], a[3]); wn0.y = pk_fp8x4(a[4], a[5], a[6], a[7]); wn0.z = pk_fp8x4(bb[0], bb[1], bb[2], bb[3]); wn0.w = pk_fp8x4(bb[4], bb[5], bb[6], bb[7]); }
              { float a[8], bb[8]; unpack8(*(const u32x4*)(kn + 32), a); unpack8(*(const u32x4*)(kn + 48), bb);
                wn1.x = pk_fp8x4(a[0], a[1], a[2], a[3]); wn1.y = pk_fp8x4(a[4], a[5], a[6], a[7]); wn1.z = pk_fp8x4(bb[0], bb[1], bb[2], bb[3]); wn1.w = pk_fp8x4(bb[4], bb[5], bb[6], bb[7]); }
              { float a[8], bb[8]; unpack8(*(const u32x4*)(kr), a); unpack8(*(const u32x4*)(kr + 16), bb);
                wr.x = pk_fp8x4(a[0], a[1], a[2], a[3]); wr.y = pk_fp8x4(a[4], a[5], a[6], a[7]); wr.z = pk_fp8x4(bb[0], bb[1], bb[2], bb[3]); wr.w = pk_fp8x4(bb[4], bb[5], bb[6], bb[7]); }
              *(u32x4*)(k8 + part * 32) = wn0; *(u32x4*)(k8 + part * 32 + 16) = wn1; *(u32x4*)(k8 + 64 + part * 16) = wr;
            } else
            { const int tok = F.tid >> 3, rem = F.tid & 7, hh = hg * 4 + (rem >> 1), part = rem & 1; const int t = b * TPB + c * 64 + tok;
              *(u32x4*)(KV + (size_t)t * 2048 + hh * 128 + 64 + part * 16) = *(const u32x4*)(KR + (size_t)t * 32 + part * 16);
              *(u32x4*)(KV + (size_t)t * 2048 + hh * 128 + 64 + part * 16 + 8) = *(const u32x4*)(KR + (size_t)t * 32 + part * 16 + 8); }
        }
    }
}
__device__ __forceinline__ void p_htrans(Frame& F) {
    for (int u = F.vcu; u < NBATCH * 68 * 4; u += F.G) {
        const int cb = u & 3, c = (u >> 2) % 68, b = (u >> 2) / 68;
        transpose_64x256(F, WSP(const bf16_t, WS_H) + (size_t)(b * TPB + c * 64) * D + cb * 256, D, 64, WSP(bf16_t, WS_F_HT) + (size_t)(b * D + cb * 256) * TPB + c * 64, TPB);
    }
}

__device__ __forceinline__ void p_htrans2(Frame& F) {
    for (int u = F.vcu; u < NBATCH * 68 * 4; u += F.G) {
        const int cb = u & 3, x = (u >> 2) % 68, b = (u >> 2) / 68;
        const bf16_t* src = WSP(const bf16_t, WS_H) + (size_t)(b * TPB + (x < 4 ? 64 * x : CTXL + (x - 4))) * D + cb * 256;
        transpose_64x256(F, src, x < 4 ? (size_t)D : (size_t)64 * D, 64, WSP(bf16_t, WS_F_HT) + (size_t)(b * D + cb * 256) * TPB + x * 64, TPB);
    }
}
__device__ __forceinline__ void p_fft_relayout(Frame& F) {
    const int gw = F.vcu * NWAVES + F.wave, NGW = F.G * NWAVES, lane = F.lane;
    LAS unsigned char* lw = F.lds + F.wave * 8704;
    const LAS unsigned short* l16 = (const LAS unsigned short*)lw;
    for (int row = gw; row < NBATCH * D; row += NGW) {
        const bf16_t* g1 = WSP(const bf16_t, WS_F_G1) + (size_t)row * 8192; bf16_t* g2 = WSP(bf16_t, WS_F_G2) + (size_t)row * 8192;
        for (int half = 0; half < 2; ++half) {
#pragma unroll
            for (int q = 0; q < 8; ++q) { const int piece = q * 64 + lane, cl = piece >> 4, o16 = piece & 15;
                *(LAS u32x4*)(lw + cl * 272 + o16 * 16) = *(const u32x4*)(g1 + (size_t)(32 * half + cl) * 128 + o16 * 8); }
            LDS_WAIT(); asm volatile("" ::: "memory");
#pragma unroll 2
            for (int it = 0; it < 8; ++it) { const int id = it * 64 + lane, c8 = id & 3, ri = (id >> 2) & 1, kl = id >> 3; float o[8];
#pragma unroll
                for (int j = 0; j < 8; ++j) { const int cl = 8 * c8 + j, c = 32 * half + cl; const float gr = bf2f(l16[cl * 136 + kl]), gi = bf2f(l16[cl * 136 + 64 + kl]);
                    const float ph = (float)((kl * c) & 4095) * (1.0f / 4096.0f); const float cs = __builtin_amdgcn_cosf(ph), sn = __builtin_amdgcn_sinf(ph);
                    o[j] = ri ? (gi * cs - gr * sn) : (gr * cs + gi * sn); }
                *(u32x4*)(g2 + kl * 128 + ri * 64 + 32 * half + 8 * c8) = pack8(o); }
            LDS_WAIT(); asm volatile("" ::: "memory");
        }
    }
}

template <int DK, int NQ, bool NOREF>
__device__ __forceinline__ unsigned p_attn_impl(Frame& F, const bf16_t* Q, int qpitch, int qhs, const bf16_t* K, int kpitch, int khs, int gsz, const bf16_t* Vt, bf16_t* O, bool ctxq, const float* qgain = nullptr, bool qfuse = false, unsigned only = 0xffffffffu) {
    constexpr int VTP = (ATT_QK8 && ATT_PV8 && (DK == 64 || MLA_QK8)) ? TPB / 2 : TPB;
    const int nkv = 16 / gsz; constexpr int UR = 256 * NQ, UPH = SEQ / UR, NU = NBATCH * 16 * UPH;
    unsigned fail = 0u, bit = 1u;
    if (ctxq) { for (int cu = F.vcu; cu < 256; cu += F.G) if ((cu & 1) == 0) { const int bh = cu >> 1, b = bh >> 4, hh = bh & 15, kvh = hh / gsz;
        if (only & bit) if (!att::unit<DK, NQ, NOREF>(F.lds, Q + (size_t)(b * TPB) * qpitch + hh * qhs, qpitch, K + (size_t)(b * TPB) * kpitch + kvh * khs, kpitch, Vt + (size_t)((b * nkv + kvh) * 64) * VTP, VTP,
                      O + (size_t)(b * TPB) * D + hh * 64, D, CTXL / 64, CTXL, qgain, qfuse ? WSP(const float, WS_TAB) : nullptr, -1)) fail |= bit;
        bit <<= 1; } }
    const int per = (NU + F.G - 1) / F.G;
    for (int i = 0; i < per; ++i) { const int uid = F.vcu * per + i; if (uid >= NU) break;
        const int qb = uid % UPH, hh = (uid / UPH) & 15, b = uid / (UPH * 16), kvh = hh / gsz; const size_t row0 = (size_t)b * TPB + CTXL + qb * UR;
        if (only & bit) if (!att::unit<DK, NQ, NOREF>(F.lds, Q + row0 * qpitch + hh * qhs, qpitch, K + (size_t)(b * TPB) * kpitch + kvh * khs, kpitch, Vt + (size_t)((b * nkv + kvh) * 64) * VTP, VTP,
                      O + row0 * D + hh * 64, D, TPB / 64, UR, qgain, qfuse ? WSP(const float, WS_TAB) : nullptr, qb * UR)) fail |= bit;
        bit <<= 1; }
    return fail;
}

template <int DK, int NQ>
__device__ __forceinline__ void p_attn(Frame& F, const bf16_t* Q, int qpitch, int qhs, const bf16_t* K, int kpitch, int khs, int gsz, const bf16_t* Vt, bf16_t* O, bool ctxq, const float* gq = nullptr, const float* gk = nullptr, bool qfuse = false) {
    bool noref = false;
    if (gq != nullptr) { float a = fabsf(gq[F.lane]), b = fabsf(gk[F.lane]);
#pragma unroll
        for (int o = 1; o < 64; o <<= 1) { a = fmaxf(a, __shfl_xor(a, o)); b = fmaxf(b, __shfl_xor(b, o)); }
        noref = (a * b <= ((ATT_QK8 && ATT_PV8) ? 1.4f : 5.0f)); }
    if constexpr (DK == 64) { if (noref) { p_attn_impl<DK, NQ, true>(F, Q, qpitch, qhs, K, kpitch, khs, gsz, Vt, O, ctxq, gq, true); return; } }
    if constexpr (DK == 96 && MLA_SPEC) {
        const unsigned fm = p_attn_impl<DK, NQ, true>(F, Q, qpitch, qhs, K, kpitch, khs, gsz, Vt, O, ctxq, nullptr, qfuse);
        if (fm) p_attn_impl<DK, NQ, false>(F, Q, qpitch, qhs, K, kpitch, khs, gsz, Vt, O, ctxq, nullptr, qfuse, fm);
        return; }
    p_attn_impl<DK, NQ, false>(F, Q, qpitch, qhs, K, kpitch, khs, gsz, Vt, O, ctxq, DK == 64 ? gq : nullptr, (DK == 64 && gq != nullptr) || qfuse);
}

__device__ __forceinline__ void g_plain(Frame& F, const bf16_t* A, int lda, const bf16_t* Bt, int ldb, bf16_t* C, int ldc, int M, int N, int K, float scale) {
    pg8::Sched S; S.init_plain(A, lda, Bt, ldb, C, ldc, M, N, F.G, F.bx);
    pg8::EpiPlain E{ldc, scale};
    pg8::gemm_phase<pg8::EpiPlain, false>(F.lds, K, lda, ldb, S, E);
}
__device__ __forceinline__ void g_swiglu(Frame& F, const bf16_t* A, const bf16_t* Bt, bf16_t* Act, int M, int FF) {
    pg8::Sched S; S.init_plain(A, D, Bt, D, Act, FF, M, 2 * FF, F.G, F.bx); S.cn = 128;
    pg8::EpiSwiGLU E{FF};
    pg8::gemm_phase<pg8::EpiSwiGLU, false>(F.lds, D, D, D, S, E);
}
__device__ __forceinline__ void g_swiglu_fp8(Frame& F, const unsigned char* Wgu8) {
    pg8::Sched S; S.init_plain(WSP(const bf16_t, WS_H), D / 2, (const bf16_t*)Wgu8, D / 2, WSP(bf16_t, WS_ACT), FFD, NTOK, 2 * FFD, F.G, F.bx);
    S.cm1 = (long)256 * (FFD / 2); S.cn = 64;
    pg8::EpiSwiGLU8 E{FFD, 1.0f / W8_GU, A8_ACT};
    pg8::gemm_phase<pg8::EpiSwiGLU8, false, true>(F.lds, D / 2, D / 2, D / 2, S, E);
}
__device__ __forceinline__ void g_swiglu_to8(Frame& F, const bf16_t* Bt) {
    pg8::Sched S; S.init_plain(WSP(const bf16_t, WS_H), D, Bt, D, WSP(bf16_t, WS_ACT), FFD, NTOK, 2 * FFD, F.G, F.bx);
    S.cm1 = (long)256 * (FFD / 2); S.cn = 64;
    pg8::EpiSwiGLU8 E{FFD, 1.0f, A8_ACT};
    pg8::gemm_phase<pg8::EpiSwiGLU8, false>(F.lds, D, D, D, S, E);
}
constexpr int DOWN8_CSN = 5;
__device__ __forceinline__ void g_down_fp8(Frame& F, const unsigned char* Wd8) {
    pg8::Sched S; S.init_plain(WSP(const bf16_t, WS_ACT), FFD / 2, (const bf16_t*)Wd8, FFD / 2, WSP(bf16_t, WS_Y2), D, NTOK, D, F.G, F.bx);
    S.cs_nsl = DOWN8_CSN; S.cs_ntl = 6; S.cs_P = WSP(bf16_t, WS_CSP);
    pg8::EpiPlain E{D, 1.0f / (W8_D * A8_ACT)};
    pg8::gemm_phase<pg8::EpiPlain, false, true>(F.lds, FFD / 2, FFD / 2, FFD / 2, S, E);
}
__device__ __forceinline__ void g_qkv_fp8(Frame& F, const unsigned char* W8) {
    pg8::Sched S; S.init_plain(WSP(const bf16_t, WS_H), D / 2, (const bf16_t*)W8, D / 2, WSP(bf16_t, WS_A_RAW), 1536, NTOK, 1536, F.G, F.bx);
    pg8::EpiPlain E{1536, 1.0f / W8_GU};
    pg8::gemm_phase<pg8::EpiPlain, false, true>(F.lds, D / 2, D / 2, D / 2, S, E);
}
__device__ __forceinline__ void set_moe(pg8::Sched& S, const MoeTiles& m, const int* list) {
    S.tend0 = m.tend[0]; S.tend1 = m.tend[1]; S.tend2 = m.tend[2]; S.tend3 = m.tend[3]; S.tend4 = m.tend[4]; S.tend5 = m.tend[5]; S.tend6 = m.tend[6]; S.tend7 = m.tend[7];
    S.cnt0 = m.cnt[0]; S.cnt1 = m.cnt[1]; S.cnt2 = m.cnt[2]; S.cnt3 = m.cnt[3]; S.cnt4 = m.cnt[4]; S.cnt5 = m.cnt[5]; S.cnt6 = m.cnt[6]; S.cnt7 = m.cnt[7];
    S.list = list; S.cap = LIST_CAP; S.moe = 1; S.nM = m.tend[7];
}
__device__ __forceinline__ void g_moe1(Frame& F, const bf16_t* Wgu, int moe_idx) {
    const MoeTiles m = moe_tiles(F, moe_idx);
    pg8::Sched S; S.init_plain(WSP(const bf16_t, WS_H), D, Wgu, D, WSP(bf16_t, WS_ACT), FFE, 256, 2 * FFE, F.G, F.bx); S.cn = 128; S.sAm = 0;
    set_moe(S, m, WSP(const int, WS_LIST)); S.sBe = (long)2 * FFE * D * 2;
    pg8::EpiSwiGLU E{FFE};
    pg8::gemm_phase<pg8::EpiSwiGLU, true>(F.lds, D, D, D, S, E);
}
__device__ __forceinline__ void g_moe1_fp8(Frame& F, const unsigned char* Wgu8, int moe_idx) {
    const MoeTiles m = moe_tiles(F, moe_idx);
    pg8::Sched S; S.init_plain(WSP(const bf16_t, WS_H), D / 2, (const bf16_t*)Wgu8, D / 2, WSP(bf16_t, WS_ACT), FFE, 256, 2 * FFE, F.G, F.bx); S.sAm = 0;
    S.cm1 = (long)256 * (FFE / 2); S.cn = 64;
    set_moe(S, m, WSP(const int, WS_LIST)); S.sBe = (long)2 * FFE * D;
    pg8::EpiSwiGLU8 E{FFE, 1.0f / W8_GU, A8_ACT};
    pg8::gemm_phase<pg8::EpiSwiGLU8, true, true>(F.lds, D / 2, D / 2, D / 2, S, E);
}
__device__ __forceinline__ void g_moe2_fp8(Frame& F, const unsigned char* Wd8, int moe_idx) {
    const MoeTiles m = moe_tiles(F, moe_idx);
    pg8::Sched S; S.init_plain(WSP(const bf16_t, WS_ACT), FFE / 2, (const bf16_t*)Wd8, FFE / 2, WSP(bf16_t, WS_Y2), D, 256, D, F.G, F.bx);
    set_moe(S, m, WSP(const int, WS_LIST)); S.sBe = (long)D * FFE;
    if (moe_idx == 1) { const MoeSplit ms = moe_split(m.tend[7], F.G); S.ms_full = ms.full; S.ms_nsl = ms.nsl; S.ms_kt = FFE / 128; S.ms_P = WSP(bf16_t, WS_MSP); }
    pg8::EpiPlain E{D, 1.0f / (W8_D * A8_ACT)};
    pg8::gemm_phase<pg8::EpiPlain, false, true>(F.lds, FFE / 2, FFE / 2, FFE / 2, S, E);
}
__device__ __forceinline__ void g_moe2(Frame& F, const bf16_t* Wd, int moe_idx) {
    const MoeTiles m = moe_tiles(F, moe_idx);
    pg8::Sched S; S.init_plain(WSP(const bf16_t, WS_ACT), FFE, Wd, FFE, WSP(bf16_t, WS_Y2), D, 256, D, F.G, F.bx);
    set_moe(S, m, WSP(const int, WS_LIST)); S.sBe = (long)D * FFE * 2;
    pg8::EpiPlain E{D, 1.0f};
    pg8::gemm_phase<pg8::EpiPlain, false>(F.lds, FFE, FFE, FFE, S, E);
}

struct Args { const float* in[23]; float* out; unsigned char* ws; int ph_lo, ph_hi; };
__global__ void __launch_bounds__(NWAVES * 64, 2) mk_fwd(Args args) {
    extern __shared__ __attribute__((aligned(16))) unsigned char lds_raw[];
    Frame F;
    F.lds = (LAS unsigned char*)lds_raw;
    F.tid = threadIdx.x; F.lane = F.tid & 63; F.wave = __builtin_amdgcn_readfirstlane(F.tid >> 6);
    F.G = gridDim.x; F.bx = blockIdx.x; F.vcu = (F.G % 8 == 0) ? (F.bx % 8) * (F.G / 8) + F.bx / 8 : F.bx;
    F.ws = args.ws; F.ctl = (unsigned*)(args.ws + WS_CTL); F.out = args.out;
#pragma unroll
    for (int i = 0; i < 23; ++i) F.in[i] = args.in[i];
    volatile LAS unsigned* MISC = (volatile LAS unsigned*)(F.lds + MISC_OFF);
    if (F.tid < 32) MISC[F.tid] = 0u;
    __syncthreads();
    XcdBarrier bar; bar.bar = F.ctl + CW_BAR; bar.x = 0; bar.st = nullptr;
    if (!MK_PER_PHASE) bar = xcd_barrier_post(F.ctl + CW_BAR, MISC + 8);
    const int lo = args.ph_lo, hi = args.ph_hi;
#define IN(k) (lo <= (k) && (k) < hi)
#define SEAM(k) do { if (IN(k) && IN((k) + 1)) { if (!MK_PER_PHASE) xcd_barrier(bar); } } while (0)
    constexpr float SC1 = 1.0f;
    if (IN(0)) { p_prologue(F); } SEAM(0);
    if (IN(1)) { p_r0(F); } SEAM(1);
    if (IN(2)) { if (QKV8 & 1) g_qkv_fp8(F, WSP(const unsigned char, WS_WQKV0)); else g_plain(F, WSP(const bf16_t, WS_H), D, WSP(const bf16_t, WS_WQKV0), D, WSP(bf16_t, WS_A_RAW), 1536, NTOK, 1536, D, SC1); } SEAM(2);
    if (IN(3)) { p_qkn(F, 0); } SEAM(3);
    if (IN(4)) { p_attn<64, 2>(F, WSP(const bf16_t, WS_A_RAW), 1536, 64, WSP(const bf16_t, WS_A_K), ATT_QK8 ? 128 : 256, ATT_QK8 ? 32 : 64, 4, WSP(const bf16_t, WS_A_VT), WSP(bf16_t, WS_A_O), true, F.in[8], F.in[9]); } SEAM(4);
    if (IN(5)) { g_plain_cs(F, WSP(const bf16_t, WS_A_O), D, WSP(const bf16_t, WS_WOA0), D, WSP(bf16_t, WS_Y), D, D, D, 4); } SEAM(5);
    if (IN(6)) { if (GU8 & 1) p_rmid<false, true>(F, 0, false, nullptr, 0, 4); else p_rmid<false>(F, 0, false, nullptr, 0, 4); } SEAM(6);
    if (IN(7)) { if (GU8 & 1) g_swiglu_fp8(F, WSP(const unsigned char, WS_WDGU0)); else if (DOWN8 & 1) g_swiglu_to8(F, WSP(const bf16_t, WS_WDGU0)); else g_swiglu(F, WSP(const bf16_t, WS_H), WSP(const bf16_t, WS_WDGU0), WSP(bf16_t, WS_ACT), NTOK, FFD); } SEAM(7);
    if (IN(8)) { if (DOWN8 & 1) g_down_fp8(F, WSP(const unsigned char, WS_WDD0)); else g_plain_cs(F, WSP(const bf16_t, WS_ACT), FFD, WSP(const bf16_t, WS_WDD0), FFD, WSP(bf16_t, WS_Y2), D, D, FFD, 11); } SEAM(8);
    if (IN(9)) { p_rend<false>(F, 0, false, 0, (DOWN8 & 1) ? DOWN8_CSN : 11); } SEAM(9);
    if (IN(10)) { if (FOURIER_FFT) p_htrans2(F); else p_htrans(F); } SEAM(10);
    if (FOURIER_FFT) {
    if (IN(11)) {
        { pg8::Sched S; S.init_plain(WSP(const bf16_t, WS_F_HT) + CTXL, TPB, WSP(const bf16_t, WS_BD1), 256, WSP(bf16_t, WS_F_G1), 8192, D, 512, F.G, F.bx);
          S.nB = NBATCH * 16; S.nB2 = 16; S.sAb = (long)D * TPB * 2; S.sAb2 = 512; S.sBb = 0; S.sBb2 = 0; S.sCb = (long)D * 8192; S.sCb2 = 512;
          pg8::EpiPlain E{8192, 1.0f}; pg8::gemm_phase<pg8::EpiPlain, false>(F.lds, 256, TPB, 256, S, E); }
        { pg8::Sched S; S.init_plain(WSP(const bf16_t, WS_TCTX), 256, WSP(const bf16_t, WS_F_HT), TPB, WSP(bf16_t, WS_F_U), 2048, 512, D, F.G, F.bx);
          S.nB = NBATCH; S.sAb = 0; S.sBb = (long)D * TPB * 2; S.sCb = (long)TPB * 2048; S.pmw = 1; S.cm1 = 0; S.cm2 = 256; S.cn = 512;
          pg8::EpiPlain E{2048, 1.0f}; pg8::gemm_phase<pg8::EpiPlain, false>(F.lds, 256, 256, TPB, S, E); }
        if (!MK_PER_PHASE) xcd_barrier(bar);
        p_fft_relayout(F);
        if (!MK_PER_PHASE) xcd_barrier(bar);
        { pg8::Sched S; S.init_plain(WSP(const bf16_t, WS_T2BD), 256, WSP(const bf16_t, WS_F_G2), 8192, WSP(bf16_t, WS_F_U) + (size_t)CTXL * 2048, 2048, 256, D, F.G, F.bx);
          S.nB = NBATCH * 32; S.nB2 = 32; S.sAb = 0; S.sAb2 = 0; S.sBb = (long)D * 8192 * 2; S.sBb2 = 512; S.sCb = (long)TPB * 2048; S.sCb2 = 2 * 2048; S.cm1 = 0; S.cn = 512;
          pg8::EpiFFT2 E{0}; pg8::gemm_phase<pg8::EpiFFT2, false>(F.lds, 256, 256, 8192, S, E); }
    } SEAM(11);
    } else {
    if (IN(11)) {
        { const int gw = F.vcu * NWAVES + F.wave, NGW = F.G * NWAVES, lane = F.lane;
          for (int rw = gw; rw < NBATCH * D; rw += NGW) { const int b = rw >> 10, ch = rw & 1023; const bf16_t* hp = WSP(const bf16_t, WS_F_HT) + (size_t)rw * TPB + CTXL; float acc_ = 0.f;
#pragma unroll
              for (int q = 0; q < 8; ++q) { float x[8]; unpack8(*(const u32x4*)(hp + (q * 64 + lane) * 8), x); acc_ += ((x[0] - x[1]) + (x[2] - x[3])) + ((x[4] - x[5]) + (x[6] - x[7])); }
              acc_ = wave_sum(acc_) * (1.0f / 1024.0f);
              if (lane == 0) { bf16_t* up = WSP(bf16_t, WS_F_U) + (size_t)(b * TPB + CTXL + 2048) * 2048 + (ch >> 8) * 512 + (ch & 255); up[0] = (bf16_t)f2bf(acc_); up[256] = 0; } } }
        { pg8::Sched S; S.init_plain(WSP(const bf16_t, WS_TSEQ), 4096, WSP(const bf16_t, WS_F_HT) + CTXL, TPB, WSP(bf16_t, WS_F_U) + (size_t)CTXL * 2048, 2048, 4096, D, F.G, F.bx);
          S.nB = NBATCH; S.sAb = 0; S.sBb = (long)D * TPB * 2; S.sCb = (long)TPB * 2048; S.pmw = 8; S.cm1 = (long)256 * 2048; S.cm2 = 256; S.cn = 512;
          pg8::EpiMirror E{2048}; pg8::gemm_phase<pg8::EpiMirror, false>(F.lds, 4096, 4096, TPB, S, E); }
        { pg8::Sched S; S.init_plain(WSP(const bf16_t, WS_TCTX), 256, WSP(const bf16_t, WS_F_HT), TPB, WSP(bf16_t, WS_F_U), 2048, 512, D, F.G, F.bx);
          S.nB = NBATCH; S.sAb = 0; S.sBb = (long)D * TPB * 2; S.sCb = (long)TPB * 2048; S.pmw = 1; S.cm1 = 0; S.cm2 = 256; S.cn = 512;
          pg8::EpiPlain E{2048, 1.0f}; pg8::gemm_phase<pg8::EpiPlain, false>(F.lds, 256, 256, TPB, S, E); }
    } SEAM(11);
    }
    if (IN(12)) { g_plain_cs(F, WSP(const bf16_t, WS_F_U), 2048, WSP(const bf16_t, WS_WFP), 2048, WSP(bf16_t, WS_Y), D, D, 2048, 8); } SEAM(12);
    if (IN(13)) { p_rmid<true, true>(F, 1, false, F.in[20], 0, 8); } SEAM(13);
    if (IN(14)) { g_moe1_fp8(F, WSP(const unsigned char, WS_WEGU0), 0); } SEAM(14);
    if (IN(15)) { g_moe2_fp8(F, WSP(const unsigned char, WS_WED0), 0); } SEAM(15);
    if (IN(16)) { p_rend<true>(F, 1, false, 0); } SEAM(16);
    if (IN(17)) { g_plain(F, WSP(const bf16_t, WS_H), D, WSP(const bf16_t, WS_WMD), D, WSP(bf16_t, WS_M_DM), 768, NTOK, 768, D, SC1); } SEAM(17);
    if (IN(18)) { p_mla1(F); } SEAM(18);
    if (IN(19)) { g_plain(F, WSP(const bf16_t, WS_M_CQ), 384, WSP(const bf16_t, WS_WUQ), 384, WSP(bf16_t, WS_M_Q), 1536, NTOK, 1536, 384, SC1);
                  g_plain(F, WSP(const bf16_t, WS_M_CKV), 256, WSP(const bf16_t, WS_WUKV), 256, WSP(bf16_t, WS_M_KV), 2048, NTOK, 2048, 256, SC1); } SEAM(19);
    if (IN(20)) { p_mla2(F); } SEAM(20);
    if (IN(21)) { p_attn<96, 2>(F, WSP(const bf16_t, WS_M_Q), 1536, 96, (MLA_QK8 && ATT_QK8) ? WSP(const bf16_t, WS_M_K8) : WSP(const bf16_t, WS_M_KV), (MLA_QK8 && ATT_QK8) ? 768 : 2048, (MLA_QK8 && ATT_QK8) ? 48 : 128, 1, WSP(const bf16_t, WS_M_VT), WSP(bf16_t, WS_M_O), true, nullptr, nullptr, true); } SEAM(21);
    if (IN(22)) { g_plain_cs(F, WSP(const bf16_t, WS_M_O), D, WSP(const bf16_t, WS_WMO), D, WSP(bf16_t, WS_Y), D, D, D, 4); } SEAM(22);
    if (IN(23)) { if (GU8 & 2) p_rmid<false, true>(F, 2, false, nullptr, 0, 4); else p_rmid<false>(F, 2, false, nullptr, 0, 4); } SEAM(23);
    if (IN(24)) { if (GU8 & 2) g_swiglu_fp8(F, WSP(const unsigned char, WS_WDGU1)); else if (DOWN8 & 2) g_swiglu_to8(F, WSP(const bf16_t, WS_WDGU1)); else g_swiglu(F, WSP(const bf16_t, WS_H), WSP(const bf16_t, WS_WDGU1), WSP(bf16_t, WS_ACT), NTOK, FFD); } SEAM(24);
    if (IN(25)) { if (DOWN8 & 2) g_down_fp8(F, WSP(const unsigned char, WS_WDD1)); else g_plain_cs(F, WSP(const bf16_t, WS_ACT), FFD, WSP(const bf16_t, WS_WDD1), FFD, WSP(bf16_t, WS_Y2), D, D, FFD, 11); } SEAM(25);
    if (IN(26)) { p_rend<false>(F, 2, false, 0, (DOWN8 & 2) ? DOWN8_CSN : 11); } SEAM(26);
    if (IN(27)) { if (QKV8 & 2) g_qkv_fp8(F, WSP(const unsigned char, WS_WQKV1)); else g_plain(F, WSP(const bf16_t, WS_H), D, WSP(const bf16_t, WS_WQKV1), D, WSP(bf16_t, WS_A_RAW), 1536, NTOK, 1536, D, SC1); } SEAM(27);
    if (IN(28)) { p_qkn(F, 1); } SEAM(28);
    if (IN(29)) { p_attn<64, 2>(F, WSP(const bf16_t, WS_A_RAW), 1536, 64, WSP(const bf16_t, WS_A_K), ATT_QK8 ? 128 : 256, ATT_QK8 ? 32 : 64, 4, WSP(const bf16_t, WS_A_VT), WSP(bf16_t, WS_A_O), false, F.in[8] + 64, F.in[9] + 64); } SEAM(29);
    if (IN(30)) { g_plain_cs(F, WSP(const bf16_t, WS_A_O), D, WSP(const bf16_t, WS_WOA1), D, WSP(bf16_t, WS_Y), D, D, D, 0); } SEAM(30);
    if (IN(31)) { p_rmid<true, true>(F, 3, true, F.in[20] + (size_t)D * NEXP, 1); } SEAM(31);
    if (IN(32)) { g_moe1_fp8(F, WSP(const unsigned char, WS_WEGU1), 1); } SEAM(32);
    if (IN(33)) { g_moe2_fp8(F, WSP(const unsigned char, WS_WED1), 1); } SEAM(33);
    if (IN(34)) { p_rend<true>(F, 3, true, 1); }
#undef IN
#undef SEAM
}


#if DBG_CHECK
__device__ __forceinline__ float blk_sum(float v, float* red) {
    __syncthreads(); red[threadIdx.x] = v; __syncthreads();
    for (int o = 128; o > 0; o >>= 1) { if ((int)threadIdx.x < o) red[threadIdx.x] += red[threadIdx.x + o]; __syncthreads(); }
    return red[0];
}
__device__ __forceinline__ bool close_enough(float got, float ref) { return fabsf(got - ref) <= 0.04f * fabsf(ref) + 0.03f; }
__global__ void dbg_check_moe(Args args, int moe_idx, int lat_only) {
    __shared__ float hs[1024]; __shared__ float red[256]; __shared__ float lg[8]; __shared__ int sh_i[8]; __shared__ float sh_f[2];
    unsigned char* ws = args.ws; unsigned* ctl = (unsigned*)ws; const int tid = threadIdx.x;
    int t = (blockIdx.x * 541 + 17) % NTOK; if (lat_only && (t % TPB) < CTXL) t += CTXL;
    const bf16_t* H = (const bf16_t*)(ws + WS_H) + (size_t)t * D;
    for (int i = tid; i < D; i += 256) hs[i] = bf2f(H[i]);
    __syncthreads();
    const float* wr = args.in[20] + (size_t)moe_idx * D * NEXP;
    for (int e = 0; e < 8; ++e) { float p = 0.f; for (int c = tid; c < D; c += 256) p += hs[c] * wr[c * 8 + e]; const float r = blk_sum(p, red); if (tid == 0) lg[e] = r; }
    __syncthreads();
    const u32x4 ti = ((const u32x4*)(ws + WS_TOKINFO))[t];
    const int e1 = ti.x & 255, e2 = ti.x >> 8, g1 = (int)ti.y, g2 = (int)ti.z; const unsigned w1b = ti.w; const float w1 = u2f(w1b);
    unsigned code = 0;
    if (tid == 0) {
        int r1 = 0; for (int e = 1; e < 8; ++e) if (lg[e] > lg[r1]) r1 = e;
        int r2 = -1; for (int e = 0; e < 8; ++e) if (e != r1 && (r2 < 0 || lg[e] > lg[r2])) r2 = e;
        int r3 = -1; for (int e = 0; e < 8; ++e) if (e != r1 && e != r2 && (r3 < 0 || lg[e] > lg[r3])) r3 = e;
        const float rw1 = 1.0f / (1.0f + expf(lg[r2] - lg[r1]));
        const bool safe = (lg[r2] - lg[r3] > 0.05f) && (lg[r1] - lg[r2] > 0.05f);
        const float* dl = (const float*)(ws + 1300 * MiB) + (size_t)t * 8; float md = 0.f; for (int e = 0; e < 8; ++e) md = fmaxf(md, fabsf(dl[e] - lg[e]));
        if (safe && fabsf(rw1 - w1) > 0.02f) code = 6;
        if (safe && r2 != e2) code = 7;
        if (safe && r1 != e1) code = 8;
        if (!(md <= 0.02f)) code = 9;
        if (e1 > 7 || e2 > 7 || e1 == e2) code = 10;
        const int* list = (const int*)(ws + WS_LIST);
        if (code == 0 && (list[(size_t)e1 * LIST_CAP + g1] != t || list[(size_t)e2 * LIST_CAP + g2] != t)) code = 5;
        int acc = 0, ts1 = 0, ts2 = 0;
        for (int e = 0; e < 8; ++e) { const int c = (int)ctl[CW_MOE + moe_idx * 8 * 64 + e * 64]; if (e == e1) { ts1 = acc; if (g1 >= c) code = code > 5 ? code : 5; } if (e == e2) { ts2 = acc; if (g2 >= c) code = code > 5 ? code : 5; } acc += (c + 255) >> 8; }
        sh_i[0] = ts1 * 256 + g1; sh_i[1] = ts2 * 256 + g2;
    }
    __syncthreads();
    const bf16_t* ACT = (const bf16_t*)(ws + WS_ACT); const bf16_t* YP = (const bf16_t*)(ws + WS_Y2);
    for (int k = 0; k < 2; ++k) {
        const int e = k ? e2 : e1; const size_t pr = (size_t)sh_i[k]; if (e > 7) continue;
        const float* wgu = args.in[21] + (size_t)(moe_idx * NEXP + e) * D * 2 * FFE; const float* wd = args.in[22] + (size_t)(moe_idx * NEXP + e) * FFE * D;
        for (int j = 0; j < 6; ++j) {
            const int ch = (j * 449 + 3 + blockIdx.x * 7) % FFE; float pg = 0.f, pu = 0.f;
            for (int c = tid; c < D; c += 256) { pg += hs[c] * wgu[(size_t)c * 2 * FFE + ch]; pu += hs[c] * wgu[(size_t)c * 2 * FFE + FFE + ch]; }
            const float g = blk_sum(pg, red); const float u = blk_sum(pu, red);
            const float ref = g / (1.0f + expf(-g)) * u; const float got = bf2f(ACT[pr * FFE + ch]);
            if (tid == 0 && !close_enough(got, ref)) { const unsigned c2 = k ? 3u : 4u; code = code > c2 ? code : c2; }
        }
        for (int j = 0; j < 6; ++j) {
            const int n = (j * 173 + 5 + blockIdx.x * 3) % D; float p = 0.f;
            for (int f = tid; f < FFE; f += 256) p += bf2f(ACT[pr * FFE + f]) * wd[(size_t)f * D + n];
            const float ref = blk_sum(p, red); const float got = bf2f(YP[pr * D + n]);
            if (tid == 0 && !close_enough(got, ref)) { const unsigned c2 = k ? 1u : 2u; code = code > c2 ? code : c2; }
        }
    }
    if (tid == 0 && code) atomicAdd(ctl + 16 + code, 1u);
}
__global__ void dbg_final(Args args) { unsigned* ctl = (unsigned*)args.ws; unsigned code = 0, cnt = 0; for (unsigned k = 1; k < 16; ++k) if (ctl[16 + k]) { code = k; cnt = ctl[16 + k]; } if (code) { float a = 1000.f * sqrtf((float)cnt); for (unsigned i = 0; i < code; ++i) a *= 10.f; args.out[0] += a; } }
#endif

extern "C" void kernel_launch(void* const* d_in, const int* in_sizes, int n_in, void* d_out, int out_size, void* d_ws, size_t ws_size, hipStream_t stream) {
    static int grid = 0;
    if (grid == 0) {
        if (n_in != 23 || out_size != NLAT * D || ws_size < WS_END) { fprintf(stderr, "kernel_launch: unexpected shapes/workspace (n_in %d out %d ws %zu need %zu)\n", n_in, out_size, ws_size, (size_t)WS_END); grid = -1; return; }
        int dev = 0, cus = 0, per_cu = 0;
        if (hipGetDevice(&dev) != hipSuccess || hipDeviceGetAttribute(&cus, hipDeviceAttributeMultiprocessorCount, dev) != hipSuccess) { grid = -1; return; }
        if (hipFuncSetAttribute((const void*)mk_fwd, hipFuncAttributeMaxDynamicSharedMemorySize, LDS_BYTES) != hipSuccess) { fprintf(stderr, "kernel_launch: hipFuncSetAttribute failed\n"); grid = -1; return; }
        if (hipOccupancyMaxActiveBlocksPerMultiprocessor(&per_cu, (const void*)mk_fwd, NWAVES * 64, LDS_BYTES) != hipSuccess || per_cu < 1) { fprintf(stderr, "kernel_launch: occupancy query reports %d\n", per_cu); }
        (void)hipGetLastError();
        grid = cus;
    }
    if (grid < 0) return;
    if (hipMemsetAsync((char*)d_ws + WS_CTL, 0, CTL_ZERO_BYTES, stream) != hipSuccess) return;
    Args a{};
    for (int i = 0; i < 23; ++i) a.in[i] = (const float*)d_in[i];
    a.out = (float*)d_out; a.ws = (unsigned char*)d_ws;
#if MK_PER_PHASE
    for (int p = 0; p < NPHASE; ++p) { a.ph_lo = p; a.ph_hi = p + 1; hipLaunchKernelGGL(mk_fwd, dim3(grid), dim3(NWAVES * 64), LDS_BYTES, stream, a);
#if DBG_CHECK
        if (p == 15) hipLaunchKernelGGL(dbg_check_moe, dim3(64), dim3(256), 0, stream, a, 0, 0);
#endif
    }
#if DBG_CHECK
    hipLaunchKernelGGL(dbg_final, dim3(1), dim3(1), 0, stream, a);
#endif
#else
    a.ph_lo = 0; a.ph_hi = NPHASE; hipLaunchKernelGGL(mk_fwd, dim3(grid), dim3(NWAVES * 64), LDS_BYTES, stream, a);
#endif
}
```

```cpp
#include <hip/hip_runtime.h>
#include <cstdio>
#include <cstdint>

#ifndef MK_PER_PHASE
#define MK_PER_PHASE 0
#endif

#ifndef FOURIER_FFT
#define FOURIER_FFT 1
#endif
#ifndef DBG_CHECK
#define DBG_CHECK 0
#endif
#ifndef DBG_SKIP
#define DBG_SKIP 0
#endif
#define LAS __attribute__((address_space(3)))
#define GAS __attribute__((address_space(1)))
typedef unsigned short bf16_t;
typedef short bf16x8 __attribute__((ext_vector_type(8)));
typedef float f32x4 __attribute__((ext_vector_type(4)));
typedef float f32x2 __attribute__((ext_vector_type(2)));
typedef float f32x16 __attribute__((ext_vector_type(16)));
typedef unsigned u32x4 __attribute__((ext_vector_type(4)));
typedef unsigned u32x2 __attribute__((ext_vector_type(2)));

constexpr int D = 1024, NBATCH = 8, SEQ = 4096, CTXL = 256, TPB = SEQ + CTXL, NTOK = NBATCH * TPB, NLAT = NBATCH * SEQ;
constexpr int FFD = 2816, FFE = 3584, NEXP = 8;
constexpr int MOE_ROWS = 71680;
constexpr int LIST_CAP = NTOK;
constexpr float NORM_EPS = 1e-6f;
constexpr float LOG2E = 1.4426950408889634f;
constexpr int NPHASE = 35;
constexpr int DOWN8 = 3;
constexpr int GU8 = 2;
constexpr float W8_GU = 64.0f, W8_D = 128.0f, A8_ACT = 4.0f;

constexpr size_t MiB = (size_t)1 << 20;
constexpr size_t WS_CTL = 0, CTL_ZERO_BYTES = 1 * MiB;
constexpr size_t WS_MOD = 1 * MiB;
constexpr size_t WS_TAB = 2 * MiB;
constexpr size_t WS_X = 4 * MiB;
constexpr size_t WS_H = 140 * MiB;
constexpr size_t WS_WQKV0 = 208 * MiB, WS_WQKV1 = 211 * MiB, WS_WOA0 = 214 * MiB, WS_WOA1 = 216 * MiB, WS_WFP = 218 * MiB, WS_WMD = 222 * MiB, WS_WUQ = 224 * MiB,
                 WS_WUKV = 226 * MiB, WS_WMO = 227 * MiB, WS_WDGU0 = 229 * MiB, WS_WDGU1 = 240 * MiB, WS_WDD0 = 251 * MiB, WS_WDD1 = 257 * MiB, WS_WEGU0 = 263 * MiB,
                 WS_WEGU1 = 375 * MiB, WS_WED0 = 487 * MiB, WS_WED1 = 543 * MiB, WS_TSEQ = 599 * MiB, WS_TCTX = 663 * MiB;
constexpr size_t T0 = 664 * MiB;
constexpr size_t WS_A_RAW = T0, WS_A_Q = T0 + 102 * MiB, WS_A_K = T0 + 170 * MiB, WS_A_VT = T0 + 187 * MiB, WS_A_O = T0 + 204 * MiB;
constexpr size_t WS_F_HT = T0, WS_F_U = T0 + 68 * MiB, WS_F_G1 = T0 + 204 * MiB, WS_F_G2 = T0 + 332 * MiB;
constexpr size_t WS_BD1 = WS_TAB + 65536, WS_T2BD = WS_TAB + 393216;
constexpr size_t WS_M_K8 = T0;
constexpr size_t WS_M_DM = T0, WS_M_CQ = T0 + 51 * MiB, WS_M_CKV = T0 + 77 * MiB, WS_M_KR = T0 + 94 * MiB, WS_M_Q = T0 + 97 * MiB, WS_M_KV = T0 + 199 * MiB,
                 WS_M_VT = T0 + 340 * MiB, WS_M_O = T0 + 408 * MiB;
constexpr size_t WS_Y = T0 + 476 * MiB;
constexpr size_t WS_ACT = T0, WS_Y2 = T0 + 490 * MiB, WS_LIST = T0 + 630 * MiB, WS_TOKINFO = T0 + 632 * MiB;
constexpr size_t WS_CSP = T0 + 560 * MiB;
constexpr size_t WS_MSP = 72 * MiB;
constexpr size_t WS_END = T0 + 634 * MiB;
static_assert((size_t)NTOK * 1024 * 4 == 136 * MiB && (size_t)MOE_ROWS * FFE * 2 == 490 * MiB && (size_t)MOE_ROWS * 1024 * 2 == 140 * MiB, "sizes");

constexpr int CW_BAR = 4096;
constexpr int CW_MOE = 8192;

constexpr int RING_BYTES = 131072;
constexpr int MISC_OFF = RING_BYTES + 320;
constexpr int LDS_BYTES = 147456;
constexpr int NWAVES = 8;

__device__ __forceinline__ unsigned f2bf(float f) { unsigned u = __builtin_bit_cast(unsigned, f); return (u + 0x7fffu + ((u >> 16) & 1u)) >> 16; }
typedef __bf16 bf16x2_p __attribute__((ext_vector_type(2)));
__device__ __forceinline__ unsigned pk2(float lo, float hi) { const f32x2 v = {lo, hi}; return __builtin_bit_cast(unsigned, __builtin_convertvector(v, bf16x2_p)); }
__device__ __forceinline__ float u2f(unsigned u) { return __builtin_bit_cast(float, u); }
__device__ __forceinline__ float bf2f(unsigned b) { return __builtin_bit_cast(float, b << 16); }
__device__ __forceinline__ float bflo(unsigned w) { return __builtin_bit_cast(float, w << 16); }
__device__ __forceinline__ float bfhi(unsigned w) { return __builtin_bit_cast(float, w & 0xffff0000u); }
__device__ __forceinline__ float wave_sum(float v) {
#pragma unroll
    for (int o = 1; o < 64; o <<= 1) v += __shfl_xor(v, o);
    return v;
}
__device__ __forceinline__ void unpack8(const u32x4 w, float (&v)[8]) { const unsigned a = w.x, b = w.y, c = w.z, d = w.w; v[0] = bflo(a); v[1] = bfhi(a); v[2] = bflo(b); v[3] = bfhi(b); v[4] = bflo(c); v[5] = bfhi(c); v[6] = bflo(d); v[7] = bfhi(d); }
__device__ __forceinline__ u32x4 pack8(const float (&v)[8]) { u32x4 w; w.x = pk2(v[0], v[1]); w.y = pk2(v[2], v[3]); w.z = pk2(v[4], v[5]); w.w = pk2(v[6], v[7]); return w; }
typedef int v8i __attribute__((ext_vector_type(8)));
typedef int v4i __attribute__((ext_vector_type(4)));
__device__ __forceinline__ unsigned pk_fp8x4(float a, float b, float c, float d) { int w = __builtin_amdgcn_cvt_pk_fp8_f32(a, b, 0, false); w = __builtin_amdgcn_cvt_pk_fp8_f32(c, d, w, true); return (unsigned)w; }
#define LDS_WAIT() asm volatile("s_waitcnt lgkmcnt(0)" ::: "memory")
#define RLX_AGENT __ATOMIC_RELAXED, __HIP_MEMORY_SCOPE_AGENT

namespace pg8 {
constexpr int BM = 256, BK = 64, HALF = 128, HTB = HALF * BK * 2, STAGE_BYTES = 8 * HTB, NXCD = 8, WGM = 8;
__host__ __device__ __forceinline__ int lds_byte(int r, int c) { const int st = (r >> 4) * 2 + (c >> 5), rr = r & 15, cc = c & 31, ob = rr * 64 + cc * 2; return st * 1024 + (ob ^ (((ob >> 9) & 1) << 5)); }
__host__ __device__ __forceinline__ void stage_rc(int b, int& R, int& C) { const int st = b / 1024, sb = b % 1024, swz = sb ^ (((sb >> 9) & 1) << 5); R = (st >> 1) * 16 + swz / 64; C = (st & 1) * 32 + (swz % 64) / 2; }
__host__ __device__ __forceinline__ int perm32(int rho) { const int n = rho >> 4, i = rho & 15; return 8 * (i >> 2) + 4 * n + (i & 3); }

struct Unit { const char* a; const char* b; bf16_t* c; int pm, pn, e, nt; };

struct Sched {
    int nM, nN, nB, G, c;
    const char* A; const char* Bt; bf16_t* C;
    long sAb, sBb, sCb;
    long sAm, sBn;
    int pmw; long cm1, cm2, cn;
    int moe; long sBe;
    int tend0, tend1, tend2, tend3, tend4, tend5, tend6, tend7;
    int cnt0, cnt1, cnt2, cnt3, cnt4, cnt5, cnt6, cnt7;
    const int* list; int cap;
    int nB2; long sAb2, sBb2, sCb2;
    int cs_ntl;
    int ms_full, ms_nsl, ms_kt; bf16_t* ms_P;
    int cs_nsl; bf16_t* cs_P;
    __device__ __forceinline__ void init_plain(const bf16_t* A_, long lda, const bf16_t* Bt_, long ldb, bf16_t* C_, long ldc, int M, int N, int G_, int c_) {
        nM = M / BM; nN = N / BM; nB = 1; G = G_; c = c_; A = (const char*)A_; Bt = (const char*)Bt_; C = C_; sAb = sBb = sCb = 0;
        sAm = (long)BM * lda * 2; sBn = (long)BM * ldb * 2; pmw = 1 << 30; cm1 = (long)BM * ldc; cm2 = 0; cn = BM; moe = 0; sBe = 0;
        cs_nsl = -1; cs_ntl = 4; cs_P = nullptr; ms_full = 0; ms_nsl = 1; ms_kt = 0; ms_P = nullptr; nB2 = 1; sAb2 = sBb2 = sCb2 = 0;
        tend0 = tend1 = tend2 = tend3 = tend4 = tend5 = tend6 = tend7 = 0; cnt0 = cnt1 = cnt2 = cnt3 = cnt4 = cnt5 = cnt6 = cnt7 = 0; list = nullptr; cap = 0;
    }
    __device__ __forceinline__ bool next(int i, Unit& u) const {
        u.nt = 0;
        if (cs_nsl >= 0) {
            const int L = i * G + c, NL = 128 * nN;
            if (L < NL) { int wgid = L; { const int q = NL / NXCD, xcd = wgid % NXCD, off = wgid / NXCD; wgid = xcd * q + off; }
                const int nig = WGM * nN, gid = wgid / nig, lp = gid * WGM + (wgid % nig) % WGM, pn = (wgid % nig) / WGM; const int pm = (lp >> 4) * 17 + 1 + (lp & 15);
                u.pm = pm; u.pn = pn; u.e = 0; u.a = A + (long)pm * sAm; u.b = Bt + (long)pn * sBn; u.c = C + (long)pm * cm1 + (long)pn * cn; return true; }
            const int q = L - NL; if (q >= 8 * nN * cs_nsl) return false;
            const int sl = q % cs_nsl, r = q / cs_nsl, pn = r % nN, b = r / nN, pm = b * 17;
            u.pm = pm; u.pn = pn; u.e = 0; u.nt = (sl == cs_nsl - 1) ? cs_ntl : 4; u.a = A + (long)pm * sAm + sl * 512; u.b = Bt + (long)pn * sBn + sl * 512;
            u.c = cs_P + ((long)(sl * 8 + b) * 256) * (cm1 / 256) + (long)pn * cn; return true;
        }
        const long L = (long)i * G + c; const int per = nM * nN; const long tot = (long)per * nB;
        int wgid, msl = -1;
        if (ms_nsl > 1) {
            if (L < ms_full) { wgid = (int)L; const int q = ms_full / NXCD, xcd = wgid % NXCD, off = wgid / NXCD; wgid = xcd * q + off; }
            else { const int q = (int)L - ms_full; msl = q % ms_nsl; wgid = ms_full + q / ms_nsl; if (wgid >= (int)tot) return false; }
        } else {
        if (L >= tot) return false;
        wgid = (int)L; { const int nwg = (int)tot; const int q = nwg / NXCD, r = nwg % NXCD, xcd = wgid % NXCD, off = wgid / NXCD; wgid = (xcd < r ? xcd * (q + 1) : r * (q + 1) + (xcd - r) * q) + off; }
        }
        const int b = wgid / per, w = wgid - b * per;
        const int nig = WGM * nN, gid = w / nig, fm = gid * WGM, gsz = (nM - fm) < WGM ? (nM - fm) : WGM;
        const int pm = fm + ((w % nig) % gsz), pn = (w % nig) / gsz;
        int e = 0;
        if (moe) { e = (pm >= tend0) + (pm >= tend1) + (pm >= tend2) + (pm >= tend3) + (pm >= tend4) + (pm >= tend5) + (pm >= tend6); }
        u.pm = pm; u.pn = pn; u.e = e;
        const int b1 = b / nB2, b2 = b - b1 * nB2;
        u.a = A + (long)b1 * sAb + (long)b2 * sAb2 + (long)pm * sAm;
        u.b = Bt + (long)b1 * sBb + (long)b2 * sBb2 + (long)pn * sBn + (long)e * sBe;
        u.c = C + (long)b1 * sCb + (long)b2 * sCb2 + (long)(pm % pmw) * cm1 + (long)(pm / pmw) * cm2 + (long)pn * cn;
        if (msl >= 0) { const int h = ms_kt / 2, k0 = 2 * ((h * msl) / ms_nsl), k1 = 2 * ((h * (msl + 1)) / ms_nsl);
            u.nt = k1 - k0; u.a += (long)k0 * 128; u.b += (long)k0 * 128;
            if (msl > 0) u.c = ms_P + (long)((msl - 1) * 32 + (pm - ms_full / nN)) * cm1 + (long)pn * cn; }
        return true;
    }
    __device__ __forceinline__ int gather_tok(const Unit& u, int r) const {
        const int e = u.e;
        const int ts = e == 0 ? 0 : e == 1 ? tend0 : e == 2 ? tend1 : e == 3 ? tend2 : e == 4 ? tend3 : e == 5 ? tend4 : e == 6 ? tend5 : tend6;
        const int cn_ = e == 0 ? cnt0 : e == 1 ? cnt1 : e == 2 ? cnt2 : e == 3 ? cnt3 : e == 4 ? cnt4 : e == 5 ? cnt5 : e == 6 ? cnt6 : cnt7;
        const int slot = (u.pm - ts) * 256 + r;
        return slot < cn_ ? list[(long)e * cap + slot] : 0;
    }
};

typedef __bf16 bf16x2_c __attribute__((ext_vector_type(2)));
__device__ __forceinline__ unsigned cvt_pk_bf16(float lo, float hi) { const f32x2 v = {lo, hi}; return __builtin_bit_cast(unsigned, __builtin_convertvector(v, bf16x2_c)); }

struct EpiPlain {
    static constexpr bool PERM = true;
    int ldc; float scale;
    __device__ __forceinline__ void operator()(const f32x4 (&acc)[2][2][4][2], const Unit& u, int wr, int wc, int fr, int fq) const {
        bf16_t* base = u.c + (size_t)(wr * 64 + fr) * ldc + wc * 32 + 8 * fq;
#pragma unroll
        for (int ai = 0; ai < 2; ++ai)
#pragma unroll
            for (int m = 0; m < 4; ++m) { bf16_t* rowp = base + (size_t)(ai * HALF + m * 16) * ldc;
#pragma unroll
                for (int bj = 0; bj < 2; ++bj) { const f32x4 v0 = acc[ai][bj][m][0] * scale, v1 = acc[ai][bj][m][1] * scale;
                    u32x4 w; w.x = cvt_pk_bf16(v0[0], v0[1]); w.y = cvt_pk_bf16(v0[2], v0[3]); w.z = cvt_pk_bf16(v1[0], v1[1]); w.w = cvt_pk_bf16(v1[2], v1[3]);
                    *(u32x4*)(rowp + bj * HALF) = w; } }
    }
};
struct EpiMirror {
    static constexpr bool PERM = true;
    int ldc_unused;
    __device__ __forceinline__ void operator()(const f32x4 (&acc)[2][2][4][2], const Unit& u, int wr, int wc, int fr, int fq) const {
        constexpr long LDC = 2048;
        const int kt = u.pm & 7, ri = u.pm >> 3; const unsigned sx = ri ? 0x80008000u : 0u;
        const int r0 = wr * 64 + fr;
        bf16_t* nb = u.c + (long)r0 * LDC + wc * 32 + 8 * fq;
        bf16_t* mb = u.c + (long)(4096 - 512 * kt - r0) * LDC + wc * 32 + 8 * fq;
#pragma unroll
        for (int ai = 0; ai < 2; ++ai)
#pragma unroll
            for (int m = 0; m < 4; ++m) { bf16_t* rowp = nb + (long)(ai * HALF + m * 16) * LDC; bf16_t* mirp = mb - (long)(ai * HALF + m * 16) * LDC;
                if (ai == 0 && m == 0) mirp = (kt == 0 && r0 == 0) ? rowp : mirp;
#pragma unroll
                for (int bj = 0; bj < 2; ++bj) { const f32x4 v0 = acc[ai][bj][m][0], v1 = acc[ai][bj][m][1];
                    u32x4 w; w.x = cvt_pk_bf16(v0[0], v0[1]); w.y = cvt_pk_bf16(v0[2], v0[3]); w.z = cvt_pk_bf16(v1[0], v1[1]); w.w = cvt_pk_bf16(v1[2], v1[3]);
                    *(u32x4*)(rowp + bj * HALF) = w;
                    u32x4 x; x.x = w.x ^ sx; x.y = w.y ^ sx; x.z = w.z ^ sx; x.w = w.w ^ sx;
                    *(u32x4*)(mirp + bj * HALF) = x; } }
    }
};
struct EpiFFT2 {
    static constexpr bool PERM = true;
    int unused;
    __device__ __forceinline__ void operator()(const f32x4 (&acc)[2][2][4][2], const Unit& u, int wr, int wc, int fr, int fq) const {
        constexpr long LDC = 2048;
        bf16_t* base = u.c + wr * 256 + (long)fr * 64 * LDC + wc * 32 + 8 * fq;
#pragma unroll
        for (int ai = 0; ai < 2; ++ai)
#pragma unroll
            for (int m = 0; m < 4; ++m) { bf16_t* rowp = base + (long)ai * LDC + (long)(m * 16) * 64 * LDC;
#pragma unroll
                for (int bj = 0; bj < 2; ++bj) { const f32x4 v0 = acc[ai][bj][m][0], v1 = acc[ai][bj][m][1];
                    u32x4 w; w.x = cvt_pk_bf16(v0[0], v0[1]); w.y = cvt_pk_bf16(v0[2], v0[3]); w.z = cvt_pk_bf16(v1[0], v1[1]); w.w = cvt_pk_bf16(v1[2], v1[3]);
                    *(u32x4*)(rowp + bj * HALF) = w; } }
    }
};
__device__ __forceinline__ float silu_mul(float g, float u) { return g * u * __builtin_amdgcn_rcpf(1.0f + __builtin_amdgcn_exp2f(-g * LOG2E)); }
struct EpiSwiGLU {
    static constexpr bool PERM = true;
    int ldc;
    __device__ __forceinline__ void operator()(const f32x4 (&acc)[2][2][4][2], const Unit& u, int wr, int wc, int fr, int fq) const {
        bf16_t* base = u.c + (size_t)(wr * 64 + fr) * ldc + wc * 32 + 8 * fq;
#pragma unroll
        for (int ai = 0; ai < 2; ++ai)
#pragma unroll
            for (int m = 0; m < 4; ++m) { bf16_t* rowp = base + (size_t)(ai * HALF + m * 16) * ldc;
                const f32x4 g0 = acc[ai][0][m][0], g1 = acc[ai][0][m][1], u0 = acc[ai][1][m][0], u1 = acc[ai][1][m][1];
                u32x4 w; w.x = cvt_pk_bf16(silu_mul(g0[0], u0[0]), silu_mul(g0[1], u0[1])); w.y = cvt_pk_bf16(silu_mul(g0[2], u0[2]), silu_mul(g0[3], u0[3]));
                w.z = cvt_pk_bf16(silu_mul(g1[0], u1[0]), silu_mul(g1[1], u1[1])); w.w = cvt_pk_bf16(silu_mul(g1[2], u1[2]), silu_mul(g1[3], u1[3]));
                *(u32x4*)rowp = w; }
    }
};

struct EpiSwiGLU8 {
    static constexpr bool PERM = true;
    int ldc; float sin, sout;
    __device__ __forceinline__ void operator()(const f32x4 (&acc)[2][2][4][2], const Unit& u, int wr, int wc, int fr, int fq) const {
        unsigned char* base = (unsigned char*)u.c + (size_t)(wr * 64 + fr) * ldc + wc * 32 + 8 * fq;
#pragma unroll
        for (int ai = 0; ai < 2; ++ai)
#pragma unroll
            for (int m = 0; m < 4; ++m) { unsigned char* rowp = base + (size_t)(ai * HALF + m * 16) * ldc;
                const f32x4 g0 = acc[ai][0][m][0] * sin, g1 = acc[ai][0][m][1] * sin, u0 = acc[ai][1][m][0] * sin, u1 = acc[ai][1][m][1] * sin;
                u32x2 w; w.x = pk_fp8x4(silu_mul(g0[0], u0[0]) * sout, silu_mul(g0[1], u0[1]) * sout, silu_mul(g0[2], u0[2]) * sout, silu_mul(g0[3], u0[3]) * sout);
                w.y = pk_fp8x4(silu_mul(g1[0], u1[0]) * sout, silu_mul(g1[1], u1[1]) * sout, silu_mul(g1[2], u1[2]) * sout, silu_mul(g1[3], u1[3]) * sout);
                *(u32x2*)rowp = w; }
    }
};
__device__ __forceinline__ v8i cat8(bf16x8 lo, bf16x8 hi) { const v4i a = __builtin_bit_cast(v4i, lo), b = __builtin_bit_cast(v4i, hi); return __builtin_shufflevector(a, b, 0, 1, 2, 3, 4, 5, 6, 7); }
template <class Epi, bool GATHER, bool FP8 = false>
__device__ __forceinline__ void gemm_phase(LAS unsigned char* lds, const int K, const int lda, const int ldb, const Sched& S, const Epi& E) {
    const int tid = threadIdx.x, wid = __builtin_amdgcn_readfirstlane(tid >> 6), lane = tid & 63, wr = wid >> 2, wc = wid & 3, fr = lane & 15, fq = lane >> 4;
    const int nt_def = K / BK;
    unsigned voffA[2], voffB[2]; int RA[2], CA2[2];
#pragma unroll
    for (int i = 0; i < 2; ++i) { int R, C; stage_rc(tid * 16 + i * 8192, R, C); const int Rb = Epi::PERM ? ((R & ~31) + perm32(R & 31)) : R;
        voffA[i] = (unsigned)(R * lda + C) * 2u; voffB[i] = (unsigned)(Rb * ldb + C) * 2u; RA[i] = R; CA2[i] = C * 2; }
    const size_t kstep = (size_t)(BK * 2);
    const size_t hstepA = (size_t)HALF * lda * 2, hstepB = (size_t)HALF * ldb * 2;
    const unsigned ldsw = (unsigned)wid * 1024u;
    const int aoff = lds_byte(wr * 64 + fr, fq * 8), boff = lds_byte(wc * 32 + fr, fq * 8);
    unsigned gAc[2][2], gAn[2][2];
#define PG8_SA(b, h) (((b) * 2 + (h)) * HTB)
#define PG8_SB(b, h) ((4 + (b) * 2 + (h)) * HTB)
#define PG8_STAGE(bufoff, gbase, voff) do { _Pragma("unroll") for (int _i = 0; _i < 2; ++_i) \
        __builtin_amdgcn_global_load_lds((const unsigned*)((const char*)(gbase) + (voff)[_i]), (LAS unsigned*)(lds + (bufoff) + ldsw + _i * 8192), 16, 0, 0); } while (0)
#define PG8_STAGE_A(bufoff, kbase, h, NX) do { if constexpr (GATHER) { unsigned _o[2]; _o[0] = (NX) ? gAn[h][0] : gAc[h][0]; _o[1] = (NX) ? gAn[h][1] : gAc[h][1]; PG8_STAGE(bufoff, kbase, _o); } \
        else { PG8_STAGE(bufoff, (kbase) + (h) * hstepA, voffA); } } while (0)
#define PG8_LDA(dst, b, h) do { _Pragma("unroll") for (int m = 0; m < 4; ++m) _Pragma("unroll") for (int k = 0; k < 2; ++k) dst[m][k] = *(const LAS bf16x8*)(lds + PG8_SA(b, h) + aoff + m * 2048 + k * 1024); } while (0)
#define PG8_LDB(dst, b, h) do { _Pragma("unroll") for (int n = 0; n < 2; ++n) _Pragma("unroll") for (int k = 0; k < 2; ++k) dst[n][k] = *(const LAS bf16x8*)(lds + PG8_SB(b, h) + boff + n * 2048 + k * 1024); } while (0)
#define PG8_MMA(ai, bj, At, Bt) do { __builtin_amdgcn_s_setprio(1); if constexpr (FP8) { _Pragma("unroll") for (int m = 0; m < 4; ++m) _Pragma("unroll") for (int n = 0; n < 2; ++n) \
        { const v8i _b8 = cat8(Bt[n][0], Bt[n][1]), _a8 = cat8(At[m][0], At[m][1]); asm volatile("v_mfma_f32_16x16x128_f8f6f4 %0, %1, %2, %0" : "+v"(acc[ai][bj][m][n]) : "v"(_b8), "v"(_a8)); } } \
        else { _Pragma("unroll") for (int m = 0; m < 4; ++m) _Pragma("unroll") for (int n = 0; n < 2; ++n) _Pragma("unroll") for (int k = 0; k < 2; ++k) \
        acc[ai][bj][m][n] = __builtin_amdgcn_mfma_f32_16x16x32_bf16(Bt[n][k], At[m][k], acc[ai][bj][m][n], 0, 0, 0); } __builtin_amdgcn_s_setprio(0); } while (0)
#define PG8_WAIT_V(n) asm volatile("s_waitcnt vmcnt(" #n ")" ::: "memory")
#define PG8_WAIT_L(n) asm volatile("s_waitcnt lgkmcnt(" #n ")" ::: "memory")
#define PG8_BAR __builtin_amdgcn_s_barrier()
#define PG8_SCHED __builtin_amdgcn_sched_barrier(0)
#define PG8_GATHER_OFFS(dst, un) do { _Pragma("unroll") for (int _h = 0; _h < 2; ++_h) _Pragma("unroll") for (int _i = 0; _i < 2; ++_i) { \
        const int _t = S.gather_tok(un, _h * HALF + RA[_i]); dst[_h][_i] = (unsigned)_t * (unsigned)(lda * 2) + (unsigned)CA2[_i]; } } while (0)
    Unit cur, nxt; int ui = 0;
    if (!S.next(0, cur)) return;
    f32x4 acc[2][2][4][2];
#pragma unroll
    for (int a = 0; a < 2; ++a)
#pragma unroll
        for (int b = 0; b < 2; ++b)
#pragma unroll
            for (int m = 0; m < 4; ++m)
#pragma unroll
                for (int n = 0; n < 2; ++n) acc[a][b][m][n] = (f32x4){0.f, 0.f, 0.f, 0.f};
    bf16x8 At[4][2], B0[2][2], B1[2][2];
    const char* cA = cur.a; const char* cB = cur.b;
    if constexpr (GATHER) { PG8_GATHER_OFFS(gAc, cur); _Pragma("unroll") for (int _h = 0; _h < 2; ++_h) _Pragma("unroll") for (int _i = 0; _i < 2; ++_i) gAn[_h][_i] = gAc[_h][_i]; }
    PG8_STAGE(PG8_SB(0, 0), cB, voffB); PG8_STAGE(PG8_SB(0, 1), cB + hstepB, voffB); PG8_STAGE_A(PG8_SA(0, 0), cA, 0, false); PG8_STAGE_A(PG8_SA(0, 1), cA, 1, false);
    if (wr == 1) PG8_BAR;
    PG8_WAIT_V(2); PG8_BAR;
    PG8_STAGE(PG8_SB(1, 0), cB + kstep, voffB); PG8_STAGE_A(PG8_SA(1, 0), cA + kstep, 0, false); PG8_STAGE(PG8_SB(1, 1), cB + hstepB + kstep, voffB);
    PG8_WAIT_V(6); PG8_BAR;
    for (;;) {
        const bool has_next = S.next(ui + 1, nxt);
        const char* nA = has_next ? nxt.a : cA; const char* nB = has_next ? nxt.b : cB;
        if constexpr (GATHER) { if (has_next) { PG8_GATHER_OFFS(gAn, nxt); } }
        const int nt = cur.nt ? cur.nt : nt_def;
#pragma unroll 1
        for (int t = 0; t < nt; t += 2) {
            const bool last = (t == nt - 2);
            const char* a1 = cA + (size_t)(t + 1) * kstep;
            const char* a2 = last ? nA : cA + (size_t)(t + 2) * kstep; const char* b2 = last ? nB : cB + (size_t)(t + 2) * kstep;
            const char* a3 = a2 + kstep; const char* b3 = b2 + kstep;
            PG8_LDB(B0, 0, 0); PG8_LDB(B1, 0, 1); PG8_SCHED; PG8_LDA(At, 0, 0); PG8_STAGE_A(PG8_SA(1, 1), a1, 1, false);
            PG8_WAIT_V(8); PG8_WAIT_L(0); PG8_BAR; PG8_MMA(0, 0, At, B0); PG8_MMA(0, 1, At, B1); PG8_BAR; PG8_SCHED;
            PG8_LDA(At, 0, 1); PG8_STAGE(PG8_SB(0, 0), b2, voffB); PG8_STAGE(PG8_SB(0, 1), b2 + hstepB, voffB); PG8_STAGE_A(PG8_SA(0, 0), a2, 0, last);
            PG8_WAIT_V(8); PG8_WAIT_L(0); PG8_BAR; PG8_MMA(1, 0, At, B0); PG8_MMA(1, 1, At, B1); PG8_BAR; PG8_SCHED;
            PG8_LDB(B0, 1, 0); PG8_LDB(B1, 1, 1); PG8_SCHED; PG8_LDA(At, 1, 0); PG8_STAGE_A(PG8_SA(0, 1), a2, 1, last);
            PG8_WAIT_V(8); PG8_WAIT_L(0); PG8_BAR; PG8_MMA(0, 0, At, B0); PG8_MMA(0, 1, At, B1); PG8_BAR; PG8_SCHED;
            PG8_LDA(At, 1, 1); PG8_STAGE(PG8_SB(1, 0), b3, voffB); PG8_STAGE(PG8_SB(1, 1), b3 + hstepB, voffB); PG8_STAGE_A(PG8_SA(1, 0), a3, 0, last);
            PG8_WAIT_V(8); PG8_WAIT_L(0); PG8_BAR; PG8_MMA(1, 0, At, B0); PG8_MMA(1, 1, At, B1); PG8_BAR; PG8_SCHED;
        }
        if constexpr (FP8) asm volatile("s_nop 15\n\ts_nop 15" ::: "memory");
        if (wr == 0) PG8_BAR;
        E(acc, cur, wr, wc, fr, fq);
        if (!has_next) break;
#pragma unroll
        for (int a = 0; a < 2; ++a)
#pragma unroll
            for (int b = 0; b < 2; ++b)
#pragma unroll
                for (int m = 0; m < 4; ++m)
#pragma unroll
                    for (int n = 0; n < 2; ++n) acc[a][b][m][n] = (f32x4){0.f, 0.f, 0.f, 0.f};
        cur = nxt; cA = nA; cB = nB; ++ui;
        if constexpr (GATHER) { _Pragma("unroll") for (int _h = 0; _h < 2; ++_h) _Pragma("unroll") for (int _i = 0; _i < 2; ++_i) gAc[_h][_i] = gAn[_h][_i]; }
        if (wr == 1) PG8_BAR;
    }
    PG8_WAIT_V(0);
    PG8_BAR;
#undef PG8_SA
#undef PG8_SB
#undef PG8_STAGE
#undef PG8_STAGE_A
#undef PG8_LDA
#undef PG8_LDB
#undef PG8_MMA
#undef PG8_WAIT_V
#undef PG8_WAIT_L
#undef PG8_BAR
#undef PG8_SCHED
#undef PG8_GATHER_OFFS
}
}

constexpr bool MLA_SPEC = true;
constexpr int QKV8 = 2;
constexpr bool ATT_LSUM = true;
constexpr bool ATT_PV8 = true;
constexpr bool MLA_QK8 = true;
constexpr bool ATT_QK8 = true;
#ifndef ATT_NEGM
#define ATT_NEGM false
#endif
namespace att {
__device__ __forceinline__ float add_nopk(float a, float b) { float o = a + b; asm("" : "+v"(o)); return o; }
typedef __bf16 bf16x2_t __attribute__((ext_vector_type(2)));
__device__ __forceinline__ unsigned cvt2(float lo, float hi) { const f32x2 v = {lo, hi}; return __builtin_bit_cast(unsigned, __builtin_convertvector(v, bf16x2_t)); }
template <int DK, int NQ, bool NOREF = false>
__device__ __forceinline__ bool unit(LAS unsigned char* lds, const bf16_t* Qp, int qpitch, const bf16_t* Kp, int kpitch, const bf16_t* Vtp, int vtpitch, bf16_t* Op, int opitch, int ntiles, int nrows,
                                     const float* qgain = nullptr, const float* qtab = nullptr, int qpos0 = -1) {
    constexpr bool QK8 = ATT_QK8 && (DK == 64 || (DK == 96 && MLA_QK8));
    constexpr bool PV8 = QK8 && ATT_PV8;
    constexpr int NKC = QK8 ? DK / 16 : DK / 8, KBUF = NKC * 1024, VBUF = PV8 ? 4096 : 8192, ND0 = DK / 16;
    const int tid = threadIdx.x, lane = tid & 63, r = lane & 31, h = lane >> 5; const int wid = __builtin_amdgcn_readfirstlane(tid >> 6);
    LAS unsigned char* Kb = lds; LAS unsigned char* Vb = lds + 2 * KBUF;
    bf16x8 qf[NQ][ND0]; v8i qf8[NQ], qf8b[NQ];
#pragma unroll
    for (int j = 0; j < NQ; ++j) { qf8[j] = (v8i){0, 0, 0, 0, 0, 0, 0, 0}; qf8b[j] = (v8i){0, 0, 0, 0, 0, 0, 0, 0}; }
#pragma unroll
    for (int j = 0; j < NQ; ++j) { const bf16_t* qrow = Qp + (size_t)(wid * (32 * NQ) + j * 32 + r) * qpitch + h * 8;
#pragma unroll
      for (int d0 = 0; d0 < ND0; ++d0) qf[j][d0] = *(const bf16x8*)(qrow + d0 * 16); }
    if constexpr (DK == 64) { if (qgain != nullptr) {
        float g[4][8];
#pragma unroll
        for (int d0 = 0; d0 < 4; ++d0) { const f32x4 g0 = *(const f32x4*)(qgain + 16 * d0 + 8 * h), g1 = *(const f32x4*)(qgain + 16 * d0 + 8 * h + 4);
#pragma unroll
            for (int i = 0; i < 4; ++i) { g[d0][i] = g0[i]; g[d0][4 + i] = g1[i]; } }
#pragma unroll
        for (int j = 0; j < NQ; ++j) {
            float x[4][8]; float ss = 0.f;
#pragma unroll
            for (int d0 = 0; d0 < 4; ++d0) { unpack8(__builtin_bit_cast(u32x4, qf[j][d0]), x[d0]);
#pragma unroll
                for (int i = 0; i < 8; ++i) ss += x[d0][i] * x[d0][i]; }
            ss += __shfl_xor(ss, 32);
            const float rs = (1.0f / sqrtf(ss * (1.0f / 64.0f) + NORM_EPS)) * (0.125f * LOG2E);
#pragma unroll
            for (int d0 = 0; d0 < 4; ++d0)
#pragma unroll
                for (int i = 0; i < 8; ++i) x[d0][i] *= rs * g[d0][i];
            if (qpos0 >= 0) { const int sp = qpos0 + wid * (32 * NQ) + j * 32 + r;
#pragma unroll
                for (int part = 0; part < 2; ++part) { const int pp = part ? (sp & 63) : (sp >> 6); const float* tc = qtab + pp * 16 + 8 * h;
                    const f32x4 c0 = *(const f32x4*)tc, c1 = *(const f32x4*)(tc + 4), s0 = *(const f32x4*)(tc + 1024), s1 = *(const f32x4*)(tc + 1028);
#pragma unroll
                    for (int i = 0; i < 8; ++i) { const float cs = i < 4 ? c0[i & 3] : c1[i & 3], sn = i < 4 ? s0[i & 3] : s1[i & 3];
                        const float x1 = x[2 * part][i], x2 = x[2 * part + 1][i]; x[2 * part][i] = x1 * cs - x2 * sn; x[2 * part + 1][i] = x2 * cs + x1 * sn; } } }
#pragma unroll
            for (int d0 = 0; d0 < 4; ++d0) qf[j][d0] = __builtin_bit_cast(bf16x8, pack8(x[d0]));
            if constexpr (QK8) { qf8[j] = (v8i){(int)pk_fp8x4(x[0][0], x[0][1], x[0][2], x[0][3]), (int)pk_fp8x4(x[0][4], x[0][5], x[0][6], x[0][7]), (int)pk_fp8x4(x[1][0], x[1][1], x[1][2], x[1][3]), (int)pk_fp8x4(x[1][4], x[1][5], x[1][6], x[1][7]),
                                               (int)pk_fp8x4(x[2][0], x[2][1], x[2][2], x[2][3]), (int)pk_fp8x4(x[2][4], x[2][5], x[2][6], x[2][7]), (int)pk_fp8x4(x[3][0], x[3][1], x[3][2], x[3][3]), (int)pk_fp8x4(x[3][4], x[3][5], x[3][6], x[3][7])}; }
        } } }
    if constexpr (DK == 96) { if (qtab != nullptr) {
        const float C2m = 0.10206207261596577f * LOG2E;
#pragma unroll
        for (int j = 0; j < NQ; ++j) {
            float x[6][8];
#pragma unroll
            for (int d0 = 0; d0 < 6; ++d0) unpack8(__builtin_bit_cast(u32x4, qf[j][d0]), x[d0]);
            if (qpos0 >= 0) { const int sp = qpos0 + wid * (32 * NQ) + j * 32 + r;
#pragma unroll
                for (int part = 0; part < 2; ++part) { const int pp = part ? (sp & 63) : (sp >> 6); const float* tc = qtab + 2048 + pp * 8;
                    const f32x4 c0 = *(const f32x4*)tc, c1 = *(const f32x4*)(tc + 4), s0 = *(const f32x4*)(tc + 512), s1 = *(const f32x4*)(tc + 516);
#pragma unroll
                    for (int i = 0; i < 8; ++i) { const float cs = i < 4 ? c0[i & 3] : c1[i & 3], sn = i < 4 ? s0[i & 3] : s1[i & 3];
                        const float xv = x[4 + part][i], pr = __shfl_xor(xv, 32);
                        x[4 + part][i] = h ? (xv * cs + pr * sn) : (xv * cs - pr * sn); } } }
#pragma unroll
            for (int d0 = 0; d0 < 6; ++d0) {
#pragma unroll
                for (int i = 0; i < 8; ++i) x[d0][i] *= C2m;
                qf[j][d0] = __builtin_bit_cast(bf16x8, pack8(x[d0])); }
            if constexpr (QK8) { qf8[j] = (v8i){(int)pk_fp8x4(x[0][0], x[0][1], x[0][2], x[0][3]), (int)pk_fp8x4(x[0][4], x[0][5], x[0][6], x[0][7]), (int)pk_fp8x4(x[1][0], x[1][1], x[1][2], x[1][3]), (int)pk_fp8x4(x[1][4], x[1][5], x[1][6], x[1][7]),
                                               (int)pk_fp8x4(x[2][0], x[2][1], x[2][2], x[2][3]), (int)pk_fp8x4(x[2][4], x[2][5], x[2][6], x[2][7]), (int)pk_fp8x4(x[3][0], x[3][1], x[3][2], x[3][3]), (int)pk_fp8x4(x[3][4], x[3][5], x[3][6], x[3][7])};
                                 qf8b[j] = (v8i){(int)pk_fp8x4(x[4][0], x[4][1], x[4][2], x[4][3]), (int)pk_fp8x4(x[4][4], x[4][5], x[4][6], x[4][7]), (int)pk_fp8x4(x[5][0], x[5][1], x[5][2], x[5][3]), (int)pk_fp8x4(x[5][4], x[5][5], x[5][6], x[5][7]), 0, 0, 0, 0}; }
        } } }
    const bf16_t* kg0 = Kp + (size_t)lane * kpitch + wid * 8; const bf16_t* kg1 = kg0 + 64; const bf16_t* vg = Vtp + (size_t)lane * vtpitch + wid * 8;
    const bool k1 = wid < NKC, k2 = (wid + 8) < NKC;
    const char* vg8 = (const char*)Vtp + (size_t)lane * (vtpitch * 2) + (wid & 3) * 16;
#define ATT_DMA(t, slot) do { if (k1) __builtin_amdgcn_global_load_lds((const unsigned*)(kg0 + (size_t)(t) * 64 * kpitch), (LAS unsigned*)(Kb + (slot) * KBUF + wid * 1024), 16, 0, 0); \
        if (k2) __builtin_amdgcn_global_load_lds((const unsigned*)(kg1 + (size_t)(t) * 64 * kpitch), (LAS unsigned*)(Kb + (slot) * KBUF + (wid + 8) * 1024), 16, 0, 0); \
        if constexpr (PV8) { if (wid >= 4) __builtin_amdgcn_global_load_lds((const unsigned*)(vg8 + (size_t)(t) * 64), (LAS unsigned*)(Vb + (slot) * VBUF + (wid - 4) * 1024), 16, 0, 0); } \
        else __builtin_amdgcn_global_load_lds((const unsigned*)(vg + (t) * 64), (LAS unsigned*)(Vb + (slot) * VBUF + wid * 1024), 16, 0, 0); } while (0)
    ATT_DMA(0, 0);
    __syncthreads();
    const int prow = (r & ~12) | ((r & 4) << 1) | ((r & 8) >> 1);
    const int koff = h * 1024 + prow * 16, voff = h * 1024 + r * 16;
    constexpr bool PVSHARE = (DK == 64) || (NQ == 1) || NOREF;
    constexpr bool NEGM = (NQ == 1);
    f32x16 o0[NQ], o1[NQ], negm[NEGM ? NQ : 1]; float mref[NQ], lrun[NQ];
    negm[0] = f32x16{};
#pragma unroll
    for (int j = 0; j < NQ; ++j) { o0[j] = f32x16{}; o1[j] = f32x16{}; mref[j] = 0.f; lrun[j] = 0.f; if constexpr (NEGM) negm[j] = f32x16{}; }
    constexpr float THR = 8.0f;
    constexpr bool LSUM = NOREF && PV8 && ATT_LSUM;
    f32x16 lacc[NQ];
#pragma unroll
    for (int j = 0; j < NQ; ++j) lacc[j] = f32x16{};
    v8i ones8 = {0x38383838, 0x38383838, 0x38383838, 0x38383838, 0x38383838, 0x38383838, 0x38383838, 0x38383838};
    if constexpr (LSUM) asm volatile("" : "+v"(ones8));
    for (int t = 0; t < ntiles; ++t) {
        const int cur = t & 1; const bool more = (t + 1 < ntiles);
        if constexpr (!NOREF && !QK8) {
#pragma unroll
        for (int j = 0; j < NQ; ++j)
#pragma unroll
            for (int d0 = 0; d0 < ND0; ++d0) asm volatile("" : "+v"(qf[j][d0]));
        }
        if (more) ATT_DMA(t + 1, cur ^ 1);
        const LAS unsigned char* kb = Kb + cur * KBUF + koff; const LAS unsigned char* vb = Vb + cur * VBUF + voff;
        f32x16 p0[NQ], p1[NQ];
#pragma unroll
        for (int j = 0; j < NQ; ++j) { if constexpr (NEGM) { p0[j] = negm[j]; p1[j] = negm[j]; } else { p0[j] = f32x16{}; p1[j] = f32x16{}; } }
        constexpr bool QKSEQ = false, PINST = false;
        if constexpr (QK8) {
            const LAS unsigned char* k8 = Kb + cur * KBUF + h * 2048 + prow * 16;
            const v8i a0 = pg8::cat8(*(const LAS bf16x8*)(k8), *(const LAS bf16x8*)(k8 + 1024)), a1 = pg8::cat8(*(const LAS bf16x8*)(k8 + 512), *(const LAS bf16x8*)(k8 + 1024 + 512));
#pragma unroll
            for (int j = 0; j < NQ; ++j) {
                if constexpr (PV8) {
                asm volatile("v_mfma_f32_32x32x64_f8f6f4 %0, %1, %2, -4.0" : "=&v"(p0[j]) : "v"(a0), "v"(qf8[j]));
                asm volatile("v_mfma_f32_32x32x64_f8f6f4 %0, %1, %2, -4.0" : "=&v"(p1[j]) : "v"(a1), "v"(qf8[j])); } else {
                asm volatile("v_mfma_f32_32x32x64_f8f6f4 %0, %1, %2, 0" : "=&v"(p0[j]) : "v"(a0), "v"(qf8[j]));
                asm volatile("v_mfma_f32_32x32x64_f8f6f4 %0, %1, %2, 0" : "=&v"(p1[j]) : "v"(a1), "v"(qf8[j])); } }
            if constexpr (DK == 96) {
                const bf16x8 z8 = bf16x8{};
                const v8i b0 = pg8::cat8(*(const LAS bf16x8*)(Kb + cur * KBUF + (4 + h) * 1024 + prow * 16), z8), b1 = pg8::cat8(*(const LAS bf16x8*)(Kb + cur * KBUF + (4 + h) * 1024 + prow * 16 + 512), z8);
#pragma unroll
                for (int j = 0; j < NQ; ++j) {
                    asm volatile("v_mfma_f32_32x32x64_f8f6f4 %0, %1, %2, %0" : "+v"(p0[j]) : "v"(b0), "v"(qf8b[j]));
                    asm volatile("v_mfma_f32_32x32x64_f8f6f4 %0, %1, %2, %0" : "+v"(p1[j]) : "v"(b1), "v"(qf8b[j])); } }
            static_assert(!QK8 || NQ == 2, "QK8 assumes two query blocks");
            asm volatile("s_nop 15\n\ts_nop 7" : "+v"(p0[0]), "+v"(p1[0]), "+v"(p0[NQ - 1]), "+v"(p1[NQ - 1]));
        } else
        if constexpr (!QKSEQ) {
#pragma unroll
        for (int d0 = 0; d0 < ND0; ++d0) { const bf16x8 a0 = *(const LAS bf16x8*)(kb + d0 * 2048), a1 = *(const LAS bf16x8*)(kb + d0 * 2048 + 512);
#pragma unroll
            for (int j = 0; j < NQ; ++j) { p0[j] = __builtin_amdgcn_mfma_f32_32x32x16_bf16(a0, qf[j][d0], p0[j], 0, 0, 0); p1[j] = __builtin_amdgcn_mfma_f32_32x32x16_bf16(a1, qf[j][d0], p1[j], 0, 0, 0); } }
        }
        if constexpr (PINST) __builtin_amdgcn_sched_barrier(0);
        bf16x8 pb[NQ][4]; v8i p8[NQ];
#pragma unroll
        for (int j = 0; j < NQ; ++j) {
            if constexpr (QKSEQ) { asm volatile("" ::: "memory");
#pragma unroll
                for (int d0 = 0; d0 < ND0; ++d0) { const bf16x8 a0 = *(const LAS bf16x8*)(kb + d0 * 2048), a1 = *(const LAS bf16x8*)(kb + d0 * 2048 + 512);
                    p0[j] = __builtin_amdgcn_mfma_f32_32x32x16_bf16(a0, qf[j][d0], p0[j], 0, 0, 0); p1[j] = __builtin_amdgcn_mfma_f32_32x32x16_bf16(a1, qf[j][d0], p1[j], 0, 0, 0); } }
            if constexpr (!NOREF) {
            float mx = fmaxf(fmaxf(p0[j][0], p0[j][1]), p1[j][0]);
#pragma unroll
            for (int i = 2; i < 16; i += 2) mx = fmaxf(fmaxf(mx, p0[j][i]), p0[j][i + 1]);
#pragma unroll
            for (int i = 1; i < 15; i += 2) mx = fmaxf(fmaxf(mx, p1[j][i]), p1[j][i + 1]);
            mx = fmaxf(mx, p1[j][15]);
            mx = fmaxf(mx, __shfl_xor(mx, 32));
            if constexpr (!NEGM) mx -= mref[j];
            if (t == 0 || __any(mx > THR)) {
                const float dl = (t == 0) ? mx : fmaxf(mx, 0.f); const float f = __builtin_amdgcn_exp2f(-dl);
                mref[j] += dl; lrun[j] *= f;
#pragma unroll
                for (int i = 0; i < 16; ++i) { o0[j][i] *= f; o1[j][i] *= f; }
                if constexpr (NEGM) {
#pragma unroll
                    for (int i = 0; i < 16; ++i) { p0[j][i] -= dl; p1[j][i] -= dl; negm[j][i] = -mref[j]; } }
            }
            }
            const float sub = NEGM ? 0.f : mref[j];
            float ls = lrun[j];
            if constexpr (LSUM) {
#pragma unroll
            for (int i = 0; i < 16; ++i) { p0[j][i] = __builtin_amdgcn_exp2f(p0[j][i]); p1[j][i] = __builtin_amdgcn_exp2f(p1[j][i]); }
            } else {
#pragma unroll
            for (int i = 0; i < 16; ++i) { p0[j][i] = __builtin_amdgcn_exp2f((NEGM || NOREF) ? p0[j][i] : p0[j][i] - sub); ls = add_nopk(ls, p0[j][i]); }
#pragma unroll
            for (int i = 0; i < 16; ++i) { p1[j][i] = __builtin_amdgcn_exp2f((NEGM || NOREF) ? p1[j][i] : p1[j][i] - sub); ls = add_nopk(ls, p1[j][i]); }
            }
            lrun[j] = ls;
            if constexpr (PINST) { asm volatile("" : "+v"(lrun[j])); __builtin_amdgcn_sched_barrier(0); }
            if constexpr (PV8) {
                int w_[8];
#pragma unroll
                for (int q = 0; q < 4; ++q) { int t0 = __builtin_amdgcn_cvt_pk_bf8_f32(p0[j][4 * q], p0[j][4 * q + 1], 0, false); w_[q] = __builtin_amdgcn_cvt_pk_bf8_f32(p0[j][4 * q + 2], p0[j][4 * q + 3], t0, true);
                                              int t1 = __builtin_amdgcn_cvt_pk_bf8_f32(p1[j][4 * q], p1[j][4 * q + 1], 0, false); w_[4 + q] = __builtin_amdgcn_cvt_pk_bf8_f32(p1[j][4 * q + 2], p1[j][4 * q + 3], t1, true); }
                p8[j] = (v8i){w_[0], w_[1], w_[2], w_[3], w_[4], w_[5], w_[6], w_[7]};
            } else {
#pragma unroll
            for (int s = 0; s < 4; ++s) { u32x4 pw;
                if (s < 2) { pw.x = cvt2(p0[j][8 * s + 0], p0[j][8 * s + 1]); pw.y = cvt2(p0[j][8 * s + 2], p0[j][8 * s + 3]); pw.z = cvt2(p0[j][8 * s + 4], p0[j][8 * s + 5]); pw.w = cvt2(p0[j][8 * s + 6], p0[j][8 * s + 7]); }
                else { const int q = s - 2; pw.x = cvt2(p1[j][8 * q + 0], p1[j][8 * q + 1]); pw.y = cvt2(p1[j][8 * q + 2], p1[j][8 * q + 3]); pw.z = cvt2(p1[j][8 * q + 4], p1[j][8 * q + 5]); pw.w = cvt2(p1[j][8 * q + 6], p1[j][8 * q + 7]); }
                pb[j][s] = __builtin_bit_cast(bf16x8, pw); }
            }
            if constexpr (PINST) __builtin_amdgcn_sched_barrier(0);
            if constexpr (!PVSHARE && !PV8) {
#pragma unroll
                for (int s = 0; s < 4; ++s) { const bf16x8 v0 = *(const LAS bf16x8*)(vb + s * 2048), v1 = *(const LAS bf16x8*)(vb + s * 2048 + 512);
                    o0[j] = __builtin_amdgcn_mfma_f32_32x32x16_bf16(v0, pb[j][s], o0[j], 0, 0, 0); o1[j] = __builtin_amdgcn_mfma_f32_32x32x16_bf16(v1, pb[j][s], o1[j], 0, 0, 0); }
                if constexpr (NOREF) __builtin_amdgcn_sched_barrier(0); }
        }
        if constexpr (PV8) {
            const LAS unsigned char* v8 = Vb + cur * VBUF + h * 2048 + r * 16;
            const v8i va = pg8::cat8(*(const LAS bf16x8*)(v8), *(const LAS bf16x8*)(v8 + 1024)), vb1 = pg8::cat8(*(const LAS bf16x8*)(v8 + 512), *(const LAS bf16x8*)(v8 + 1024 + 512));
#pragma unroll
            for (int j = 0; j < NQ; ++j) {
                asm volatile("s_nop 1\n\tv_mfma_f32_32x32x64_f8f6f4 %0, %1, %2, %0 cbsz:0 blgp:1" : "+v"(o0[j]) : "v"(va), "v"(p8[j]));
                asm volatile("v_mfma_f32_32x32x64_f8f6f4 %0, %1, %2, %0 cbsz:0 blgp:1" : "+v"(o1[j]) : "v"(vb1), "v"(p8[j]));
                if constexpr (LSUM) asm volatile("s_nop 1\n\tv_mfma_f32_32x32x64_f8f6f4 %0, %1, %2, %0 cbsz:0 blgp:1" : "+v"(lacc[j]) : "v"(ones8), "v"(p8[j])); }
        } else
        if constexpr (PVSHARE) {
#pragma unroll
        for (int s = 0; s < 4; ++s) {
            const bf16x8 v0 = *(const LAS bf16x8*)(vb + s * 2048), v1 = *(const LAS bf16x8*)(vb + s * 2048 + 512);
#pragma unroll
            for (int j = 0; j < NQ; ++j) { o0[j] = __builtin_amdgcn_mfma_f32_32x32x16_bf16(v0, pb[j][s], o0[j], 0, 0, 0); o1[j] = __builtin_amdgcn_mfma_f32_32x32x16_bf16(v1, pb[j][s], o1[j], 0, 0, 0); }
        }
        }
        __syncthreads();
    }
#undef ATT_DMA
    if constexpr (LSUM) asm volatile("s_nop 15\n\ts_nop 7" : "+v"(lacc[0]), "+v"(lacc[NQ - 1]) : "v"(ones8));
    if constexpr (PV8) asm volatile("s_nop 15\n\ts_nop 7" : "+v"(o0[0]), "+v"(o1[0]), "+v"(o0[NQ - 1]), "+v"(o1[NQ - 1]));
    if constexpr (NOREF && DK == 96) { int bad = 0;
#pragma unroll
        for (int j = 0; j < NQ; ++j) { const int qr = wid * (32 * NQ) + j * 32 + r; const float ltot = LSUM ? lacc[j][0] : lrun[j] + __shfl_xor(lrun[j], 32);
            if (qr < nrows && !(ltot >= 8.7e-19f && ltot <= (PV8 ? 3.2e4f : 1.2e30f))) bad = 1; }
        if (__syncthreads_or(bad)) return false; }
#pragma unroll
    for (int j = 0; j < NQ; ++j) {
        const int qr = wid * (32 * NQ) + j * 32 + r;
        const float ltot = LSUM ? lacc[j][0] : lrun[j] + __shfl_xor(lrun[j], 32); const float inv = 1.0f / ltot;
        if (qr < nrows) {
            bf16_t* orow = Op + (size_t)qr * opitch + 4 * h;
#pragma unroll
            for (int g = 0; g < 4; ++g) {
                u32x2 w0, w1; w0.x = pk2(o0[j][4 * g] * inv, o0[j][4 * g + 1] * inv); w0.y = pk2(o0[j][4 * g + 2] * inv, o0[j][4 * g + 3] * inv);
                w1.x = pk2(o1[j][4 * g] * inv, o1[j][4 * g + 1] * inv); w1.y = pk2(o1[j][4 * g + 2] * inv, o1[j][4 * g + 3] * inv);
                *(u32x2*)(orow + 8 * g) = w0; *(u32x2*)(orow + 32 + 8 * g) = w1;
            }
        }
    }
    return true;
}
}

#define XB_TMO      128
#define XB_XCNT(j)  (256  + 64 * (j))
#define XB_XSUB(j)  (1280 + 64 * (j))
#define XB_XGEN(j)  (2304 + 64 * (j))
#define XB_TOP      3328
#define XB_TOPGEN   3392
#define XCD_BAR_WORDS 3456
#define XB_SPIN_CAP (1u << 22)
__device__ __forceinline__ unsigned xb_ld(unsigned* p)              { return __hip_atomic_load(p, __ATOMIC_RELAXED, __HIP_MEMORY_SCOPE_AGENT); }
__device__ __forceinline__ unsigned xb_add(unsigned* p, unsigned v) { return __hip_atomic_fetch_add(p, v, __ATOMIC_RELAXED, __HIP_MEMORY_SCOPE_AGENT); }
__device__ __forceinline__ unsigned xb_xcc_id() { return (unsigned)__builtin_amdgcn_s_getreg((3 << 11) | 20) & 0xFu; }
#define XB_SPIN(cond, bar) do { unsigned _sp = 0; while (cond) { __builtin_amdgcn_s_sleep(1); \
    if ((++_sp & 255u) == 0u) { if (xb_ld(&(bar)[XB_TMO])) break; if (_sp > XB_SPIN_CAP) { atomicAdd(&(bar)[XB_TMO], 1u); break; } } } } while (0)
struct XcdBarrier { unsigned* bar; unsigned x; volatile LAS unsigned* st; };
__device__ __forceinline__ XcdBarrier xcd_barrier_post(unsigned* bar, volatile LAS unsigned* st) {
    XcdBarrier b; b.bar = bar; b.x = xb_xcc_id(); b.st = st;
    if (threadIdx.x == 0) (void)xb_add(&bar[XB_XCNT(b.x)], 1u);
    return b;
}
__device__ __forceinline__ void xcd_barrier_complete(unsigned* bar, unsigned x, unsigned& nloc, unsigned& nx) {
    const unsigned G = gridDim.x * gridDim.y * gridDim.z;
    unsigned sum, cnt, mine, sp = 0u;
    for (;;) {
        sum = 0u; cnt = 0u; mine = 0u;
#pragma unroll
        for (unsigned j = 0; j < 16; ++j) { const unsigned c = xb_ld(&bar[XB_XCNT(j)]); sum += c; cnt += (c > 0u) ? 1u : 0u; mine = (j == x) ? c : mine; }
        if (sum == G) break;
        __builtin_amdgcn_s_sleep(1);
        if ((++sp & 255u) == 0u) { if (xb_ld(&bar[XB_TMO])) break; if (sp > XB_SPIN_CAP) { atomicAdd(&bar[XB_TMO], 1u); break; } }
    }
    nloc = mine > 0u ? mine : 1u; nx = cnt > 0u ? cnt : 1u;
}
__device__ __forceinline__ void xcd_barrier(const XcdBarrier& b) {
    asm volatile("s_waitcnt vmcnt(0)" ::: "memory");
    __syncthreads();
    if (threadIdx.x == 0) {
        unsigned* bar = b.bar;
        __builtin_amdgcn_s_waitcnt(0);
        unsigned nloc = b.st[0], nx = b.st[1];
        if (nloc == 0u) { xcd_barrier_complete(bar, b.x, nloc, nx); b.st[0] = nloc; b.st[1] = nx; }
        const unsigned old = xb_add(&bar[XB_XSUB(b.x)], 1u);
        const unsigned gen = old / nloc;
        if (old + 1u == (gen + 1u) * nloc) {
            __builtin_amdgcn_fence(__ATOMIC_RELEASE, "agent");
            asm volatile("s_waitcnt vmcnt(0)" ::: "memory");
            const unsigned og = xb_add(&bar[XB_TOP], 1u);
            const unsigned tg = og / nx;
            if (og + 1u == (tg + 1u) * nx) xb_add(&bar[XB_TOPGEN], 1u);
            else XB_SPIN(xb_ld(&bar[XB_TOPGEN]) == tg, bar);
            __builtin_amdgcn_fence(__ATOMIC_ACQUIRE, "agent");
            xb_add(&bar[XB_XGEN(b.x)], 1u);
            asm volatile("s_waitcnt vmcnt(0)" ::: "memory");
        } else {
            XB_SPIN(xb_ld(&bar[XB_XGEN(b.x)]) == gen, bar);
            __builtin_amdgcn_fence(__ATOMIC_ACQUIRE, "agent");
            asm volatile("s_waitcnt vmcnt(0)" ::: "memory");
        }
    }
    __syncthreads();
}

struct Frame {
    LAS unsigned char* lds;
    unsigned* ctl;
    unsigned char* ws;
    int tid, lane, wave, vcu, G, bx;
    const float* in[23];
    float* out;
};
#define WSP(T, off) ((T*)(F.ws + (off)))

struct Row { f32x4 v[4]; };
__device__ __forceinline__ Row ld_row_f32(const float* p, int lane) { Row r; const f32x4* q = (const f32x4*)p + lane;
#pragma unroll
    for (int j = 0; j < 4; ++j) r.v[j] = q[64 * j]; return r; }
__device__ __forceinline__ Row ld_row_f32_nt(const float* p, int lane) { Row r; const f32x4* q = (const f32x4*)p + lane;
#pragma unroll
    for (int j = 0; j < 4; ++j) r.v[j] = __builtin_nontemporal_load(q + 64 * j); return r; }
__device__ __forceinline__ void st_row_f32(float* p, int lane, const Row& r) { f32x4* q = (f32x4*)p + lane;
#pragma unroll
    for (int j = 0; j < 4; ++j) __builtin_nontemporal_store(r.v[j], q + 64 * j); }
__device__ __forceinline__ Row ld_row_bf16(const bf16_t* p, int lane) { Row r; const u32x2* q = (const u32x2*)p + lane;
#pragma unroll
    for (int j = 0; j < 4; ++j) { const u32x2 w = q[64 * j]; r.v[j] = (f32x4){bflo(w.x), bfhi(w.x), bflo(w.y), bfhi(w.y)}; } return r; }
__device__ __forceinline__ void st_row_bf16(bf16_t* p, int lane, const Row& r) { u32x2* q = (u32x2*)p + lane;
#pragma unroll
    for (int j = 0; j < 4; ++j) { u32x2 w; w.x = pk2(r.v[j][0], r.v[j][1]); w.y = pk2(r.v[j][2], r.v[j][3]); q[64 * j] = w; } }
__device__ __forceinline__ float row_rstd(const Row& r) { float s = 0.f;
#pragma unroll
    for (int j = 0; j < 4; ++j) s += (r.v[j][0] * r.v[j][0] + r.v[j][1] * r.v[j][1]) + (r.v[j][2] * r.v[j][2] + r.v[j][3] * r.v[j][3]);
    return 1.0f / sqrtf(wave_sum(s) * (1.0f / D) + NORM_EPS); }
__device__ __forceinline__ Row modnorm(const Row& x, const float* g, const float* shift, const float* scale, int lane) {
    const float rs = row_rstd(x); const Row G = ld_row_f32(g, lane), SH = ld_row_f32(shift, lane), SC = ld_row_f32(scale, lane); Row h;
#pragma unroll
    for (int j = 0; j < 4; ++j) h.v[j] = (x.v[j] * rs * G.v[j]) * (1.0f + SC.v[j]) + SH.v[j];
    return h; }
__device__ __forceinline__ Row resid(const Row& x, const Row& y, const float* g, const float* gate, int lane) {
    const float rs = row_rstd(y); const Row G = ld_row_f32(g, lane), GT = ld_row_f32(gate, lane); Row o;
#pragma unroll
    for (int j = 0; j < 4; ++j) o.v[j] = x.v[j] + GT.v[j] * (y.v[j] * rs * G.v[j]);
    return o; }
__device__ __forceinline__ const float* modp(Frame& F, int layer, int mrow, int chunk) { return WSP(const float, WS_MOD) + ((size_t)(layer * 9 + mrow) * 6 + chunk) * D; }
__device__ __forceinline__ const float* normg(Frame& F, int layer, int k) { return F.in[6] + (size_t)(layer * 4 + k) * D; }

__device__ __forceinline__ void cvt_tile(const float* src, size_t ldsrc, bf16_t* dst, size_t lddst, int lane) {
    const int kg = lane >> 3, ng = lane & 7;
    const float* p = src + (size_t)(8 * kg) * ldsrc + 4 * ng;
    f32x4 v[8];
#pragma unroll
    for (int j = 0; j < 8; ++j) v[j] = *(const f32x4*)(p + (size_t)j * ldsrc);
    bf16_t* o = dst + (size_t)(4 * ng) * lddst + 8 * kg;
#pragma unroll
    for (int q = 0; q < 4; ++q) { u32x4 w; w.x = pk2(v[0][q], v[1][q]); w.y = pk2(v[2][q], v[3][q]); w.z = pk2(v[4][q], v[5][q]); w.w = pk2(v[6][q], v[7][q]); *(u32x4*)(o + (size_t)q * lddst) = w; }
}
template <bool GU>
__device__ __forceinline__ void cvt_matrix(const float* W, int K, int N, bf16_t* WT, int gw, int NGW, int lane) {
    const int nblk = N / 32, nitem = (K / 64) * nblk, FF = N / 2;
    for (int it = gw; it < nitem; it += NGW) {
        const int kb = it / nblk, nb = it % nblk, k0 = 64 * kb, n0 = 32 * nb;
        int drow = n0;
        if (GU) { const int half = n0 >= FF ? 1 : 0, n1 = n0 - half * FF; drow = 256 * (n1 / 128) + 128 * half + (n1 % 128); }
        cvt_tile(W + (size_t)k0 * N + n0, (size_t)N, WT + (size_t)drow * K + k0, (size_t)K, lane);
    }
}
__device__ __forceinline__ void cvt_tile8(const float* src, size_t ldsrc, unsigned char* dst, size_t lddst, float sc, int lane) {
    const int kg = lane >> 3, ng = lane & 7;
    const float* p = src + (size_t)(16 * kg) * ldsrc + 4 * ng;
    f32x4 v[16];
#pragma unroll
    for (int j = 0; j < 16; ++j) v[j] = *(const f32x4*)(p + (size_t)j * ldsrc);
    unsigned char* o = dst + (size_t)(4 * ng) * lddst + 16 * kg;
#pragma unroll
    for (int q = 0; q < 4; ++q) { u32x4 w;
        w.x = pk_fp8x4(v[0][q] * sc, v[1][q] * sc, v[2][q] * sc, v[3][q] * sc); w.y = pk_fp8x4(v[4][q] * sc, v[5][q] * sc, v[6][q] * sc, v[7][q] * sc);
        w.z = pk_fp8x4(v[8][q] * sc, v[9][q] * sc, v[10][q] * sc, v[11][q] * sc); w.w = pk_fp8x4(v[12][q] * sc, v[13][q] * sc, v[14][q] * sc, v[15][q] * sc);
        *(u32x4*)(o + (size_t)q * lddst) = w; }
}
template <bool GU>
__device__ __forceinline__ void cvt_matrix8(const float* W, int K, int N, unsigned char* WT, float sc, int nmat, int gw, int NGW, int lane) {
    const int nblk = N / 32, per = (K / 128) * nblk, nitem = per * nmat, FF = N / 2;
    for (int it = gw; it < nitem; it += NGW) {
        const int m = it / per, r = it - m * per, kb = r / nblk, nb = r % nblk, k0 = 128 * kb, n0 = 32 * nb;
        int drow = n0;
        if (GU) { const int half = n0 >= FF ? 1 : 0, n1 = n0 - half * FF; drow = 256 * (n1 / 128) + 128 * half + (n1 % 128); }
        cvt_tile8(W + (size_t)m * K * N + (size_t)k0 * N + n0, (size_t)N, WT + (size_t)m * K * N + (size_t)drow * K + k0, (size_t)K, sc, lane);
    }
}
__device__ __forceinline__ float silu_f(float x) { return x / (1.0f + __expf(-x)); }

__device__ __forceinline__ void p_prologue(Frame& F) {
    LAS float* sc = (LAS float*)(F.lds + 69632);
    const int gw = F.vcu * NWAVES + F.wave, NGW = F.G * NWAVES, lane = F.lane;
    for (int i = F.tid; i < 9 * D; i += 512) { const int r = i / D, k = i % D; sc[i] = silu_f(r < 8 ? F.in[1][r * D + k] : F.in[3][k]); }
    __syncthreads();
    { LAS float* red = (LAS float*)F.lds;
      for (int bi = F.vcu; bi < 4 * 192; bi += F.G) {
        const int l = bi / 192, n0 = (bi % 192) * 32, cg = lane & 7, kq = lane >> 3, kb = F.wave * 8 + kq;
        const float* w = F.in[4] + (size_t)l * D * 6144 + (size_t)kb * 6144 + n0 + 4 * cg;
        f32x4 wv[16];
#pragma unroll
        for (int i = 0; i < 16; ++i) wv[i] = *(const f32x4*)(w + (size_t)i * 64 * 6144);
        f32x4 a[9];
#pragma unroll
        for (int r = 0; r < 9; ++r) a[r] = (f32x4){0.f, 0.f, 0.f, 0.f};
#pragma unroll
        for (int i = 0; i < 16; ++i) {
#pragma unroll
            for (int r = 0; r < 9; ++r) { const float sv = sc[r * D + kb + 64 * i]; a[r] = a[r] + wv[i] * sv; } }
#pragma unroll
        for (int r = 0; r < 9; ++r) {
#pragma unroll
            for (int q = 0; q < 4; ++q) { float v = a[r][q]; v += __shfl_xor(v, 8); v += __shfl_xor(v, 16); v += __shfl_xor(v, 32); a[r][q] = v; } }
        if (kq == 0) {
#pragma unroll
            for (int r = 0; r < 9; ++r) *(LAS f32x4*)(red + (F.wave * 9 + r) * 32 + 4 * cg) = a[r]; }
        __syncthreads();
        if (F.tid < 288) { const int r = F.tid >> 5, c = F.tid & 31; float sacc = F.in[5][l * 6144 + n0 + c];
#pragma unroll
            for (int w8 = 0; w8 < 8; ++w8) sacc += red[(w8 * 9 + r) * 32 + c];
            WSP(float, WS_MOD)[(size_t)(l * 9 + r) * 6144 + n0 + c] = sacc; }
        __syncthreads();
      } }
    for (int it = gw; it < 2048; it += NGW) {
        const int g = it >> 9, ch = (it >> 8) & 1, n0 = (it & 255) * 4, c0 = ch * 128 + 2 * lane; const float* fw = F.in[11] + (size_t)(g * 256) * D + n0;
        const f32x2 wr = {__builtin_amdgcn_cosf((float)c0 * (1.0f / 256.0f)), __builtin_amdgcn_cosf((float)(c0 + 1) * (1.0f / 256.0f))};
        const f32x2 wi = {__builtin_amdgcn_sinf((float)c0 * (1.0f / 256.0f)), __builtin_amdgcn_sinf((float)(c0 + 1) * (1.0f / 256.0f))};
        f32x2 ac[4], as[4];
#pragma unroll
        for (int q = 0; q < 4; ++q) { ac[q] = (f32x2){0.f, 0.f}; as[q] = (f32x2){0.f, 0.f}; }
        for (int l0 = 0; l0 < 256; l0 += 32) {
            f32x2 cr = {__builtin_amdgcn_cosf((float)((l0 * c0) & 255) * (1.0f / 256.0f)), __builtin_amdgcn_cosf((float)((l0 * (c0 + 1)) & 255) * (1.0f / 256.0f))};
            f32x2 ci = {__builtin_amdgcn_sinf((float)((l0 * c0) & 255) * (1.0f / 256.0f)), __builtin_amdgcn_sinf((float)((l0 * (c0 + 1)) & 255) * (1.0f / 256.0f))};
            f32x4 f[32];
#pragma unroll
            for (int l = 0; l < 32; ++l) f[l] = *(const f32x4*)(fw + (size_t)(l0 + l) * D);
#pragma unroll
            for (int l = 0; l < 32; ++l) {
#pragma unroll
                for (int q = 0; q < 4; ++q) { ac[q] = ac[q] + cr * f[l][q]; as[q] = as[q] + ci * f[l][q]; }
                const f32x2 nr = cr * wr - ci * wi, ni = cr * wi + ci * wr; cr = nr; ci = ni; }
        }
        bf16_t* o = WSP(bf16_t, WS_WFP) + (size_t)n0 * 2048 + g * 512 + c0;
#pragma unroll
        for (int q = 0; q < 4; ++q) { *(unsigned*)(o + (size_t)q * 2048) = pk2(ac[q][0], ac[q][1]); *(unsigned*)(o + (size_t)q * 2048 + 256) = pk2(-as[q][0], -as[q][1]); }
    }
    { const long NT = (long)F.G * 512; const long gt = (long)F.vcu * 512 + F.tid;
      if (FOURIER_FFT) {
        for (long it = gt; it < (long)(512 + 256) * 32; it += NT) { const int row = (int)(it >> 5), c8 = (int)(it & 31); float v[8];
#pragma unroll
            for (int j = 0; j < 8; ++j) { const int col = c8 * 8 + j; float x = 0.f;
                if (row < 512) { const int cl = row >> 7, ri = (row >> 6) & 1, kl = row & 63, cl2 = col >> 6, a = col & 63;
                    if (cl == cl2) { const float ph = (float)((kl * a) & 63) * (1.0f / 64.0f); x = ri ? -__builtin_amdgcn_sinf(ph) : __builtin_amdgcn_cosf(ph); } }
                else { const int r2 = row - 512, kl = r2 >> 7, ro = (r2 >> 6) & 1, kh = r2 & 63, kl2 = col >> 7, ri = (col >> 6) & 1, c = col & 63;
                    if (kl == kl2) { const float ph = (float)((kh * c) & 63) * (1.0f / 64.0f); const float cs = __builtin_amdgcn_cosf(ph), sn = __builtin_amdgcn_sinf(ph);
                        x = (ro == 0 ? (ri == 0 ? cs : sn) : (ri == 0 ? sn : -cs)) * (1.0f / 1024.0f); } }
                v[j] = x; }
            u32x4 w; w.x = pk2(v[0], v[1]); w.y = pk2(v[2], v[3]); w.z = pk2(v[4], v[5]); w.w = pk2(v[6], v[7]);
            *(u32x4*)((row < 512 ? WSP(bf16_t, WS_BD1) + (size_t)row * 256 : WSP(bf16_t, WS_T2BD) + (size_t)(row - 512) * 256) + c8 * 8) = w; }
      } else
      for (long it = gt; it < (long)4096 * 512; it += NT) { const int row = (int)(it >> 9), s8 = (int)(it & 511), ri = row >> 11, k = row & 2047; float v[8];
#pragma unroll
          for (int j = 0; j < 8; ++j) { const float ph = (float)((k * (s8 * 8 + j)) & 4095) * (1.0f / 4096.0f); v[j] = (ri ? __builtin_amdgcn_sinf(ph) : __builtin_amdgcn_cosf(ph)) * (1.0f / 1024.0f); }
          u32x4 w; w.x = pk2(v[0], v[1]); w.y = pk2(v[2], v[3]); w.z = pk2(v[4], v[5]); w.w = pk2(v[6], v[7]); *(u32x4*)(WSP(bf16_t, WS_TSEQ) + (size_t)row * 4096 + s8 * 8) = w; }
      for (long it = gt; it < (long)512 * 32; it += NT) { const int row = (int)(it >> 5), s8 = (int)(it & 31), ri = row >> 8, k = row & 255; float v[8];
#pragma unroll
          for (int j = 0; j < 8; ++j) { const float ph = (float)((k * (s8 * 8 + j)) & 255) * (1.0f / 256.0f); v[j] = (ri ? __builtin_amdgcn_sinf(ph) : __builtin_amdgcn_cosf(ph)) * (1.0f / 256.0f); }
          u32x4 w; w.x = pk2(v[0], v[1]); w.y = pk2(v[2], v[3]); w.z = pk2(v[4], v[5]); w.w = pk2(v[6], v[7]); *(u32x4*)(WSP(bf16_t, WS_TCTX) + (size_t)row * 256 + s8 * 8) = w; }
      for (long it = gt; it < 96 * 128; it += NT) *(u32x4*)(WSP(bf16_t, WS_WMD) + (size_t)672 * D + it * 8) = (u32x4){0u, 0u, 0u, 0u};
      for (long it = gt; it < 1024 + 512; it += NT) { const bool isA = it < 1024; const int q = isA ? (int)it : (int)it - 1024; const int nf = isA ? 16 : 8; const int pos = q / nf, i = q % nf;
          const float inv = exp2f(-((float)i / (float)nf) * 13.287712379549449f); const float ang = (float)pos * inv;
          double rev = (double)ang * 0.15915494309189535; rev -= __builtin_rint(rev);
          const float cv = __builtin_amdgcn_cosf((float)rev), sv = __builtin_amdgcn_sinf((float)rev);
          float* tab = WSP(float, WS_TAB); if (isA) { tab[q] = cv; tab[1024 + q] = sv; } else { tab[2048 + q] = cv; tab[2560 + q] = sv; } }
    }
    for (int l = 0; l < 2; ++l) {
        if (QKV8 & (1 << l)) cvt_matrix8<false>(F.in[7] + (size_t)l * D * 1536, D, 1536, WSP(unsigned char, l ? WS_WQKV1 : WS_WQKV0), W8_GU, 1, gw, NGW, lane);
        else cvt_matrix<false>(F.in[7] + (size_t)l * D * 1536, D, 1536, WSP(bf16_t, l ? WS_WQKV1 : WS_WQKV0), gw, NGW, lane);
        cvt_matrix<false>(F.in[10] + (size_t)l * D * D, D, D, WSP(bf16_t, l ? WS_WOA1 : WS_WOA0), gw, NGW, lane);
        if (GU8 & (1 << l)) cvt_matrix8<true>(F.in[18] + (size_t)l * D * 2 * FFD, D, 2 * FFD, WSP(unsigned char, l ? WS_WDGU1 : WS_WDGU0), W8_GU, 1, gw, NGW, lane);
        else cvt_matrix<true>(F.in[18] + (size_t)l * D * 2 * FFD, D, 2 * FFD, WSP(bf16_t, l ? WS_WDGU1 : WS_WDGU0), gw, NGW, lane);
        if (DOWN8 & (1 << l)) cvt_matrix8<false>(F.in[19] + (size_t)l * FFD * D, FFD, D, WSP(unsigned char, l ? WS_WDD1 : WS_WDD0), W8_D, 1, gw, NGW, lane);
        else cvt_matrix<false>(F.in[19] + (size_t)l * FFD * D, FFD, D, WSP(bf16_t, l ? WS_WDD1 : WS_WDD0), gw, NGW, lane);
        cvt_matrix8<true>(F.in[21] + (size_t)(l * NEXP) * D * 2 * FFE, D, 2 * FFE, WSP(unsigned char, l ? WS_WEGU1 : WS_WEGU0), W8_GU, NEXP, gw, NGW, lane);
        cvt_matrix8<false>(F.in[22] + (size_t)(l * NEXP) * FFE * D, FFE, D, WSP(unsigned char, l ? WS_WED1 : WS_WED0), W8_D, NEXP, gw, NGW, lane);
    }
    cvt_matrix<false>(F.in[12], D, 672, WSP(bf16_t, WS_WMD), gw, NGW, lane);
    cvt_matrix<false>(F.in[15], 384, 1536, WSP(bf16_t, WS_WUQ), gw, NGW, lane);
    cvt_matrix<false>(F.in[16], 256, 2048, WSP(bf16_t, WS_WUKV), gw, NGW, lane);
    cvt_matrix<false>(F.in[17], D, D, WSP(bf16_t, WS_WMO), gw, NGW, lane);
}

__device__ __forceinline__ void g_plain_cs(Frame& F, const bf16_t* A, int lda, const bf16_t* Bt, int ldb, bf16_t* C, int ldc, int N, int K, int nsl) {
    pg8::Sched S; S.init_plain(A, lda, Bt, ldb, C, ldc, NTOK, N, F.G, F.bx); S.cs_nsl = nsl; S.cs_P = WSP(bf16_t, WS_CSP);
    pg8::EpiPlain E{ldc, 1.0f};
    pg8::gemm_phase<pg8::EpiPlain, false>(F.lds, K, lda, ldb, S, E);
}
__device__ __forceinline__ Row ctx_partial_row(Frame& F, int b, int j, int nsl, int lane) {
    Row y = ld_row_bf16(WSP(bf16_t, WS_CSP) + (size_t)(b * 256 + j) * D, lane);
    for (int sl = 1; sl < nsl; ++sl) { const Row z = ld_row_bf16(WSP(bf16_t, WS_CSP) + ((size_t)(sl * 8 + b) * 256 + j) * D, lane);
#pragma unroll
        for (int jj = 0; jj < 4; ++jj) y.v[jj] = y.v[jj] + z.v[jj]; }
    return y;
}
__device__ __forceinline__ void st_row_fp8(unsigned* hp, int lane, const Row& h) {
#pragma unroll
    for (int jj = 0; jj < 4; ++jj) hp[lane + 64 * jj] = pk_fp8x4(h.v[jj][0], h.v[jj][1], h.v[jj][2], h.v[jj][3]); }
__device__ __forceinline__ void p_r0(Frame& F) {
    const int gw = F.vcu * NWAVES + F.wave, NGW = F.G * NWAVES, lane = F.lane;
    for (int t = gw; t < NTOK; t += NGW) {
        const int b = t / TPB, j = t % TPB; const bool isc = j < CTXL;
        const float* src = isc ? F.in[2] + (size_t)(b * CTXL + j) * D : F.in[0] + (size_t)(b * SEQ + (j - CTXL)) * D;
        const Row x = ld_row_f32_nt(src, lane);
        const int mr = isc ? 8 : b;
        const Row h = modnorm(x, normg(F, 0, 0), modp(F, 0, mr, 0), modp(F, 0, mr, 1), lane);
        if (QKV8 & 1) st_row_fp8(WSP(unsigned, WS_H) + (size_t)t * (D / 4), lane, h); else st_row_bf16(WSP(bf16_t, WS_H) + (size_t)t * D, lane, h);
    }
}

template <bool MOE, bool H8 = false>
__device__ __forceinline__ void p_rmid(Frame& F, int layer, bool lat_only, const float* w_router, int moe_idx, int csn = 0) {
    const int lane = F.lane;
    const int nact = lat_only ? NLAT : NTOK; const int per = (nact + F.G - 1) / F.G;
    const int nrows = (nact - F.bx + F.G - 1) / F.G < per ? (nact - F.bx + F.G - 1) / F.G : per;
    LAS float* wrT = (LAS float*)F.lds;
    LAS int* cntL = (LAS int*)(F.lds + 32768); LAS int* baseL = cntL + 8;
    LAS unsigned* rowE = (LAS unsigned*)(F.lds + 32768 + 64); LAS unsigned* rowS = rowE + 1024; LAS float* rowW = (LAS float*)(rowS + 1024);
    if (MOE) {
        for (int i = F.tid; i < 8 * D; i += 512) { const int c = i >> 3, e = i & 7; wrT[e * D + c] = w_router[i]; }
        if (F.tid < 8) cntL[F.tid] = 0;
        __syncthreads();
    }
    for (int rr = F.wave; rr < nrows; rr += NWAVES) {
        const int a = rr * F.G + F.bx; const int t = lat_only ? (a / SEQ) * TPB + CTXL + (a % SEQ) : a;
        const int b = t / TPB, j = t % TPB; const int mr = (j < CTXL) ? 8 : b;
        bf16_t* xp = WSP(bf16_t, WS_X) + (size_t)t * D;
        const Row y = (csn > 0 && j < CTXL) ? ctx_partial_row(F, b, j, csn, lane) : ld_row_bf16(WSP(bf16_t, WS_Y) + (size_t)t * D, lane);
        const Row x0 = layer == 0 ? ld_row_f32_nt(j < CTXL ? F.in[2] + (size_t)(b * CTXL + j) * D : F.in[0] + (size_t)(b * SEQ + (j - CTXL)) * D, lane) : ld_row_bf16(xp, lane);
        Row x = resid(x0, y, normg(F, layer, 1), modp(F, layer, mr, 2), lane);
        if ((DBG_SKIP >> (2 * layer)) & 1) x = x0;
        st_row_bf16(xp, lane, x);
        const Row h = modnorm(x, normg(F, layer, 2), modp(F, layer, mr, 3), modp(F, layer, mr, 4), lane);
        if (H8) { unsigned* hp = WSP(unsigned, WS_H) + (size_t)t * (D / 4) + lane;
#pragma unroll
            for (int jj = 0; jj < 4; ++jj) hp[64 * jj] = pk_fp8x4(h.v[jj][0], h.v[jj][1], h.v[jj][2], h.v[jj][3]); }
        else st_row_bf16(WSP(bf16_t, WS_H) + (size_t)t * D, lane, h);
        if (MOE) {
            float lg[8];
#pragma unroll
            for (int e = 0; e < 8; ++e) { float s = 0.f;
#pragma unroll
                for (int jj = 0; jj < 4; ++jj) { const f32x4 w = *(const LAS f32x4*)(wrT + e * D + 4 * lane + 256 * jj); s += (h.v[jj][0] * w[0] + h.v[jj][1] * w[1]) + (h.v[jj][2] * w[2] + h.v[jj][3] * w[3]); }
                lg[e] = wave_sum(s); }
            int e1 = 0; float v1 = lg[0];
#pragma unroll
            for (int e = 1; e < 8; ++e) if (lg[e] > v1) { v1 = lg[e]; e1 = e; }
            int e2 = -1; float v2 = -3.0e38f;
#pragma unroll
            for (int e = 0; e < 8; ++e) if (e != e1 && (e2 < 0 || lg[e] > v2)) { v2 = lg[e]; e2 = e; }
            const float ex = __expf(v2 - v1); const float w1 = 1.0f / (1.0f + ex);
#if DBG_CHECK
            if (lane < 8) { float vv = lg[0];
#pragma unroll
                for (int e = 1; e < 8; ++e) vv = (lane == e) ? lg[e] : vv;
                ((float*)(F.ws + 1300 * MiB))[(size_t)t * 8 + lane] = vv; }
#endif
            if (lane == 0) { const int s1 = __hip_atomic_fetch_add(cntL + e1, 1, __ATOMIC_RELAXED, __HIP_MEMORY_SCOPE_WORKGROUP), s2 = __hip_atomic_fetch_add(cntL + e2, 1, __ATOMIC_RELAXED, __HIP_MEMORY_SCOPE_WORKGROUP);
                rowE[rr] = (unsigned)e1 | ((unsigned)e2 << 8); rowS[rr] = (unsigned)s1 | ((unsigned)s2 << 16); rowW[rr] = w1; }
        }
    }
    if (MOE) {
        __syncthreads();
        unsigned* cntg = F.ctl + CW_MOE + moe_idx * 8 * 64;
        if (F.tid < 8) baseL[F.tid] = (int)__hip_atomic_fetch_add(cntg + F.tid * 64, (unsigned)cntL[F.tid], RLX_AGENT);
        __syncthreads();
        int* list = WSP(int, WS_LIST); u32x4* tinfo = WSP(u32x4, WS_TOKINFO);
        for (int rr = F.tid; rr < nrows; rr += 512) {
            const int a = rr * F.G + F.bx; const int t = lat_only ? (a / SEQ) * TPB + CTXL + (a % SEQ) : a;
            const unsigned E = rowE[rr], Sx = rowS[rr]; const int e1 = E & 255, e2 = E >> 8; const int g1 = baseL[e1] + (int)(Sx & 0xffff), g2 = baseL[e2] + (int)(Sx >> 16);
            list[(size_t)e1 * LIST_CAP + g1] = t; list[(size_t)e2 * LIST_CAP + g2] = t;
            tinfo[t] = (u32x4){E, (unsigned)g1, (unsigned)g2, __builtin_bit_cast(unsigned, rowW[rr])};
        }
        __syncthreads();
    }
}

struct MoeTiles { int cnt[8]; int tend[8]; };
__device__ __forceinline__ MoeTiles moe_tiles(Frame& F, int moe_idx) {
    MoeTiles m; unsigned* cntg = F.ctl + CW_MOE + moe_idx * 8 * 64; int acc = 0;
#pragma unroll
    for (int e = 0; e < 8; ++e) { const int c = (int)__builtin_amdgcn_readfirstlane(__hip_atomic_load(cntg + e * 64, RLX_AGENT)); m.cnt[e] = c; acc += (c + 255) >> 8; m.tend[e] = acc; }
    return m;
}

constexpr bool MOE8_SPLIT = true;
struct MoeSplit { int full, nsl; };
__device__ __forceinline__ MoeSplit moe_split(int nMt, int G) {
    MoeSplit r; const int tot = nMt * 4; r.full = (tot / G) * G; const int R = tot - r.full;
    int nsl = (R > 0) ? G / R : 1; nsl = nsl > 4 ? 4 : nsl;
    if (nsl < 2 || (r.full & 31) != 0 || r.full == 0 || R > 128) nsl = 1;
    r.nsl = nsl; return r;
}

template <bool MOE>
__device__ __forceinline__ void p_rend(Frame& F, int layer, bool last, int moe_idx, int csn = 0) {
    const int gw = F.vcu * NWAVES + F.wave, NGW = F.G * NWAVES, lane = F.lane;
    const int nact = last ? NLAT : NTOK;
    int ts[8]; int ms_pm0 = 1 << 30, ms_nsl = 1;
    if (MOE) { const MoeTiles m = moe_tiles(F, moe_idx); ts[0] = 0;
#pragma unroll
        for (int e = 1; e < 8; ++e) ts[e] = m.tend[e - 1];
        if (MOE8_SPLIT && moe_idx == 1) { const MoeSplit ms = moe_split(m.tend[7], F.G); ms_nsl = ms.nsl; if (ms.nsl > 1) ms_pm0 = ms.full / 4; } }
    for (int a = gw; a < nact; a += NGW) {
        const int t = last ? (a / SEQ) * TPB + CTXL + (a % SEQ) : a;
        const int b = t / TPB, j = t % TPB; const int mr = (j < CTXL) ? 8 : b;
        bf16_t* xp = WSP(bf16_t, WS_X) + (size_t)t * D;
        Row y;
        if (MOE) {
            const u32x4 ti = WSP(const u32x4, WS_TOKINFO)[t]; const int e1 = ti.x & 255, e2 = ti.x >> 8; int t1 = 0, t2 = 0;
#pragma unroll
            for (int e = 1; e < 8; ++e) { if (e1 == e) t1 = ts[e]; if (e2 == e) t2 = ts[e]; }
            const unsigned w1b = ti.w; const float w1 = u2f(w1b), w2 = 1.0f - w1;
            const size_t ra = (size_t)t1 * 256 + ti.y, rb = (size_t)t2 * 256 + ti.z;
            Row ya = ld_row_bf16(WSP(bf16_t, WS_Y2) + ra * D, lane), yb = ld_row_bf16(WSP(bf16_t, WS_Y2) + rb * D, lane);
            if ((int)(ra >> 8) >= ms_pm0) { for (int sl = 1; sl < ms_nsl; ++sl) { const Row z = ld_row_bf16(WSP(bf16_t, WS_MSP) + ((size_t)((sl - 1) * 32 * 256) + (ra - (size_t)ms_pm0 * 256)) * D, lane);
#pragma unroll
                for (int jj = 0; jj < 4; ++jj) ya.v[jj] = ya.v[jj] + z.v[jj]; } }
            if ((int)(rb >> 8) >= ms_pm0) { for (int sl = 1; sl < ms_nsl; ++sl) { const Row z = ld_row_bf16(WSP(bf16_t, WS_MSP) + ((size_t)((sl - 1) * 32 * 256) + (rb - (size_t)ms_pm0 * 256)) * D, lane);
#pragma unroll
                for (int jj = 0; jj < 4; ++jj) yb.v[jj] = yb.v[jj] + z.v[jj]; } }
#pragma unroll
            for (int jj = 0; jj < 4; ++jj) y.v[jj] = ya.v[jj] * w1 + yb.v[jj] * w2;
        } else y = (csn > 0 && j < CTXL) ? ctx_partial_row(F, b, j, csn, lane) : ld_row_bf16(WSP(bf16_t, WS_Y2) + (size_t)t * D, lane);
        const Row x0 = ld_row_bf16(xp, lane);
        Row x = resid(x0, y, normg(F, layer, 3), modp(F, layer, mr, 5), lane);
        if ((DBG_SKIP >> (2 * layer + 1)) & 1) x = x0;
        if (last) { st_row_f32(F.out + ((size_t)b * SEQ + (j - CTXL)) * D, lane, x); }
        else {
            st_row_bf16(xp, lane, x);
            const Row h = modnorm(x, normg(F, layer + 1, 0), modp(F, layer + 1, mr, 0), modp(F, layer + 1, mr, 1), lane);
            if ((QKV8 & 2) && layer == 2) st_row_fp8(WSP(unsigned, WS_H) + (size_t)t * (D / 4), lane, h);
            else st_row_bf16(WSP(bf16_t, WS_H) + (size_t)t * D, lane, h);
        }
    }
}

__device__ __forceinline__ void transpose_64x256(Frame& F, const bf16_t* src, size_t sp, int hs, bf16_t* dst, size_t dp) {
    LAS bf16_t* tl = (LAS bf16_t*)F.lds;
#pragma unroll
    for (int q = 0; q < 4; ++q) { const int cid = F.tid + 512 * q; const int tok = cid >> 5, ch = cid & 31; const int scol = (ch >> 3) * hs + (ch & 7) * 8;
        *(LAS u32x4*)(tl + tok * 264 + ch * 8) = *(const u32x4*)(src + (size_t)tok * sp + scol); }
    __syncthreads();
#pragma unroll
    for (int q = 0; q < 4; ++q) { const int item = F.tid + 512 * q; const int dcol = item & 255, c8 = item >> 8; unsigned v[8];
#pragma unroll
        for (int jj = 0; jj < 8; ++jj) v[jj] = tl[(c8 * 8 + jj) * 264 + dcol];
        u32x4 w; w.x = v[0] | (v[1] << 16); w.y = v[2] | (v[3] << 16); w.z = v[4] | (v[5] << 16); w.w = v[6] | (v[7] << 16);
        *(u32x4*)(dst + (size_t)dcol * dp + c8 * 8) = w; }
    __syncthreads();
}

__device__ __forceinline__ void transpose_64x256_v8(Frame& F, const bf16_t* src, size_t sp, int hs, unsigned char* dst, size_t dp) {
    LAS bf16_t* tl = (LAS bf16_t*)F.lds;
#pragma unroll
    for (int q = 0; q < 4; ++q) { const int cid = F.tid + 512 * q; const int tok = cid >> 5, ch = cid & 31; const int scol = (ch >> 3) * hs + (ch & 7) * 8;
        *(LAS u32x4*)(tl + tok * 264 + ch * 8) = *(const u32x4*)(src + (size_t)tok * sp + scol); }
    __syncthreads();
#pragma unroll
    for (int q = 0; q < 4; ++q) { const int item = F.tid + 512 * q; const int dcol = item & 255, gk = item >> 8; float v[8];
#pragma unroll
        for (int jj = 0; jj < 8; ++jj) v[jj] = bf2f((unsigned)tl[(gk * 8 + jj) * 264 + dcol]);
        u32x2 w; w.x = pk_fp8x4(v[0], v[1], v[2], v[3]); w.y = pk_fp8x4(v[4], v[5], v[6], v[7]);
        *(u32x2*)(dst + (size_t)dcol * dp + (4 * (gk & 1) + (gk >> 1)) * 8) = w; }
    __syncthreads();
}
__device__ __forceinline__ void p_qkn(Frame& F, int j_a) {
    const int lane = F.lane, a = lane & 7; const float* tab = WSP(const float, WS_TAB);
    const bf16_t* raw = WSP(const bf16_t, WS_A_RAW); bf16_t* Q = WSP(bf16_t, WS_A_Q); bf16_t* Kd = WSP(bf16_t, WS_A_K); bf16_t* Vt = WSP(bf16_t, WS_A_VT);
    float gq[8], gk[8];
#pragma unroll
    for (int i = 0; i < 8; ++i) { gq[i] = F.in[8][j_a * 64 + a * 8 + i]; gk[i] = F.in[9][j_a * 64 + a * 8 + i]; }
    const float C2 = 0.125f * LOG2E; const bool second = (a & 2) != 0;
    for (int u = F.vcu; u < NBATCH * 68; u += F.G) {
        const int b = u / 68, c = u % 68;
        for (int tt = F.wave; tt < 64; tt += NWAVES) {
            const int j = c * 64 + tt, t = b * TPB + j; const bool lat = j >= CTXL; const int sp = j - CTXL;
            float cs[8], sn[8];
            if (lat) { const int pp = (a < 4) ? (sp >> 6) : (sp & 63); const float* tc = tab + pp * 16 + 8 * (a & 1);
                const f32x4 c0 = *(const f32x4*)tc, c1 = *(const f32x4*)(tc + 4), s0 = *(const f32x4*)(tc + 1024), s1 = *(const f32x4*)(tc + 1028);
#pragma unroll
                for (int i = 0; i < 4; ++i) { cs[i] = c0[i]; cs[4 + i] = c1[i]; sn[i] = s0[i]; sn[4 + i] = s1[i]; } }
            else {
#pragma unroll
                for (int i = 0; i < 8; ++i) { cs[i] = 1.f; sn[i] = 0.f; } }
            const bf16_t* rp = raw + (size_t)t * 1536;
#pragma unroll
            for (int pass = 2; pass < 3; ++pass) {
                const bool act = (pass < 2) || (lane < 32); const int chunk = pass * 64 + lane;
                u32x4 w = (u32x4){0u, 0u, 0u, 0u}; if (act) w = *(const u32x4*)(rp + chunk * 8);
                float x[8]; unpack8(w, x); float ss = 0.f;
#pragma unroll
                for (int i = 0; i < 8; ++i) ss += x[i] * x[i];
                ss += __shfl_xor(ss, 1); ss += __shfl_xor(ss, 2); ss += __shfl_xor(ss, 4);
                const float rs = 1.0f / sqrtf(ss * (1.0f / 64.0f) + NORM_EPS);
                float o[8];
#pragma unroll
                for (int i = 0; i < 8; ++i) { const float xn = x[i] * rs * (pass < 2 ? gq[i] : gk[i]); const float pr = __shfl_xor(xn, 2);
                    o[i] = second ? (xn * cs[i] + pr * sn[i]) : (xn * cs[i] - pr * sn[i]); if (pass < 2) o[i] *= C2; }
                if (pass < 2) *(u32x4*)(Q + (size_t)t * D + chunk * 8) = pack8(o);
                else if (act) {
                    if constexpr (ATT_QK8) { u32x2 w8; w8.x = pk_fp8x4(o[0], o[1], o[2], o[3]); w8.y = pk_fp8x4(o[4], o[5], o[6], o[7]);
                        *(u32x2*)((unsigned char*)Kd + (size_t)t * 256 + (lane >> 3) * 64 + (a & 1) * 32 + (a >> 1) * 8) = w8; }
                    else *(u32x4*)(Kd + (size_t)t * 256 + (chunk - 128) * 8) = pack8(o); }
            }
        }
        if constexpr (ATT_QK8 && ATT_PV8) transpose_64x256_v8(F, raw + (size_t)(b * TPB + c * 64) * 1536 + 1280, 1536, 64, (unsigned char*)Vt + (size_t)(b * 256) * TPB + c * 64, TPB);
        else transpose_64x256(F, raw + (size_t)(b * TPB + c * 64) * 1536 + 1280, 1536, 64, Vt + (size_t)(b * 256) * TPB + c * 64, TPB);
    }
}

__device__ __forceinline__ void p_mla1(Frame& F) {
    const int gw = F.vcu * NWAVES + F.wave, NGW = F.G * NWAVES, lane = F.lane; const float* tab = WSP(const float, WS_TAB);
    const bf16_t* Dm = WSP(const bf16_t, WS_M_DM); bf16_t* CQ = WSP(bf16_t, WS_M_CQ); bf16_t* CKV = WSP(bf16_t, WS_M_CKV); bf16_t* KR = WSP(bf16_t, WS_M_KR);
    float gq[8], gk[8];
#pragma unroll
    for (int i = 0; i < 8; ++i) { gq[i] = lane < 48 ? F.in[13][lane * 8 + i] : 0.f; gk[i] = lane < 32 ? F.in[14][lane * 8 + i] : 0.f; }
    const int rc = lane & 3; const bool second = (rc & 1) != 0;
    for (int t = gw; t < NTOK; t += NGW) {
        const int j = t % TPB; const bool lat = j >= CTXL; const int sp = j - CTXL;
        const bf16_t* dp = Dm + (size_t)t * 768;
        u32x4 w1 = (u32x4){0u, 0u, 0u, 0u}, w2 = (u32x4){0u, 0u, 0u, 0u};
        if (lane < 48) w1 = *(const u32x4*)(dp + lane * 8);
        if (lane < 36) w2 = *(const u32x4*)(dp + 384 + lane * 8);
        float x[8], y[8]; unpack8(w1, x); unpack8(w2, y); float s1 = 0.f, s2 = 0.f;
#pragma unroll
        for (int i = 0; i < 8; ++i) { s1 += x[i] * x[i]; s2 += y[i] * y[i]; }
        if (lane >= 32) s2 = 0.f;
        const float rq = 1.0f / sqrtf(wave_sum(s1) * (1.0f / 384.0f) + NORM_EPS), rk = 1.0f / sqrtf(wave_sum(s2) * (1.0f / 256.0f) + NORM_EPS);
        float o[8];
#pragma unroll
        for (int i = 0; i < 8; ++i) o[i] = x[i] * rq * gq[i];
        if (lane < 48) *(u32x4*)(CQ + (size_t)t * 384 + lane * 8) = pack8(o);
        float cs[8], sn[8];
        if (lat) { const int pp = (rc < 2) ? (sp >> 6) : (sp & 63); const float* tc = tab + 2048 + pp * 8;
            const f32x4 c0 = *(const f32x4*)tc, c1 = *(const f32x4*)(tc + 4), s0 = *(const f32x4*)(tc + 512), s1v = *(const f32x4*)(tc + 516);
#pragma unroll
            for (int i = 0; i < 4; ++i) { cs[i] = c0[i]; cs[4 + i] = c1[i]; sn[i] = s0[i]; sn[4 + i] = s1v[i]; } }
        else {
#pragma unroll
            for (int i = 0; i < 8; ++i) { cs[i] = 1.f; sn[i] = 0.f; } }
        float k[8];
#pragma unroll
        for (int i = 0; i < 8; ++i) { const float pr = __shfl_xor(y[i], 1); k[i] = second ? (y[i] * cs[i] + pr * sn[i]) : (y[i] * cs[i] - pr * sn[i]); o[i] = y[i] * rk * gk[i]; }
        if (lane < 32) *(u32x4*)(CKV + (size_t)t * 256 + lane * 8) = pack8(o);
        else if (lane < 36) *(u32x4*)(KR + (size_t)t * 32 + (lane - 32) * 8) = pack8(k);
    }
}
__device__ __forceinline__ void p_mla2(Frame& F) {
    const int lane = F.lane; const float* tab = WSP(const float, WS_TAB);
    bf16_t* Qm = WSP(bf16_t, WS_M_Q); bf16_t* KV = WSP(bf16_t, WS_M_KV); const bf16_t* KR = WSP(const bf16_t, WS_M_KR); bf16_t* Vt = WSP(bf16_t, WS_M_VT);
    const float C2 = 0.10206207261596577f * LOG2E;
    for (int u = F.vcu; u < NBATCH * 68; u += F.G) {
        const int b = u / 68, c = u % 68;
        for (int hg = 0; hg < 4; ++hg) {
            if constexpr (ATT_QK8 && MLA_QK8 && ATT_PV8) transpose_64x256_v8(F, KV + (size_t)(b * TPB + c * 64) * 2048 + hg * 512 + 64, 2048, 128, (unsigned char*)Vt + (size_t)(b * 1024 + hg * 256) * TPB + c * 64, TPB);
            else transpose_64x256(F, KV + (size_t)(b * TPB + c * 64) * 2048 + hg * 512 + 64, 2048, 128, Vt + (size_t)(b * 1024 + hg * 256) * TPB + c * 64, TPB);
            if constexpr (MLA_QK8 && ATT_QK8) {
              const int tok = F.tid >> 3, rem = F.tid & 7, hh = hg * 4 + (rem >> 1), part = rem & 1; const int t = b * TPB + c * 64 + tok;
              const bf16_t* kn = KV + (size_t)t * 2048 + hh * 128 + 8 * part; const bf16_t* kr = KR + (size_t)t * 32 + 8 * part;
              unsigned char* k8 = WSP(unsigned char, WS_M_K8) + (size_t)t * 1536 + hh * 96;
              u32x4 wn0, wn1, wr;
              { float a[8], bb[8]; unpack8(*(const u32x4*)(kn), a); unpack8(*(const u32x4*)(kn + 16), bb);
                wn0.x = pk_fp8x4(a[0], a[1], a[2], a[3]); wn0.y = pk_fp8x4(a[4], a[5], a[6], a[7]); wn0.z = pk_fp8x4(bb[0], bb[1], bb[2], bb[3]); wn0.w = pk_fp8x4(bb[4], bb[5], bb[6], bb[7]); }
              { float a[8], bb[8]; unpack8(*(const u32x4*)(kn + 32), a); unpack8(*(const u32x4*)(kn + 48), bb);
                wn1.x = pk_fp8x4(a[0], a[1], a[2], a[3]); wn1.y = pk_fp8x4(a[4], a[5], a[6], a[7]); wn1.z = pk_fp8x4(bb[0], bb[1], bb[2], bb[3]); wn1.w = pk_fp8x4(bb[4], bb[5], bb[6], bb[7]); }
              { float a[8], bb[8]; unpack8(*(const u32x4*)(kr), a); unpack8(*(const u32x4*)(kr + 16), bb);
                wr.x = pk_fp8x4(a[0], a[1], a[2], a[3]); wr.y = pk_fp8x4(a[4], a[5], a[6], a[7]); wr.z = pk_fp8x4(bb[0], bb[1], bb[2], bb[3]); wr.w = pk_fp8x4(bb[4], bb[5], bb[6], bb[7]); }
              *(u32x4*)(k8 + part * 32) = wn0; *(u32x4*)(k8 + part * 32 + 16) = wn1; *(u32x4*)(k8 + 64 + part * 16) = wr;
            } else
            { const int tok = F.tid >> 3, rem = F.tid & 7, hh = hg * 4 + (rem >> 1), part = rem & 1; const int t = b * TPB + c * 64 + tok;
              *(u32x4*)(KV + (size_t)t * 2048 + hh * 128 + 64 + part * 16) = *(const u32x4*)(KR + (size_t)t * 32 + part * 16);
              *(u32x4*)(KV + (size_t)t * 2048 + hh * 128 + 64 + part * 16 + 8) = *(const u32x4*)(KR + (size_t)t * 32 + part * 16 + 8); }
        }
    }
}
__device__ __forceinline__ void p_htrans(Frame& F) {
    for (int u = F.vcu; u < NBATCH * 68 * 4; u += F.G) {
        const int cb = u & 3, c = (u >> 2) % 68, b = (u >> 2) / 68;
        transpose_64x256(F, WSP(const bf16_t, WS_H) + (size_t)(b * TPB + c * 64) * D + cb * 256, D, 64, WSP(bf16_t, WS_F_HT) + (size_t)(b * D + cb * 256) * TPB + c * 64, TPB);
    }
}

__device__ __forceinline__ void p_htrans2(Frame& F) {
    for (int u = F.vcu; u < NBATCH * 68 * 4; u += F.G) {
        const int cb = u & 3, x = (u >> 2) % 68, b = (u >> 2) / 68;
        const bf16_t* src = WSP(const bf16_t, WS_H) + (size_t)(b * TPB + (x < 4 ? 64 * x : CTXL + (x - 4))) * D + cb * 256;
        transpose_64x256(F, src, x < 4 ? (size_t)D : (size_t)64 * D, 64, WSP(bf16_t, WS_F_HT) + (size_t)(b * D + cb * 256) * TPB + x * 64, TPB);
    }
}
__device__ __forceinline__ void p_fft_relayout(Frame& F) {
    const int gw = F.vcu * NWAVES + F.wave, NGW = F.G * NWAVES, lane = F.lane;
    LAS unsigned char* lw = F.lds + F.wave * 8704;
    const LAS unsigned short* l16 = (const LAS unsigned short*)lw;
    for (int row = gw; row < NBATCH * D; row += NGW) {
        const bf16_t* g1 = WSP(const bf16_t, WS_F_G1) + (size_t)row * 8192; bf16_t* g2 = WSP(bf16_t, WS_F_G2) + (size_t)row * 8192;
        for (int half = 0; half < 2; ++half) {
#pragma unroll
            for (int q = 0; q < 8; ++q) { const int piece = q * 64 + lane, cl = piece >> 4, o16 = piece & 15;
                *(LAS u32x4*)(lw + cl * 272 + o16 * 16) = *(const u32x4*)(g1 + (size_t)(32 * half + cl) * 128 + o16 * 8); }
            LDS_WAIT(); asm volatile("" ::: "memory");
#pragma unroll 2
            for (int it = 0; it < 8; ++it) { const int id = it * 64 + lane, c8 = id & 3, ri = (id >> 2) & 1, kl = id >> 3; float o[8];
#pragma unroll
                for (int j = 0; j < 8; ++j) { const int cl = 8 * c8 + j, c = 32 * half + cl; const float gr = bf2f(l16[cl * 136 + kl]), gi = bf2f(l16[cl * 136 + 64 + kl]);
                    const float ph = (float)((kl * c) & 4095) * (1.0f / 4096.0f); const float cs = __builtin_amdgcn_cosf(ph), sn = __builtin_amdgcn_sinf(ph);
                    o[j] = ri ? (gi * cs - gr * sn) : (gr * cs + gi * sn); }
                *(u32x4*)(g2 + kl * 128 + ri * 64 + 32 * half + 8 * c8) = pack8(o); }
            LDS_WAIT(); asm volatile("" ::: "memory");
        }
    }
}

template <int DK, int NQ, bool NOREF>
__device__ __forceinline__ unsigned p_attn_impl(Frame& F, const bf16_t* Q, int qpitch, int qhs, const bf16_t* K, int kpitch, int khs, int gsz, const bf16_t* Vt, bf16_t* O, bool ctxq, const float* qgain = nullptr, bool qfuse = false, unsigned only = 0xffffffffu) {
    constexpr int VTP = (ATT_QK8 && ATT_PV8 && (DK == 64 || MLA_QK8)) ? TPB / 2 : TPB;
    const int nkv = 16 / gsz; constexpr int UR = 256 * NQ, UPH = SEQ / UR, NU = NBATCH * 16 * UPH;
    unsigned fail = 0u, bit = 1u;
    if (ctxq) { for (int cu = F.vcu; cu < 256; cu += F.G) if ((cu & 1) == 0) { const int bh = cu >> 1, b = bh >> 4, hh = bh & 15, kvh = hh / gsz;
        if (only & bit) if (!att::unit<DK, NQ, NOREF>(F.lds, Q + (size_t)(b * TPB) * qpitch + hh * qhs, qpitch, K + (size_t)(b * TPB) * kpitch + kvh * khs, kpitch, Vt + (size_t)((b * nkv + kvh) * 64) * VTP, VTP,
                      O + (size_t)(b * TPB) * D + hh * 64, D, CTXL / 64, CTXL, qgain, qfuse ? WSP(const float, WS_TAB) : nullptr, -1)) fail |= bit;
        bit <<= 1; } }
    const int per = (NU + F.G - 1) / F.G;
    for (int i = 0; i < per; ++i) { const int uid = F.vcu * per + i; if (uid >= NU) break;
        const int qb = uid % UPH, hh = (uid / UPH) & 15, b = uid / (UPH * 16), kvh = hh / gsz; const size_t row0 = (size_t)b * TPB + CTXL + qb * UR;
        if (only & bit) if (!att::unit<DK, NQ, NOREF>(F.lds, Q + row0 * qpitch + hh * qhs, qpitch, K + (size_t)(b * TPB) * kpitch + kvh * khs, kpitch, Vt + (size_t)((b * nkv + kvh) * 64) * VTP, VTP,
                      O + row0 * D + hh * 64, D, TPB / 64, UR, qgain, qfuse ? WSP(const float, WS_TAB) : nullptr, qb * UR)) fail |= bit;
        bit <<= 1; }
    return fail;
}

template <int DK, int NQ>
__device__ __forceinline__ void p_attn(Frame& F, const bf16_t* Q, int qpitch, int qhs, const bf16_t* K, int kpitch, int khs, int gsz, const bf16_t* Vt, bf16_t* O, bool ctxq, const float* gq = nullptr, const float* gk = nullptr, bool qfuse = false) {
    bool noref = false;
    if (gq != nullptr) { float a = fabsf(gq[F.lane]), b = fabsf(gk[F.lane]);
#pragma unroll
        for (int o = 1; o < 64; o <<= 1) { a = fmaxf(a, __shfl_xor(a, o)); b = fmaxf(b, __shfl_xor(b, o)); }
        noref = (a * b <= ((ATT_QK8 && ATT_PV8) ? 1.4f : 5.0f)); }
    if constexpr (DK == 64) { if (noref) { p_attn_impl<DK, NQ, true>(F, Q, qpitch, qhs, K, kpitch, khs, gsz, Vt, O, ctxq, gq, true); return; } }
    if constexpr (DK == 96 && MLA_SPEC) {
        const unsigned fm = p_attn_impl<DK, NQ, true>(F, Q, qpitch, qhs, K, kpitch, khs, gsz, Vt, O, ctxq, nullptr, qfuse);
        if (fm) p_attn_impl<DK, NQ, false>(F, Q, qpitch, qhs, K, kpitch, khs, gsz, Vt, O, ctxq, nullptr, qfuse, fm);
        return; }
    p_attn_impl<DK, NQ, false>(F, Q, qpitch, qhs, K, kpitch, khs, gsz, Vt, O, ctxq, DK == 64 ? gq : nullptr, (DK == 64 && gq != nullptr) || qfuse);
}

__device__ __forceinline__ void g_plain(Frame& F, const bf16_t* A, int lda, const bf16_t* Bt, int ldb, bf16_t* C, int ldc, int M, int N, int K, float scale) {
    pg8::Sched S; S.init_plain(A, lda, Bt, ldb, C, ldc, M, N, F.G, F.bx);
    pg8::EpiPlain E{ldc, scale};
    pg8::gemm_phase<pg8::EpiPlain, false>(F.lds, K, lda, ldb, S, E);
}
__device__ __forceinline__ void g_swiglu(Frame& F, const bf16_t* A, const bf16_t* Bt, bf16_t* Act, int M, int FF) {
    pg8::Sched S; S.init_plain(A, D, Bt, D, Act, FF, M, 2 * FF, F.G, F.bx); S.cn = 128;
    pg8::EpiSwiGLU E{FF};
    pg8::gemm_phase<pg8::EpiSwiGLU, false>(F.lds, D, D, D, S, E);
}
__device__ __forceinline__ void g_swiglu_fp8(Frame& F, const unsigned char* Wgu8) {
    pg8::Sched S; S.init_plain(WSP(const bf16_t, WS_H), D / 2, (const bf16_t*)Wgu8, D / 2, WSP(bf16_t, WS_ACT), FFD, NTOK, 2 * FFD, F.G, F.bx);
    S.cm1 = (long)256 * (FFD / 2); S.cn = 64;
    pg8::EpiSwiGLU8 E{FFD, 1.0f / W8_GU, A8_ACT};
    pg8::gemm_phase<pg8::EpiSwiGLU8, false, true>(F.lds, D / 2, D / 2, D / 2, S, E);
}
__device__ __forceinline__ void g_swiglu_to8(Frame& F, const bf16_t* Bt) {
    pg8::Sched S; S.init_plain(WSP(const bf16_t, WS_H), D, Bt, D, WSP(bf16_t, WS_ACT), FFD, NTOK, 2 * FFD, F.G, F.bx);
    S.cm1 = (long)256 * (FFD / 2); S.cn = 64;
    pg8::EpiSwiGLU8 E{FFD, 1.0f, A8_ACT};
    pg8::gemm_phase<pg8::EpiSwiGLU8, false>(F.lds, D, D, D, S, E);
}
constexpr int DOWN8_CSN = 5;
__device__ __forceinline__ void g_down_fp8(Frame& F, const unsigned char* Wd8) {
    pg8::Sched S; S.init_plain(WSP(const bf16_t, WS_ACT), FFD / 2, (const bf16_t*)Wd8, FFD / 2, WSP(bf16_t, WS_Y2), D, NTOK, D, F.G, F.bx);
    S.cs_nsl = DOWN8_CSN; S.cs_ntl = 6; S.cs_P = WSP(bf16_t, WS_CSP);
    pg8::EpiPlain E{D, 1.0f / (W8_D * A8_ACT)};
    pg8::gemm_phase<pg8::EpiPlain, false, true>(F.lds, FFD / 2, FFD / 2, FFD / 2, S, E);
}
__device__ __forceinline__ void g_qkv_fp8(Frame& F, const unsigned char* W8) {
    pg8::Sched S; S.init_plain(WSP(const bf16_t, WS_H), D / 2, (const bf16_t*)W8, D / 2, WSP(bf16_t, WS_A_RAW), 1536, NTOK, 1536, F.G, F.bx);
    pg8::EpiPlain E{1536, 1.0f / W8_GU};
    pg8::gemm_phase<pg8::EpiPlain, false, true>(F.lds, D / 2, D / 2, D / 2, S, E);
}
__device__ __forceinline__ void set_moe(pg8::Sched& S, const MoeTiles& m, const int* list) {
    S.tend0 = m.tend[0]; S.tend1 = m.tend[1]; S.tend2 = m.tend[2]; S.tend3 = m.tend[3]; S.tend4 = m.tend[4]; S.tend5 = m.tend[5]; S.tend6 = m.tend[6]; S.tend7 = m.tend[7];
    S.cnt0 = m.cnt[0]; S.cnt1 = m.cnt[1]; S.cnt2 = m.cnt[2]; S.cnt3 = m.cnt[3]; S.cnt4 = m.cnt[4]; S.cnt5 = m.cnt[5]; S.cnt6 = m.cnt[6]; S.cnt7 = m.cnt[7];
    S.list = list; S.cap = LIST_CAP; S.moe = 1; S.nM = m.tend[7];
}
__device__ __forceinline__ void g_moe1(Frame& F, const bf16_t* Wgu, int moe_idx) {
    const MoeTiles m = moe_tiles(F, moe_idx);
    pg8::Sched S; S.init_plain(WSP(const bf16_t, WS_H), D, Wgu, D, WSP(bf16_t, WS_ACT), FFE, 256, 2 * FFE, F.G, F.bx); S.cn = 128; S.sAm = 0;
    set_moe(S, m, WSP(const int, WS_LIST)); S.sBe = (long)2 * FFE * D * 2;
    pg8::EpiSwiGLU E{FFE};
    pg8::gemm_phase<pg8::EpiSwiGLU, true>(F.lds, D, D, D, S, E);
}
__device__ __forceinline__ void g_moe1_fp8(Frame& F, const unsigned char* Wgu8, int moe_idx) {
    const MoeTiles m = moe_tiles(F, moe_idx);
    pg8::Sched S; S.init_plain(WSP(const bf16_t, WS_H), D / 2, (const bf16_t*)Wgu8, D / 2, WSP(bf16_t, WS_ACT), FFE, 256, 2 * FFE, F.G, F.bx); S.sAm = 0;
    S.cm1 = (long)256 * (FFE / 2); S.cn = 64;
    set_moe(S, m, WSP(const int, WS_LIST)); S.sBe = (long)2 * FFE * D;
    pg8::EpiSwiGLU8 E{FFE, 1.0f / W8_GU, A8_ACT};
    pg8::gemm_phase<pg8::EpiSwiGLU8, true, true>(F.lds, D / 2, D / 2, D / 2, S, E);
}
__device__ __forceinline__ void g_moe2_fp8(Frame& F, const unsigned char* Wd8, int moe_idx) {
    const MoeTiles m = moe_tiles(F, moe_idx);
    pg8::Sched S; S.init_plain(WSP(const bf16_t, WS_ACT), FFE / 2, (const bf16_t*)Wd8, FFE / 2, WSP(bf16_t, WS_Y2), D, 256, D, F.G, F.bx);
    set_moe(S, m, WSP(const int, WS_LIST)); S.sBe = (long)D * FFE;
    if (moe_idx == 1) { const MoeSplit ms = moe_split(m.tend[7], F.G); S.ms_full = ms.full; S.ms_nsl = ms.nsl; S.ms_kt = FFE / 128; S.ms_P = WSP(bf16_t, WS_MSP); }
    pg8::EpiPlain E{D, 1.0f / (W8_D * A8_ACT)};
    pg8::gemm_phase<pg8::EpiPlain, false, true>(F.lds, FFE / 2, FFE / 2, FFE / 2, S, E);
}
__device__ __forceinline__ void g_moe2(Frame& F, const bf16_t* Wd, int moe_idx) {
    const MoeTiles m = moe_tiles(F, moe_idx);
    pg8::Sched S; S.init_plain(WSP(const bf16_t, WS_ACT), FFE, Wd, FFE, WSP(bf16_t, WS_Y2), D, 256, D, F.G, F.bx);
    set_moe(S, m, WSP(const int, WS_LIST)); S.sBe = (long)D * FFE * 2;
    pg8::EpiPlain E{D, 1.0f};
    pg8::gemm_phase<pg8::EpiPlain, false>(F.lds, FFE, FFE, FFE, S, E);
}

struct Args { const float* in[23]; float* out; unsigned char* ws; int ph_lo, ph_hi; };
__global__ void __launch_bounds__(NWAVES * 64, 2) mk_fwd(Args args) {
    extern __shared__ __attribute__((aligned(16))) unsigned char lds_raw[];
    Frame F;
    F.lds = (LAS unsigned char*)lds_raw;
    F.tid = threadIdx.x; F.lane = F.tid & 63; F.wave = __builtin_amdgcn_readfirstlane(F.tid >> 6);
    F.G = gridDim.x; F.bx = blockIdx.x; F.vcu = (F.G % 8 == 0) ? (F.bx % 8) * (F.G / 8) + F.bx / 8 : F.bx;
    F.ws = args.ws; F.ctl = (unsigned*)(args.ws + WS_CTL); F.out = args.out;
#pragma unroll
    for (int i = 0; i < 23; ++i) F.in[i] = args.in[i];
    volatile LAS unsigned* MISC = (volatile LAS unsigned*)(F.lds + MISC_OFF);
    if (F.tid < 32) MISC[F.tid] = 0u;
    __syncthreads();
    XcdBarrier bar; bar.bar = F.ctl + CW_BAR; bar.x = 0; bar.st = nullptr;
    if (!MK_PER_PHASE) bar = xcd_barrier_post(F.ctl + CW_BAR, MISC + 8);
    const int lo = args.ph_lo, hi = args.ph_hi;
#define IN(k) (lo <= (k) && (k) < hi)
#define SEAM(k) do { if (IN(k) && IN((k) + 1)) { if (!MK_PER_PHASE) xcd_barrier(bar); } } while (0)
    constexpr float SC1 = 1.0f;
    if (IN(0)) { p_prologue(F); } SEAM(0);
    if (IN(1)) { p_r0(F); } SEAM(1);
    if (IN(2)) { if (QKV8 & 1) g_qkv_fp8(F, WSP(const unsigned char, WS_WQKV0)); else g_plain(F, WSP(const bf16_t, WS_H), D, WSP(const bf16_t, WS_WQKV0), D, WSP(bf16_t, WS_A_RAW), 1536, NTOK, 1536, D, SC1); } SEAM(2);
    if (IN(3)) { p_qkn(F, 0); } SEAM(3);
    if (IN(4)) { p_attn<64, 2>(F, WSP(const bf16_t, WS_A_RAW), 1536, 64, WSP(const bf16_t, WS_A_K), ATT_QK8 ? 128 : 256, ATT_QK8 ? 32 : 64, 4, WSP(const bf16_t, WS_A_VT), WSP(bf16_t, WS_A_O), true, F.in[8], F.in[9]); } SEAM(4);
    if (IN(5)) { g_plain_cs(F, WSP(const bf16_t, WS_A_O), D, WSP(const bf16_t, WS_WOA0), D, WSP(bf16_t, WS_Y), D, D, D, 4); } SEAM(5);
    if (IN(6)) { if (GU8 & 1) p_rmid<false, true>(F, 0, false, nullptr, 0, 4); else p_rmid<false>(F, 0, false, nullptr, 0, 4); } SEAM(6);
    if (IN(7)) { if (GU8 & 1) g_swiglu_fp8(F, WSP(const unsigned char, WS_WDGU0)); else if (DOWN8 & 1) g_swiglu_to8(F, WSP(const bf16_t, WS_WDGU0)); else g_swiglu(F, WSP(const bf16_t, WS_H), WSP(const bf16_t, WS_WDGU0), WSP(bf16_t, WS_ACT), NTOK, FFD); } SEAM(7);
    if (IN(8)) { if (DOWN8 & 1) g_down_fp8(F, WSP(const unsigned char, WS_WDD0)); else g_plain_cs(F, WSP(const bf16_t, WS_ACT), FFD, WSP(const bf16_t, WS_WDD0), FFD, WSP(bf16_t, WS_Y2), D, D, FFD, 11); } SEAM(8);
    if (IN(9)) { p_rend<false>(F, 0, false, 0, (DOWN8 & 1) ? DOWN8_CSN : 11); } SEAM(9);
    if (IN(10)) { if (FOURIER_FFT) p_htrans2(F); else p_htrans(F); } SEAM(10);
    if (FOURIER_FFT) {
    if (IN(11)) {
        { pg8::Sched S; S.init_plain(WSP(const bf16_t, WS_F_HT) + CTXL, TPB, WSP(const bf16_t, WS_BD1), 256, WSP(bf16_t, WS_F_G1), 8192, D, 512, F.G, F.bx);
          S.nB = NBATCH * 16; S.nB2 = 16; S.sAb = (long)D * TPB * 2; S.sAb2 = 512; S.sBb = 0; S.sBb2 = 0; S.sCb = (long)D * 8192; S.sCb2 = 512;
          pg8::EpiPlain E{8192, 1.0f}; pg8::gemm_phase<pg8::EpiPlain, false>(F.lds, 256, TPB, 256, S, E); }
        { pg8::Sched S; S.init_plain(WSP(const bf16_t, WS_TCTX), 256, WSP(const bf16_t, WS_F_HT), TPB, WSP(bf16_t, WS_F_U), 2048, 512, D, F.G, F.bx);
          S.nB = NBATCH; S.sAb = 0; S.sBb = (long)D * TPB * 2; S.sCb = (long)TPB * 2048; S.pmw = 1; S.cm1 = 0; S.cm2 = 256; S.cn = 512;
          pg8::EpiPlain E{2048, 1.0f}; pg8::gemm_phase<pg8::EpiPlain, false>(F.lds, 256, 256, TPB, S, E); }
        if (!MK_PER_PHASE) xcd_barrier(bar);
        p_fft_relayout(F);
        if (!MK_PER_PHASE) xcd_barrier(bar);
        { pg8::Sched S; S.init_plain(WSP(const bf16_t, WS_T2BD), 256, WSP(const bf16_t, WS_F_G2), 8192, WSP(bf16_t, WS_F_U) + (size_t)CTXL * 2048, 2048, 256, D, F.G, F.bx);
          S.nB = NBATCH * 32; S.nB2 = 32; S.sAb = 0; S.sAb2 = 0; S.sBb = (long)D * 8192 * 2; S.sBb2 = 512; S.sCb = (long)TPB * 2048; S.sCb2 = 2 * 2048; S.cm1 = 0; S.cn = 512;
          pg8::EpiFFT2 E{0}; pg8::gemm_phase<pg8::EpiFFT2, false>(F.lds, 256, 256, 8192, S, E); }
    } SEAM(11);
    } else {
    if (IN(11)) {
        { const int gw = F.vcu * NWAVES + F.wave, NGW = F.G * NWAVES, lane = F.lane;
          for (int rw = gw; rw < NBATCH * D; rw += NGW) { const int b = rw >> 10, ch = rw & 1023; const bf16_t* hp = WSP(const bf16_t, WS_F_HT) + (size_t)rw * TPB + CTXL; float acc_ = 0.f;
#pragma unroll
              for (int q = 0; q < 8; ++q) { float x[8]; unpack8(*(const u32x4*)(hp + (q * 64 + lane) * 8), x); acc_ += ((x[0] - x[1]) + (x[2] - x[3])) + ((x[4] - x[5]) + (x[6] - x[7])); }
              acc_ = wave_sum(acc_) * (1.0f / 1024.0f);
              if (lane == 0) { bf16_t* up = WSP(bf16_t, WS_F_U) + (size_t)(b * TPB + CTXL + 2048) * 2048 + (ch >> 8) * 512 + (ch & 255); up[0] = (bf16_t)f2bf(acc_); up[256] = 0; } } }
        { pg8::Sched S; S.init_plain(WSP(const bf16_t, WS_TSEQ), 4096, WSP(const bf16_t, WS_F_HT) + CTXL, TPB, WSP(bf16_t, WS_F_U) + (size_t)CTXL * 2048, 2048, 4096, D, F.G, F.bx);
          S.nB = NBATCH; S.sAb = 0; S.sBb = (long)D * TPB * 2; S.sCb = (long)TPB * 2048; S.pmw = 8; S.cm1 = (long)256 * 2048; S.cm2 = 256; S.cn = 512;
          pg8::EpiMirror E{2048}; pg8::gemm_phase<pg8::EpiMirror, false>(F.lds, 4096, 4096, TPB, S, E); }
        { pg8::Sched S; S.init_plain(WSP(const bf16_t, WS_TCTX), 256, WSP(const bf16_t, WS_F_HT), TPB, WSP(bf16_t, WS_F_U), 2048, 512, D, F.G, F.bx);
          S.nB = NBATCH; S.sAb = 0; S.sBb = (long)D * TPB * 2; S.sCb = (long)TPB * 2048; S.pmw = 1; S.cm1 = 0; S.cm2 = 256; S.cn = 512;
          pg8::EpiPlain E{2048, 1.0f}; pg8::gemm_phase<pg8::EpiPlain, false>(F.lds, 256, 256, TPB, S, E); }
    } SEAM(11);
    }
    if (IN(12)) { g_plain_cs(F, WSP(const bf16_t, WS_F_U), 2048, WSP(const bf16_t, WS_WFP), 2048, WSP(bf16_t, WS_Y), D, D, 2048, 8); } SEAM(12);
    if (IN(13)) { p_rmid<true, true>(F, 1, false, F.in[20], 0, 8); } SEAM(13);
    if (IN(14)) { g_moe1_fp8(F, WSP(const unsigned char, WS_WEGU0), 0); } SEAM(14);
    if (IN(15)) { g_moe2_fp8(F, WSP(const unsigned char, WS_WED0), 0); } SEAM(15);
    if (IN(16)) { p_rend<true>(F, 1, false, 0); } SEAM(16);
    if (IN(17)) { g_plain(F, WSP(const bf16_t, WS_H), D, WSP(const bf16_t, WS_WMD), D, WSP(bf16_t, WS_M_DM), 768, NTOK, 768, D, SC1); } SEAM(17);
    if (IN(18)) { p_mla1(F); } SEAM(18);
    if (IN(19)) { g_plain(F, WSP(const bf16_t, WS_M_CQ), 384, WSP(const bf16_t, WS_WUQ), 384, WSP(bf16_t, WS_M_Q), 1536, NTOK, 1536, 384, SC1);
                  g_plain(F, WSP(const bf16_t, WS_M_CKV), 256, WSP(const bf16_t, WS_WUKV), 256, WSP(bf16_t, WS_M_KV), 2048, NTOK, 2048, 256, SC1); } SEAM(19);
    if (IN(20)) { p_mla2(F); } SEAM(20);
    if (IN(21)) { p_attn<96, 2>(F, WSP(const bf16_t, WS_M_Q), 1536, 96, (MLA_QK8 && ATT_QK8) ? WSP(const bf16_t, WS_M_K8) : WSP(const bf16_t, WS_M_KV), (MLA_QK8 && ATT_QK8) ? 768 : 2048, (MLA_QK8 && ATT_QK8) ? 48 : 128, 1, WSP(const bf16_t, WS_M_VT), WSP(bf16_t, WS_M_O), true, nullptr, nullptr, true); } SEAM(21);
    if (IN(22)) { g_plain_cs(F, WSP(const bf16_t, WS_M_O), D, WSP(const bf16_t, WS_WMO), D, WSP(bf16_t, WS_Y), D, D, D, 4); } SEAM(22);
    if (IN(23)) { if (GU8 & 2) p_rmid<false, true>(F, 2, false, nullptr, 0, 4); else p_rmid<false>(F, 2, false, nullptr, 0, 4); } SEAM(23);
    if (IN(24)) { if (GU8 & 2) g_swiglu_fp8(F, WSP(const unsigned char, WS_WDGU1)); else if (DOWN8 & 2) g_swiglu_to8(F, WSP(const bf16_t, WS_WDGU1)); else g_swiglu(F, WSP(const bf16_t, WS_H), WSP(const bf16_t, WS_WDGU1), WSP(bf16_t, WS_ACT), NTOK, FFD); } SEAM(24);
    if (IN(25)) { if (DOWN8 & 2) g_down_fp8(F, WSP(const unsigned char, WS_WDD1)); else g_plain_cs(F, WSP(const bf16_t, WS_ACT), FFD, WSP(const bf16_t, WS_WDD1), FFD, WSP(bf16_t, WS_Y2), D, D, FFD, 11); } SEAM(25);
    if (IN(26)) { p_rend<false>(F, 2, false, 0, (DOWN8 & 2) ? DOWN8_CSN : 11); } SEAM(26);
    if (IN(27)) { if (QKV8 & 2) g_qkv_fp8(F, WSP(const unsigned char, WS_WQKV1)); else g_plain(F, WSP(const bf16_t, WS_H), D, WSP(const bf16_t, WS_WQKV1), D, WSP(bf16_t, WS_A_RAW), 1536, NTOK, 1536, D, SC1); } SEAM(27);
    if (IN(28)) { p_qkn(F, 1); } SEAM(28);
    if (IN(29)) { p_attn<64, 2>(F, WSP(const bf16_t, WS_A_RAW), 1536, 64, WSP(const bf16_t, WS_A_K), ATT_QK8 ? 128 : 256, ATT_QK8 ? 32 : 64, 4, WSP(const bf16_t, WS_A_VT), WSP(bf16_t, WS_A_O), false, F.in[8] + 64, F.in[9] + 64); } SEAM(29);
    if (IN(30)) { g_plain_cs(F, WSP(const bf16_t, WS_A_O), D, WSP(const bf16_t, WS_WOA1), D, WSP(bf16_t, WS_Y), D, D, D, 0); } SEAM(30);
    if (IN(31)) { p_rmid<true, true>(F, 3, true, F.in[20] + (size_t)D * NEXP, 1); } SEAM(31);
    if (IN(32)) { g_moe1_fp8(F, WSP(const unsigned char, WS_WEGU1), 1); } SEAM(32);
    if (IN(33)) { g_moe2_fp8(F, WSP(const unsigned char, WS_WED1), 1); } SEAM(33);
    if (IN(34)) { p_rend<true>(F, 3, true, 1); }
#undef IN
#undef SEAM
}


#if DBG_CHECK
__device__ __forceinline__ float blk_sum(float v, float* red) {
    __syncthreads(); red[threadIdx.x] = v; __syncthreads();
    for (int o = 128; o > 0; o >>= 1) { if ((int)threadIdx.x < o) red[threadIdx.x] += red[threadIdx.x + o]; __syncthreads(); }
    return red[0];
}
__device__ __forceinline__ bool close_enough(float got, float ref) { return fabsf(got - ref) <= 0.04f * fabsf(ref) + 0.03f; }
__global__ void dbg_check_moe(Args args, int moe_idx, int lat_only) {
    __shared__ float hs[1024]; __shared__ float red[256]; __shared__ float lg[8]; __shared__ int sh_i[8]; __shared__ float sh_f[2];
    unsigned char* ws = args.ws; unsigned* ctl = (unsigned*)ws; const int tid = threadIdx.x;
    int t = (blockIdx.x * 541 + 17) % NTOK; if (lat_only && (t % TPB) < CTXL) t += CTXL;
    const bf16_t* H = (const bf16_t*)(ws + WS_H) + (size_t)t * D;
    for (int i = tid; i < D; i += 256) hs[i] = bf2f(H[i]);
    __syncthreads();
    const float* wr = args.in[20] + (size_t)moe_idx * D * NEXP;
    for (int e = 0; e < 8; ++e) { float p = 0.f; for (int c = tid; c < D; c += 256) p += hs[c] * wr[c * 8 + e]; const float r = blk_sum(p, red); if (tid == 0) lg[e] = r; }
    __syncthreads();
    const u32x4 ti = ((const u32x4*)(ws + WS_TOKINFO))[t];
    const int e1 = ti.x & 255, e2 = ti.x >> 8, g1 = (int)ti.y, g2 = (int)ti.z; const unsigned w1b = ti.w; const float w1 = u2f(w1b);
    unsigned code = 0;
    if (tid == 0) {
        int r1 = 0; for (int e = 1; e < 8; ++e) if (lg[e] > lg[r1]) r1 = e;
        int r2 = -1; for (int e = 0; e < 8; ++e) if (e != r1 && (r2 < 0 || lg[e] > lg[r2])) r2 = e;
        int r3 = -1; for (int e = 0; e < 8; ++e) if (e != r1 && e != r2 && (r3 < 0 || lg[e] > lg[r3])) r3 = e;
        const float rw1 = 1.0f / (1.0f + expf(lg[r2] - lg[r1]));
        const bool safe = (lg[r2] - lg[r3] > 0.05f) && (lg[r1] - lg[r2] > 0.05f);
        const float* dl = (const float*)(ws + 1300 * MiB) + (size_t)t * 8; float md = 0.f; for (int e = 0; e < 8; ++e) md = fmaxf(md, fabsf(dl[e] - lg[e]));
        if (safe && fabsf(rw1 - w1) > 0.02f) code = 6;
        if (safe && r2 != e2) code = 7;
        if (safe && r1 != e1) code = 8;
        if (!(md <= 0.02f)) code = 9;
        if (e1 > 7 || e2 > 7 || e1 == e2) code = 10;
        const int* list = (const int*)(ws + WS_LIST);
        if (code == 0 && (list[(size_t)e1 * LIST_CAP + g1] != t || list[(size_t)e2 * LIST_CAP + g2] != t)) code = 5;
        int acc = 0, ts1 = 0, ts2 = 0;
        for (int e = 0; e < 8; ++e) { const int c = (int)ctl[CW_MOE + moe_idx * 8 * 64 + e * 64]; if (e == e1) { ts1 = acc; if (g1 >= c) code = code > 5 ? code : 5; } if (e == e2) { ts2 = acc; if (g2 >= c) code = code > 5 ? code : 5; } acc += (c + 255) >> 8; }
        sh_i[0] = ts1 * 256 + g1; sh_i[1] = ts2 * 256 + g2;
    }
    __syncthreads();
    const bf16_t* ACT = (const bf16_t*)(ws + WS_ACT); const bf16_t* YP = (const bf16_t*)(ws + WS_Y2);
    for (int k = 0; k < 2; ++k) {
        const int e = k ? e2 : e1; const size_t pr = (size_t)sh_i[k]; if (e > 7) continue;
        const float* wgu = args.in[21] + (size_t)(moe_idx * NEXP + e) * D * 2 * FFE; const float* wd = args.in[22] + (size_t)(moe_idx * NEXP + e) * FFE * D;
        for (int j = 0; j < 6; ++j) {
            const int ch = (j * 449 + 3 + blockIdx.x * 7) % FFE; float pg = 0.f, pu = 0.f;
            for (int c = tid; c < D; c += 256) { pg += hs[c] * wgu[(size_t)c * 2 * FFE + ch]; pu += hs[c] * wgu[(size_t)c * 2 * FFE + FFE + ch]; }
            const float g = blk_sum(pg, red); const float u = blk_sum(pu, red);
            const float ref = g / (1.0f + expf(-g)) * u; const float got = bf2f(ACT[pr * FFE + ch]);
            if (tid == 0 && !close_enough(got, ref)) { const unsigned c2 = k ? 3u : 4u; code = code > c2 ? code : c2; }
        }
        for (int j = 0; j < 6; ++j) {
            const int n = (j * 173 + 5 + blockIdx.x * 3) % D; float p = 0.f;
            for (int f = tid; f < FFE; f += 256) p += bf2f(ACT[pr * FFE + f]) * wd[(size_t)f * D + n];
            const float ref = blk_sum(p, red); const float got = bf2f(YP[pr * D + n]);
            if (tid == 0 && !close_enough(got, ref)) { const unsigned c2 = k ? 1u : 2u; code = code > c2 ? code : c2; }
        }
    }
    if (tid == 0 && code) atomicAdd(ctl + 16 + code, 1u);
}
__global__ void dbg_final(Args args) { unsigned* ctl = (unsigned*)args.ws; unsigned code = 0, cnt = 0; for (unsigned k = 1; k < 16; ++k) if (ctl[16 + k]) { code = k; cnt = ctl[16 + k]; } if (code) { float a = 1000.f * sqrtf((float)cnt); for (unsigned i = 0; i < code; ++i) a *= 10.f; args.out[0] += a; } }
#endif

extern "C" void kernel_launch(void* const* d_in, const int* in_sizes, int n_in, void* d_out, int out_size, void* d_ws, size_t ws_size, hipStream_t stream) {
    static int grid = 0;
    if (grid == 0) {
        if (n_in != 23 || out_size != NLAT * D || ws_size < WS_END) { fprintf(stderr, "kernel_launch: unexpected shapes/workspace (n_in %d out %d ws %zu need %zu)\n", n_in, out_size, ws_size, (size_t)WS_END); grid = -1; return; }
        int dev = 0, cus = 0, per_cu = 0;
        if (hipGetDevice(&dev) != hipSuccess || hipDeviceGetAttribute(&cus, hipDeviceAttributeMultiprocessorCount, dev) != hipSuccess) { grid = -1; return; }
        if (hipFuncSetAttribute((const void*)mk_fwd, hipFuncAttributeMaxDynamicSharedMemorySize, LDS_BYTES) != hipSuccess) { fprintf(stderr, "kernel_launch: hipFuncSetAttribute failed\n"); grid = -1; return; }
        if (hipOccupancyMaxActiveBlocksPerMultiprocessor(&per_cu, (const void*)mk_fwd, NWAVES * 64, LDS_BYTES) != hipSuccess || per_cu < 1) { fprintf(stderr, "kernel_launch: occupancy query reports %d\n", per_cu); }
        (void)hipGetLastError();
        grid = cus;
    }
    if (grid < 0) return;
    if (hipMemsetAsync((char*)d_ws + WS_CTL, 0, CTL_ZERO_BYTES, stream) != hipSuccess) return;
    Args a{};
    for (int i = 0; i < 23; ++i) a.in[i] = (const float*)d_in[i];
    a.out = (float*)d_out; a.ws = (unsigned char*)d_ws;
#if MK_PER_PHASE
    for (int p = 0; p < NPHASE; ++p) { a.ph_lo = p; a.ph_hi = p + 1; hipLaunchKernelGGL(mk_fwd, dim3(grid), dim3(NWAVES * 64), LDS_BYTES, stream, a);
#if DBG_CHECK
        if (p == 15) hipLaunchKernelGGL(dbg_check_moe, dim3(64), dim3(256), 0, stream, a, 0, 0);
#endif
    }
#if DBG_CHECK
    hipLaunchKernelGGL(dbg_final, dim3(1), dim3(1), 0, stream, a);
#endif
#else
    a.ph_lo = 0; a.ph_hi = NPHASE; hipLaunchKernelGGL(mk_fwd, dim3(grid), dim3(NWAVES * 64), LDS_BYTES, stream, a);
#endif
}
```
